# Optimizing an MI355X kernel written in HIP

```python
import jax, jax.numpy as jnp
from jax import lax
import numpy as np

D_MODEL = 4096
BATCH = 2
SEQ = 4096
DEPTH = 2

N_A = (DEPTH + 1) // 2
N_B = DEPTH - N_A
EPS = 1e-6

MLA_NOPE = 128
MLA_ROPE = 64
MLA_V = 128
MLA_HEADS = D_MODEL // 128
MLA_Q_LORA = 1024
MLA_KV_LORA = 512
ROPE_THETA = 10000.0
Q_BLOCK = 128

SWA_HEAD_DIM = 64
SWA_HEADS = D_MODEL // SWA_HEAD_DIM
SWA_KV_HEADS = 8
WINDOW = 128

D_FF = ((8 * D_MODEL // 3) + 255) // 256 * 256
CONV_W = 3

kernel_name = "yoco_mla_swa_sink_convffn"


def rmsnorm(x, g):
    xf = x.astype(jnp.float32)
    y = xf * lax.rsqrt(jnp.mean(xf * xf, axis=-1, keepdims=True) + EPS)
    return (y * g.astype(jnp.float32)).astype(x.dtype)


def rope(x, pos):
    half = x.shape[-1] // 2
    freqs = ROPE_THETA ** (-jnp.arange(half, dtype=jnp.float32) / half)
    ang = pos.astype(jnp.float32)[..., None] * freqs
    ang = ang.reshape(ang.shape[:2] + (1,) * (x.ndim - 3) + (half,))
    cos, sin = jnp.cos(ang), jnp.sin(ang)
    xf = x.astype(jnp.float32)
    x1, x2 = xf[..., :half], xf[..., half:]
    return jnp.concatenate([x1 * cos - x2 * sin, x2 * cos + x1 * sin], axis=-1).astype(x.dtype)


def mla_attention(h, pos, w_dq, q_norm, w_uq, w_dkv, kv_norm, w_ukv, w_o):
    B, S, _ = h.shape
    H = MLA_HEADS
    cq = rmsnorm(h @ w_dq, q_norm)
    q = (cq @ w_uq).reshape(B, S, H, MLA_NOPE + MLA_ROPE)
    q = jnp.concatenate([q[..., :MLA_NOPE], rope(q[..., MLA_NOPE:], pos)], axis=-1)
    ckv = h @ w_dkv
    c = rmsnorm(ckv[..., :MLA_KV_LORA], kv_norm)
    k_rope = rope(ckv[..., MLA_KV_LORA:], pos)
    kv = (c @ w_ukv).reshape(B, S, H, MLA_NOPE + MLA_V)
    k = jnp.concatenate(
        [kv[..., :MLA_NOPE], jnp.broadcast_to(k_rope[:, :, None, :], (B, S, H, MLA_ROPE))], axis=-1)
    v = kv[..., MLA_NOPE:]
    scale = (MLA_NOPE + MLA_ROPE) ** -0.5
    nb = S // Q_BLOCK
    q_blocks = q.reshape(B, nb, Q_BLOCK, H, MLA_NOPE + MLA_ROPE).transpose(1, 0, 2, 3, 4)
    key_pos = jnp.arange(S)

    def one_block(args):
        qb, i = args
        s = jnp.einsum('bqhd,bkhd->bhqk', qb, k).astype(jnp.float32) * scale
        q_pos = i * Q_BLOCK + jnp.arange(Q_BLOCK)
        causal = key_pos[None, :] <= q_pos[:, None]
        s = jnp.where(causal[None, None], s, -jnp.inf)
        p = jax.nn.softmax(s, axis=-1).astype(v.dtype)
        return jnp.einsum('bhqk,bkhd->bqhd', p, v)

    o = lax.map(one_block, (q_blocks, jnp.arange(nb)))
    o = o.transpose(1, 0, 2, 3, 4).reshape(B, S, H * MLA_V)
    return o @ w_o


def band(x):
    B, S = x.shape[:2]
    nb = S // WINDOW
    xb = x.reshape((B, nb, WINDOW) + x.shape[2:])
    prev = jnp.pad(xb[:, :-1], ((0, 0), (1, 0), (0, 0), (0, 0), (0, 0)))
    return jnp.concatenate([prev, xb], axis=2)


def shared_kv(h, g, w_k, w_v):
    B, S, _ = h.shape
    hn = rmsnorm(h, g)
    k = (hn @ w_k).reshape(B, S, SWA_KV_HEADS, SWA_HEAD_DIM)
    v = (hn @ w_v).reshape(B, S, SWA_KV_HEADS, SWA_HEAD_DIM)
    return band(k), band(v)


def alibi_slopes(n):
    return 2.0 ** (-8.0 * jnp.arange(1, n + 1, dtype=jnp.float32) / n)


def swa_attention(h, k_band, v_band, w_q, sinks, w_o):
    B, S, _ = h.shape
    nb = S // WINDOW
    G = SWA_KV_HEADS
    R = SWA_HEADS // SWA_KV_HEADS
    q = (h @ w_q).reshape(B, nb, WINDOW, G, R, SWA_HEAD_DIM)
    s = jnp.einsum('bnqgrd,bnkgd->bngrqk', q, k_band).astype(jnp.float32) * (SWA_HEAD_DIM ** -0.5)
    qi = jnp.arange(WINDOW)[:, None]
    kj = jnp.arange(2 * WINDOW)[None, :]
    dist = qi + WINDOW - kj
    slopes = alibi_slopes(SWA_HEADS).reshape(G, R)
    s = s - slopes[:, :, None, None] * dist.astype(jnp.float32)
    key_pos = jnp.arange(nb)[:, None, None] * WINDOW - WINDOW + kj[None]
    valid = (dist[None] >= 0) & (dist[None] < WINDOW) & (key_pos >= 0)
    s = jnp.where(valid[None, :, None, None], s, -jnp.inf)
    sink_col = jnp.broadcast_to(sinks.astype(jnp.float32).reshape(G, R)[None, None, :, :, None, None],
                                (B, nb, G, R, WINDOW, 1))
    p = jax.nn.softmax(jnp.concatenate([s, sink_col], axis=-1), axis=-1)[..., :-1].astype(v_band.dtype)
    o = jnp.einsum('bngrqk,bnkgd->bnqgrd', p, v_band).reshape(B, S, SWA_HEADS * SWA_HEAD_DIM)
    return o @ w_o


def conv_ffn(h, w_in, conv_w, conv_b, w_out):
    S = h.shape[1]
    u = h @ w_in
    up = jnp.pad(u, ((0, 0), (CONV_W - 1, 0), (0, 0)))
    u = conv_b + sum(conv_w[j] * up[:, j:j + S] for j in range(CONV_W))
    gate, val = u[..., :D_FF], u[..., D_FF:]
    return (jax.nn.silu(gate) * val) @ w_out


def setup_inputs(seed: int = 0) -> dict:
    key = jax.random.key(seed)
    ks = jax.random.split(key, 32)
    f32 = jnp.float32

    def w(k, shape, fan_in):
        return jax.random.normal(k, shape, f32) * (fan_in ** -0.5)

    def gain(k, shape):
        return 1.0 + 0.05 * jax.random.normal(k, shape, f32)

    D = D_MODEL
    return {
        "x": jax.random.normal(ks[0], (BATCH, SEQ, D), f32),
        "positions": (jnp.arange(SEQ, dtype=jnp.int32)[None, :]
                      + jax.random.randint(ks[1], (BATCH, 1), 0, 1024, dtype=jnp.int32)),
        "norm_mix_pre": gain(ks[2], (DEPTH, D)),
        "norm_mix_post": gain(ks[3], (DEPTH, D)),
        "norm_ffn_pre": gain(ks[4], (DEPTH, D)),
        "norm_ffn_post": gain(ks[5], (DEPTH, D)),
        "mla_w_dq": w(ks[6], (N_A, D, MLA_Q_LORA), D),
        "mla_q_norm": gain(ks[7], (N_A, MLA_Q_LORA)),
        "mla_w_uq": w(ks[8], (N_A, MLA_Q_LORA, MLA_HEADS * (MLA_NOPE + MLA_ROPE)), MLA_Q_LORA),
        "mla_w_dkv": w(ks[9], (N_A, D, MLA_KV_LORA + MLA_ROPE), D),
        "mla_kv_norm": gain(ks[10], (N_A, MLA_KV_LORA)),
        "mla_w_ukv": w(ks[11], (N_A, MLA_KV_LORA, MLA_HEADS * (MLA_NOPE + MLA_V)), MLA_KV_LORA),
        "mla_w_o": w(ks[12], (N_A, MLA_HEADS * MLA_V, D), MLA_HEADS * MLA_V),
        "shared_kv_norm": gain(ks[13], (D,)),
        "swa_w_k": w(ks[14], (D, SWA_KV_HEADS * SWA_HEAD_DIM), D),
        "swa_w_v": w(ks[15], (D, SWA_KV_HEADS * SWA_HEAD_DIM), D),
        "swa_w_q": w(ks[16], (N_B, D, SWA_HEADS * SWA_HEAD_DIM), D),
        "swa_sinks": 0.5 * jax.random.normal(ks[17], (N_B, SWA_HEADS), f32),
        "swa_w_o": w(ks[18], (N_B, SWA_HEADS * SWA_HEAD_DIM, D), SWA_HEADS * SWA_HEAD_DIM),
        "ffn_w_in": w(ks[19], (DEPTH, D, 2 * D_FF), D),
        "ffn_conv_w": w(ks[20], (DEPTH, CONV_W, 2 * D_FF), CONV_W),
        "ffn_conv_b": 0.01 * jax.random.normal(ks[21], (DEPTH, 2 * D_FF), f32),
        "ffn_w_out": w(ks[22], (DEPTH, D_FF, D), D_FF),
    }


def reference(x, positions, norm_mix_pre, norm_mix_post, norm_ffn_pre, norm_ffn_post,
              mla_w_dq, mla_q_norm, mla_w_uq, mla_w_dkv, mla_kv_norm, mla_w_ukv, mla_w_o,
              shared_kv_norm, swa_w_k, swa_w_v, swa_w_q, swa_sinks, swa_w_o,
              ffn_w_in, ffn_conv_w, ffn_conv_b, ffn_w_out):
    h = x
    k_band = None
    v_band = None
    for l in range(DEPTH):
        hn = rmsnorm(h, norm_mix_pre[l])
        if l < N_A:
            a = mla_attention(hn, positions, mla_w_dq[l], mla_q_norm[l], mla_w_uq[l],
                              mla_w_dkv[l], mla_kv_norm[l], mla_w_ukv[l], mla_w_o[l])
        else:
            if l == N_A:
                k_band, v_band = shared_kv(h, shared_kv_norm, swa_w_k, swa_w_v)
            j = l - N_A
            a = swa_attention(hn, k_band, v_band, swa_w_q[j], swa_sinks[j], swa_w_o[j])
        h = h + rmsnorm(a, norm_mix_post[l])
        f = conv_ffn(rmsnorm(h, norm_ffn_pre[l]), ffn_w_in[l], ffn_conv_w[l], ffn_conv_b[l], ffn_w_out[l])
        h = h + rmsnorm(f, norm_ffn_post[l])
    return h
```

```cpp
#include <hip/hip_runtime.h>
#include <cstdio>
#include <cstdint>
#include <cstring>
namespace pg8 {
#define PG8_LAS __attribute__((address_space(3)))
typedef unsigned short bf16_t;
typedef short bf16x8 __attribute__((ext_vector_type(8)));
typedef float f32x4 __attribute__((ext_vector_type(4)));
typedef unsigned u32x4 __attribute__((ext_vector_type(4)));
constexpr int BM = 256, BK = 64, HALF = 128, HTB = HALF * BK * 2  , STAGE_BYTES = 8 * HTB, NXCD = 8, WGM = 8;

__host__ __device__ __forceinline__ int lds_byte(int r, int c) { const int st = (r >> 4) * 2 + (c >> 5), rr = r & 15, cc = c & 31, ob = rr * 64 + cc * 2; return st * 1024 + (ob ^ (((ob >> 9) & 1) << 5)); }
__host__ __device__ __forceinline__ void stage_rc(int b, int& R, int& C) { const int st = b / 1024, sb = b % 1024, swz = sb ^ (((sb >> 9) & 1) << 5); R = (st >> 1) * 16 + swz / 64; C = (st & 1) * 32 + (swz % 64) / 2; }
__host__ __device__ __forceinline__ int perm32(int rho) { const int n = rho >> 4, i = rho & 15; return 8 * (i >> 2) + 4 * n + (i & 3); }

struct Unit { int pm, pn; };
struct Gemm { const bf16_t* A; const bf16_t* Bt; int M, N, K; };

struct StaticOrder {
    int nM, nN, nwg, G, c;
    __host__ __device__ void init(int M, int N, int G_, int c_) { nM = M / BM; nN = N / BM; nwg = nM * nN; G = G_; c = c_; }
    __host__ __device__ bool next(int i, Unit& u) const {
        const long L = (long)i * G + c; if (L >= nwg) return false;
        int wgid = (int)L; { const int q = nwg / NXCD, r = nwg % NXCD, xcd = wgid % NXCD, off = wgid / NXCD; wgid = (xcd < r ? xcd * (q + 1) : r * (q + 1) + (xcd - r) * q) + off; }
        const int nig = WGM * nN, gid = wgid / nig, fm = gid * WGM, gsz = (nM - fm) < WGM ? (nM - fm) : WGM;
        u.pm = fm + ((wgid % nig) % gsz); u.pn = (wgid % nig) / gsz; return true;
    }
    __device__ __forceinline__ void a_ready(const Unit&) const {}
    __device__ __forceinline__ void done(const Unit&) const {}
};

__device__ __forceinline__ unsigned cvt_pk_bf16(float lo, float hi) { unsigned r; asm volatile("v_cvt_pk_bf16_f32 %0, %1, %2" : "=v"(r) : "v"(lo), "v"(hi)); return r; }
typedef float f32x2 __attribute__((ext_vector_type(2)));
struct EpiF32 {
    static constexpr bool PERM = false, AFTER_DRAIN = false;
    float* C; int ldc;
    __device__ __forceinline__ void operator()(const f32x4 (&acc)[2][2][4][2], const Unit& u, int wr, int wc, int fr, int fq) const {
        const int row0 = u.pm * BM + wr * 64 + fr, col0 = u.pn * BM + wc * 32 + 4 * fq;
#pragma unroll
        for (int ai = 0; ai < 2; ++ai)
#pragma unroll
            for (int m = 0; m < 4; ++m) { float* rowp = C + (size_t)(row0 + ai * HALF + m * 16) * ldc + col0;
#pragma unroll
                for (int bj = 0; bj < 2; ++bj)
#pragma unroll
                    for (int n = 0; n < 2; ++n) *(f32x4*)(rowp + bj * HALF + n * 16) = acc[ai][bj][m][n]; }
    }
};
struct EpiBf16Map {
    static constexpr bool PERM = true, AFTER_DRAIN = false;
    bf16_t* O; int ldc; int gs, gstride; int scale_cols; float scale0;
    __device__ __forceinline__ void operator()(const f32x4 (&acc)[2][2][4][2], const Unit& u, int wr, int wc, int fr, int fq) const {
        const int row0 = u.pm * BM + wr * 64 + fr;
        int dcol[2]; float sc[2];
#pragma unroll
        for (int bj = 0; bj < 2; ++bj) { const int ch = u.pn * BM + bj * HALF, grp = ch / gs; dcol[bj] = grp * gstride + (ch - grp * gs) + wc * 32 + 8 * fq; sc[bj] = ch < scale_cols ? scale0 : 1.f; }
#pragma unroll
        for (int ai = 0; ai < 2; ++ai)
#pragma unroll
            for (int m = 0; m < 4; ++m) { bf16_t* rowp = O + (size_t)(row0 + ai * HALF + m * 16) * ldc;
#pragma unroll
                for (int bj = 0; bj < 2; ++bj) { const f32x4 v0 = acc[ai][bj][m][0] * sc[bj], v1 = acc[ai][bj][m][1] * sc[bj];
                    u32x4 w; w.x = cvt_pk_bf16(v0[0], v0[1]); w.y = cvt_pk_bf16(v0[2], v0[3]); w.z = cvt_pk_bf16(v1[0], v1[1]); w.w = cvt_pk_bf16(v1[2], v1[3]);
                    *(u32x4*)(rowp + dcol[bj]) = w; } }
    }
};

template <class Epi, class Sched, bool ALIGN_EPI = false, bool SP2 = false>
__device__ __forceinline__ void gemm_phase(PG8_LAS unsigned char* lds, const Gemm g, const Sched& S, const Epi& E) {
    const int tid = threadIdx.x, wid = __builtin_amdgcn_readfirstlane(tid >> 6), lane = tid & 63, wr = wid >> 2, wc = wid & 3, fr = lane & 15, fq = lane >> 4;
    const int K = g.K, nt = K / BK;
    unsigned voffA[2], voffB[2];
#pragma unroll
    for (int i = 0; i < 2; ++i) { int R, C; stage_rc(tid * 16 + i * 8192, R, C); const int Rb = Epi::PERM ? ((R & ~31) + perm32(R & 31)) : R;
        voffA[i] = (unsigned)(R * K + C) * 2u; voffB[i] = (unsigned)(Rb * K + C) * 2u; }
    const size_t kstep = (size_t)(BK * 2);
    const size_t hstep = (size_t)HALF * K * 2;
    const size_t tstep = 2 * hstep;
    const unsigned ldsw = (unsigned)wid * 1024u;
    const int aoff = lds_byte(wr * 64 + fr, fq * 8), boff = lds_byte(wc * 32 + fr, fq * 8);
#define PG8_SA(b, h) (((b) * 2 + (h)) * HTB)
#define PG8_SB(b, h) ((4 + (b) * 2 + (h)) * HTB)
#define PG8_STAGE(bufoff, gbase, voff) do { _Pragma("unroll") for (int _i = 0; _i < 2; ++_i) \
        __builtin_amdgcn_global_load_lds((const unsigned*)((const char*)(gbase) + (voff)[_i]), (PG8_LAS unsigned*)(lds + (bufoff) + ldsw + _i * 8192), 16, 0, 0); } while (0)
#define PG8_LDA(dst, b, h) do { _Pragma("unroll") for (int m = 0; m < 4; ++m) _Pragma("unroll") for (int k = 0; k < 2; ++k) dst[m][k] = *(const PG8_LAS bf16x8*)(lds + PG8_SA(b, h) + aoff + m * 2048 + k * 1024); } while (0)
#define PG8_LDB(dst, b, h) do { _Pragma("unroll") for (int n = 0; n < 2; ++n) _Pragma("unroll") for (int k = 0; k < 2; ++k) dst[n][k] = *(const PG8_LAS bf16x8*)(lds + PG8_SB(b, h) + boff + n * 2048 + k * 1024); } while (0)
#define PG8_MMA(ai, bj, At, Bt) do { __builtin_amdgcn_s_setprio(1); _Pragma("unroll") for (int m = 0; m < 4; ++m) _Pragma("unroll") for (int n = 0; n < 2; ++n) _Pragma("unroll") for (int k = 0; k < 2; ++k) \
        acc[ai][bj][m][n] = __builtin_amdgcn_mfma_f32_16x16x32_bf16(Bt[n][k], At[m][k], acc[ai][bj][m][n], 0, 0, 0); __builtin_amdgcn_s_setprio(0); } while (0)
#define PG8_WAIT_V(n) asm volatile("s_waitcnt vmcnt(" #n ")" ::: "memory")
#define PG8_WAIT_L(n) asm volatile("s_waitcnt lgkmcnt(" #n ")" ::: "memory")
#define PG8_BAR __builtin_amdgcn_s_barrier()
#define PG8_SCHED __builtin_amdgcn_sched_barrier(0)
    Unit cur, nxt; int ui = 0;
    if (!S.next(0, cur)) return;
    f32x4 acc[2][2][4][2];
#pragma unroll
    for (int a = 0; a < 2; ++a)
#pragma unroll
        for (int b = 0; b < 2; ++b)
#pragma unroll
            for (int m = 0; m < 4; ++m)
#pragma unroll
                for (int n = 0; n < 2; ++n) acc[a][b][m][n] = (f32x4){0.f, 0.f, 0.f, 0.f};
    bf16x8 At[4][2], B0[2][2], B1[2][2];
    const char* cA = (const char*)g.A + (size_t)cur.pm * tstep; const char* cB = (const char*)g.Bt + (size_t)cur.pn * tstep;
    S.a_ready(cur);
    if constexpr (SP2) {
        PG8_STAGE(PG8_SB(0, 0), cB, voffB); PG8_STAGE(PG8_SB(0, 1), cB + hstep, voffB); PG8_STAGE(PG8_SA(0, 0), cA, voffA); PG8_STAGE(PG8_SA(0, 1), cA + hstep, voffA);
        if (wr == 1) PG8_BAR;
        PG8_WAIT_V(2); PG8_BAR;
        PG8_STAGE(PG8_SB(1, 0), cB + kstep, voffB); PG8_STAGE(PG8_SA(1, 0), cA + kstep, voffA); PG8_STAGE(PG8_SB(1, 1), cB + hstep + kstep, voffB);
        PG8_WAIT_V(6); PG8_BAR;
    } else {
        PG8_STAGE(PG8_SB(0, 0), cB, voffB); PG8_STAGE(PG8_SA(0, 0), cA, voffA); PG8_STAGE(PG8_SB(0, 1), cB + hstep, voffB); PG8_STAGE(PG8_SA(0, 1), cA + hstep, voffA);
        if (wr == 1) PG8_BAR;
        PG8_WAIT_V(4); PG8_BAR;
        PG8_STAGE(PG8_SB(1, 0), cB + kstep, voffB); PG8_STAGE(PG8_SA(1, 0), cA + kstep, voffA); PG8_STAGE(PG8_SB(1, 1), cB + hstep + kstep, voffB);
        PG8_WAIT_V(6); PG8_BAR;
    }
    for (;;) {
        const bool has_next = S.next(ui + 1, nxt);
        const char* nA = has_next ? (const char*)g.A + (size_t)nxt.pm * tstep : cA; const char* nB = has_next ? (const char*)g.Bt + (size_t)nxt.pn * tstep : cB;
        for (int t = 0; t < nt; t += 2) {
            const bool last = (t == nt - 2);
            const char* a1 = cA + (size_t)(t + 1) * kstep;
            const char* a2 = last ? nA : cA + (size_t)(t + 2) * kstep; const char* b2 = last ? nB : cB + (size_t)(t + 2) * kstep;
            const char* a3 = a2 + kstep; const char* b3 = b2 + kstep;
            if (last && has_next) S.a_ready(nxt);
            if constexpr (SP2) {
            PG8_LDB(B0, 0, 0); PG8_LDB(B1, 0, 1); PG8_SCHED; PG8_LDA(At, 0, 0); PG8_STAGE(PG8_SA(1, 1), a1 + hstep, voffA);
            PG8_WAIT_V(8); PG8_WAIT_L(0); PG8_BAR; PG8_MMA(0, 0, At, B0); PG8_MMA(0, 1, At, B1); PG8_BAR; PG8_SCHED;
            PG8_LDA(At, 0, 1); PG8_STAGE(PG8_SB(0, 0), b2, voffB); PG8_STAGE(PG8_SB(0, 1), b2 + hstep, voffB); PG8_STAGE(PG8_SA(0, 0), a2, voffA);
            PG8_WAIT_V(8); PG8_WAIT_L(0); PG8_BAR; PG8_MMA(1, 0, At, B0); PG8_MMA(1, 1, At, B1); PG8_BAR; PG8_SCHED;
            PG8_LDB(B0, 1, 0); PG8_LDB(B1, 1, 1); PG8_SCHED; PG8_LDA(At, 1, 0); PG8_STAGE(PG8_SA(0, 1), a2 + hstep, voffA);
            PG8_WAIT_V(8); PG8_WAIT_L(0); PG8_BAR; PG8_MMA(0, 0, At, B0); PG8_MMA(0, 1, At, B1); PG8_BAR; PG8_SCHED;
            PG8_LDA(At, 1, 1); PG8_STAGE(PG8_SB(1, 0), b3, voffB); PG8_STAGE(PG8_SB(1, 1), b3 + hstep, voffB); PG8_STAGE(PG8_SA(1, 0), a3, voffA);
            PG8_WAIT_V(8); PG8_WAIT_L(0); PG8_BAR; PG8_MMA(1, 0, At, B0); PG8_MMA(1, 1, At, B1); PG8_BAR; PG8_SCHED;
            } else {
            PG8_LDB(B0, 0, 0); PG8_SCHED; PG8_LDA(At, 0, 0); PG8_STAGE(PG8_SA(1, 1), a1 + hstep, voffA);
            PG8_WAIT_L(8); PG8_BAR; PG8_WAIT_L(0); PG8_MMA(0, 0, At, B0); PG8_BAR; PG8_SCHED;
            PG8_LDB(B1, 0, 1); PG8_STAGE(PG8_SB(0, 0), b2, voffB);
            PG8_BAR; PG8_WAIT_L(0); PG8_MMA(0, 1, At, B1); PG8_BAR;
            PG8_LDA(At, 0, 1); PG8_STAGE(PG8_SA(0, 0), a2, voffA);
            PG8_BAR; PG8_WAIT_L(0); PG8_MMA(1, 0, At, B0); PG8_BAR; PG8_SCHED;
            PG8_STAGE(PG8_SB(0, 1), b2 + hstep, voffB);
            PG8_WAIT_V(6); PG8_BAR; PG8_MMA(1, 1, At, B1); PG8_BAR;
            PG8_LDB(B0, 1, 0); PG8_SCHED; PG8_LDA(At, 1, 0); PG8_STAGE(PG8_SA(0, 1), a2 + hstep, voffA);
            PG8_WAIT_L(8); PG8_BAR; PG8_WAIT_L(0); PG8_MMA(0, 0, At, B0); PG8_BAR; PG8_SCHED;
            PG8_LDB(B1, 1, 1); PG8_STAGE(PG8_SB(1, 0), b3, voffB);
            PG8_BAR; PG8_WAIT_L(0); PG8_MMA(0, 1, At, B1); PG8_BAR;
            PG8_LDA(At, 1, 1); PG8_STAGE(PG8_SA(1, 0), a3, voffA);
            PG8_BAR; PG8_WAIT_L(0); PG8_MMA(1, 0, At, B0); PG8_BAR; PG8_SCHED;
            PG8_STAGE(PG8_SB(1, 1), b3 + hstep, voffB);
            PG8_WAIT_V(6); PG8_BAR; PG8_MMA(1, 1, At, B1); PG8_BAR;
            }
        }
        if constexpr (ALIGN_EPI) { if (wr == 0) PG8_BAR; }
        if constexpr (!Epi::AFTER_DRAIN) { E(acc, cur, wr, wc, fr, fq); S.done(cur); }
        if (!has_next) break;
#pragma unroll
        for (int a = 0; a < 2; ++a)
#pragma unroll
            for (int b = 0; b < 2; ++b)
#pragma unroll
                for (int m = 0; m < 4; ++m)
#pragma unroll
                    for (int n = 0; n < 2; ++n) acc[a][b][m][n] = (f32x4){0.f, 0.f, 0.f, 0.f};
        cur = nxt; cA = nA; cB = nB; ++ui;
        if constexpr (ALIGN_EPI) { if (wr == 1) PG8_BAR; }
    }
    PG8_WAIT_V(0);
    if constexpr (!ALIGN_EPI) { if (wr == 0) PG8_BAR; }
    PG8_BAR;
    if constexpr (Epi::AFTER_DRAIN) { E.fused(acc, cur, wr, wc, fr, fq, lds, wid, lane); S.done(cur); }
#undef PG8_SA
#undef PG8_SB
#undef PG8_STAGE
#undef PG8_LDA
#undef PG8_LDB
#undef PG8_MMA
#undef PG8_WAIT_V
#undef PG8_WAIT_L
#undef PG8_BAR
#undef PG8_SCHED
}
}

constexpr int BATCH = 2, SEQ = 4096, DM = 4096, M = BATCH * SEQ;
constexpr int QLORA = 1024, KVLORA = 512, NH = 32, DQK = 192, DNOPE = 128, DROPE = 64, DV = 128;
constexpr int N1 = 1792;
constexpr int QW = NH * DQK;
constexpr int DFF = 11008, DFF2 = 22016;
constexpr int SWH = 64, SWKV = 8, SWD = 64, WIN = 128, QK1W = 4096 + 512;
constexpr float EPS = 1e-6f;
constexpr float LOG2E = 1.4426950408889634f;
constexpr float QS0 = (float)(0.07216878364870322 * 1.4426950408889634);
constexpr float QS1 = (float)(0.125 * 1.4426950408889634);
constexpr int NWAVES = 8;

constexpr size_t MiB = 1u << 20;
constexpr size_t WS_CTL = 0, CTL_ZERO_BYTES = 1 * MiB;
constexpr size_t WS_CS    = 2 * MiB;
constexpr size_t WS_W1T   = 8 * MiB;
constexpr size_t WS_WUQT  = WS_W1T   + (size_t)N1 * DM * 2;
constexpr size_t WS_WKNT  = WS_WUQT  + (size_t)QW * QLORA * 2;
constexpr size_t WS_WVT   = WS_WKNT  + (size_t)4096 * KVLORA * 2;
constexpr size_t WS_WO0T  = WS_WVT   + (size_t)4096 * KVLORA * 2;
constexpr size_t WS_WIN0T = WS_WO0T  + (size_t)DM * DM * 2;
constexpr size_t WS_WOUT0T= WS_WIN0T + (size_t)DFF2 * DM * 2;
constexpr size_t WS_WQK1T = WS_WOUT0T+ (size_t)DM * DFF * 2;
constexpr size_t WS_WV1T  = WS_WQK1T + (size_t)QK1W * DM * 2;
constexpr size_t WS_WO1T  = WS_WV1T  + (size_t)512 * DM * 2;
constexpr size_t WS_WIN1T = WS_WO1T  + (size_t)DM * DM * 2;
constexpr size_t WS_WOUT1T= WS_WIN1T + (size_t)DFF2 * DM * 2;
constexpr size_t WS_XN    = WS_WOUT1T+ (size_t)DM * DFF * 2;
constexpr size_t WS_CQKV  = WS_XN    + (size_t)M * DM * 2;
constexpr size_t WS_CQN   = WS_CQKV  + (size_t)M * N1 * 4;
constexpr size_t WS_CKV   = WS_CQN   + (size_t)M * QLORA * 2;
constexpr size_t WS_QF    = WS_CKV   + (size_t)M * KVLORA * 2;
constexpr size_t WS_Q     = WS_QF    + (size_t)M * QW * 4;
constexpr size_t WS_K     = WS_Q     + (size_t)M * QW * 2;
constexpr size_t WS_VT    = WS_K     + (size_t)M * QW * 2;
constexpr size_t WS_O     = WS_VT    + (size_t)4096 * M * 2;
constexpr size_t WS_AF    = WS_O     + (size_t)M * DM * 2;
constexpr size_t WS_U     = WS_AF    + (size_t)M * DM * 4;
constexpr size_t WS_ACT   = WS_U     + (size_t)M * DFF2 * 2;
constexpr size_t WS_QK1   = WS_ACT   + (size_t)M * DFF * 2;
constexpr size_t WS_VT1   = WS_QK1   + (size_t)M * QK1W * 2;
constexpr size_t WS_END   = WS_VT1   + (size_t)512 * M * 2;
constexpr int CW_BAR = 4096;

constexpr int RING_OFF = 0, RING_BYTES = 131072;
constexpr int LDSCTL_OFF = RING_BYTES, MISC_OFF = LDSCTL_OFF + 320;
constexpr int LDS_BYTES = 147456;
#define GAS __attribute__((address_space(1)))
#define LAS __attribute__((address_space(3)))
typedef unsigned short bf16;
typedef unsigned v4u __attribute__((ext_vector_type(4)));
typedef float f32x4 __attribute__((ext_vector_type(4)));
typedef short bf16x8 __attribute__((ext_vector_type(8)));
typedef GAS unsigned gu32;
typedef GAS unsigned long long gu64;
#define RLX_AGENT __ATOMIC_RELAXED, __HIP_MEMORY_SCOPE_AGENT
#define LDS_WAIT() asm volatile("s_waitcnt lgkmcnt(0)" ::: "memory")
#define VM_WAIT() asm volatile("s_waitcnt vmcnt(0)" ::: "memory")
__device__ __forceinline__ unsigned long long rt() { return __builtin_amdgcn_s_memrealtime(); }
__device__ __forceinline__ unsigned f2bf(float f) { unsigned u = __builtin_bit_cast(unsigned, f); return (u + 0x7fffu + ((u >> 16) & 1u)) >> 16; }
__device__ __forceinline__ unsigned pk2(float lo, float hi) { return f2bf(lo) | (f2bf(hi) << 16); }

#define XB_TMO      128
#define XB_XCNT(j)  (256  + 64 * (j))
#define XB_XSUB(j)  (1280 + 64 * (j))
#define XB_XGEN(j)  (2304 + 64 * (j))
#define XB_TOP      3328
#define XB_TOPGEN   3392
#define XCD_BAR_WORDS 3456
#define XB_SPIN_CAP (1u << 18)

__device__ __forceinline__ unsigned xb_ld(unsigned* p)              { return __hip_atomic_load(p, __ATOMIC_RELAXED, __HIP_MEMORY_SCOPE_AGENT); }
__device__ __forceinline__ unsigned xb_add(unsigned* p, unsigned v) { return __hip_atomic_fetch_add(p, v, __ATOMIC_RELAXED, __HIP_MEMORY_SCOPE_AGENT); }
__device__ __forceinline__ unsigned xb_xcc_id() { return (unsigned)__builtin_amdgcn_s_getreg((3 << 11) | 20) & 0xFu; }
#define XB_SPIN(cond, bar) do { unsigned _sp = 0; while (cond) { __builtin_amdgcn_s_sleep(1); \
    if ((++_sp & 255u) == 0u) { if (xb_ld(&(bar)[XB_TMO])) break; if (_sp > XB_SPIN_CAP) { atomicAdd(&(bar)[XB_TMO], 1u); break; } } } } while (0)

struct XcdBarrier {
    unsigned* bar; unsigned x;
    volatile LAS unsigned* st;
};

__device__ __forceinline__ XcdBarrier xcd_barrier_post(unsigned* bar, volatile LAS unsigned* st) {
    XcdBarrier b; b.bar = bar; b.x = xb_xcc_id(); b.st = st;
    if (threadIdx.x == 0) (void)xb_add(&bar[XB_XCNT(b.x)], 1u);
    return b;
}
__device__ __forceinline__ void xcd_barrier_complete(unsigned* bar, unsigned x, unsigned& nloc, unsigned& nx) {
    const unsigned G = gridDim.x * gridDim.y * gridDim.z;
    unsigned sum, cnt, mine, sp = 0u;
    for (;;) {
        sum = 0u; cnt = 0u; mine = 0u;
#pragma unroll
        for (unsigned j = 0; j < 16; ++j) { const unsigned c = xb_ld(&bar[XB_XCNT(j)]); sum += c; cnt += (c > 0u) ? 1u : 0u; mine = (j == x) ? c : mine; }
        if (sum == G) break;
        __builtin_amdgcn_s_sleep(1);
        if ((++sp & 255u) == 0u) { if (xb_ld(&bar[XB_TMO])) break; if (sp > XB_SPIN_CAP) { atomicAdd(&bar[XB_TMO], 1u); break; } }
    }
    nloc = mine > 0u ? mine : 1u; nx = cnt > 0u ? cnt : 1u;
}

__device__ __forceinline__ void xcd_barrier(const XcdBarrier& b) {
    asm volatile("s_waitcnt vmcnt(0)" ::: "memory");
    __syncthreads();
    if (threadIdx.x == 0) {
        unsigned* bar = b.bar;
        __builtin_amdgcn_s_waitcnt(0);
        unsigned nloc = b.st[0], nx = b.st[1];
        if (nloc == 0u) { xcd_barrier_complete(bar, b.x, nloc, nx); b.st[0] = nloc; b.st[1] = nx; }
        const unsigned old = xb_add(&bar[XB_XSUB(b.x)], 1u);
        const unsigned gen = old / nloc;
        if (old + 1u == (gen + 1u) * nloc) {
            __builtin_amdgcn_fence(__ATOMIC_RELEASE, "agent");
            asm volatile("s_waitcnt vmcnt(0)" ::: "memory");
            const unsigned og = xb_add(&bar[XB_TOP], 1u);
            const unsigned tg = og / nx;
            if (og + 1u == (tg + 1u) * nx) xb_add(&bar[XB_TOPGEN], 1u);
            else XB_SPIN(xb_ld(&bar[XB_TOPGEN]) == tg, bar);
            __builtin_amdgcn_fence(__ATOMIC_ACQUIRE, "agent");
            xb_add(&bar[XB_XGEN(b.x)], 1u);
            asm volatile("s_waitcnt vmcnt(0)" ::: "memory");
        } else {
            XB_SPIN(xb_ld(&bar[XB_XGEN(b.x)]) == gen, bar);
            __builtin_amdgcn_fence(__ATOMIC_ACQUIRE, "agent");
            asm volatile("s_waitcnt vmcnt(0)" ::: "memory");
        }
    }
    __syncthreads();
}

typedef float f32x16 __attribute__((ext_vector_type(16)));
typedef float f32x2v __attribute__((ext_vector_type(2)));
typedef unsigned u32x2v __attribute__((ext_vector_type(2)));
__device__ __forceinline__ unsigned cvtpk(float lo, float hi) { unsigned r; asm volatile("v_cvt_pk_bf16_f32 %0, %1, %2" : "=v"(r) : "v"(lo), "v"(hi)); return r; }
#define PACK8(P, B) __builtin_bit_cast(bf16x8, (v4u){cvtpk(P[(B) + 0], P[(B) + 1]), cvtpk(P[(B) + 2], P[(B) + 3]), cvtpk(P[(B) + 4], P[(B) + 5]), cvtpk(P[(B) + 6], P[(B) + 7])})
__device__ __forceinline__ float wave_sum(float v) {
#pragma unroll
    for (int o = 1; o < 64; o <<= 1) v += __shfl_xor(v, o);
    return v;
}
__device__ __forceinline__ int pi32(int m) { return (m & ~0xC) | ((m & 4) << 1) | ((m & 8) >> 1); }
__constant__ float kFreq[32] = {
    1.000000000e+00f, 7.498942614e-01f, 5.623413324e-01f, 4.216965139e-01f, 3.162277639e-01f, 2.371373773e-01f, 1.778279394e-01f, 1.333521307e-01f,
    1.000000015e-01f, 7.498941571e-02f, 5.623413250e-02f, 4.216965288e-02f, 3.162277490e-02f, 2.371373773e-02f, 1.778279431e-02f, 1.333521493e-02f,
    9.999999776e-03f, 7.498941850e-03f, 5.623413250e-03f, 4.216964822e-03f, 3.162277630e-03f, 2.371373586e-03f, 1.778279431e-03f, 1.333521446e-03f,
    1.000000047e-03f, 7.498942432e-04f, 5.623413017e-04f, 4.216965172e-04f, 3.162277571e-04f, 2.371373703e-04f, 1.778279402e-04f, 1.333521504e-04f};

struct Ctx { LAS unsigned char* lds; int tid, lane, wave, vcu, G; };

struct WJob { const float* W; const float* gain; bf16* WT; int ldw, K, ncols, col0, gs, gsrc, drow0, item0; };
constexpr int NJOBS = 14;
__device__ __forceinline__ void wt_item(const float* W, const float* gain, bf16* WT, int ldw, int K, int ncols, int col0, int gs, int gsrc, int drow0, LAS float* scr, int item, int lane) {
    const int nblk = ncols / 32, kb = item / nblk, nb = item - kb * nblk, k0 = 64 * kb, n0 = 32 * nb;
    const int grp = n0 / gs, sc0 = col0 + grp * gsrc + (n0 - grp * gs);
    const float* src = W + (size_t)k0 * ldw + sc0 + (lane & 31);
#pragma unroll 8
    for (int i = 0; i < 32; ++i) { const int kk = 2 * i + (lane >> 5); float w = src[(size_t)kk * ldw]; if (gain) w *= gain[k0 + kk]; scr[kk * 33 + (lane & 31)] = w; }
    LDS_WAIT(); asm volatile("" ::: "memory");
    const int c = lane & 7;
#pragma unroll
    for (int j = 0; j < 4; ++j) { const int n = (lane >> 3) + 8 * j; const LAS float* s = scr + (8 * c) * 33 + n;
        v4u o; o.x = cvtpk(s[0 * 33], s[1 * 33]); o.y = cvtpk(s[2 * 33], s[3 * 33]); o.z = cvtpk(s[4 * 33], s[5 * 33]); o.w = cvtpk(s[6 * 33], s[7 * 33]);
        *(GAS v4u*)(WT + (size_t)(drow0 + n0 + n) * K + k0 + 8 * c) = o; }
    LDS_WAIT(); asm volatile("" ::: "memory");
}
__device__ __forceinline__ void sincos_d(float angf, float& s, float& c) {
    const double x = (double)angf;
    const double kd = __builtin_rint(x * 0.63661977236758134308);
    double r = __builtin_fma(-kd, 1.57079632679489655800e+00, x);
    r = __builtin_fma(-kd, 6.12323399573676603587e-17, r);
    const int k = (int)kd;
    const double r2 = r * r;
    double sp = 1.0 / 6227020800.0;
    sp = sp * r2 - 1.0 / 39916800.0; sp = sp * r2 + 1.0 / 362880.0; sp = sp * r2 - 1.0 / 5040.0; sp = sp * r2 + 1.0 / 120.0; sp = sp * r2 - 1.0 / 6.0; sp = sp * r2 + 1.0; sp = sp * r;
    double cp = -1.0 / 87178291200.0;
    cp = cp * r2 + 1.0 / 479001600.0; cp = cp * r2 - 1.0 / 3628800.0; cp = cp * r2 + 1.0 / 40320.0; cp = cp * r2 - 1.0 / 720.0; cp = cp * r2 + 1.0 / 24.0; cp = cp * r2 - 0.5; cp = cp * r2 + 1.0;
    const int q = k & 3;
    const double ss = (q == 0) ? sp : (q == 1) ? cp : (q == 2) ? -sp : -cp;
    const double cc = (q == 0) ? cp : (q == 1) ? -sp : (q == 2) ? -cp : sp;
    s = (float)ss; c = (float)cc;
}

template <int MODE>
__device__ __forceinline__ void rows_phase(const Ctx& F, const float* src, const float* Hin, const float* g, float* Hout, bf16* XN) {
    const int gw = F.vcu * NWAVES + F.wave, NGW = F.G * NWAVES;
    for (int m = gw; m < M; m += NGW) {
        const GAS f32x4* a = (const GAS f32x4*)(src + (size_t)m * DM) + F.lane;
        f32x4 v[16]; float ss = 0.f;
#pragma unroll
        for (int j = 0; j < 16; ++j) { v[j] = a[64 * j]; ss += (v[j].x * v[j].x + v[j].y * v[j].y) + (v[j].z * v[j].z + v[j].w * v[j].w); }
        const float rstd = 1.0f / sqrtf(wave_sum(ss) * (1.0f / DM) + EPS);
        if (MODE == 0) {
            GAS unsigned long long* o8 = (GAS unsigned long long*)(XN + (size_t)m * DM) + F.lane;
#pragma unroll
            for (int j = 0; j < 16; ++j) o8[64 * j] = (unsigned long long)cvtpk(v[j].x * rstd, v[j].y * rstd) | ((unsigned long long)cvtpk(v[j].z * rstd, v[j].w * rstd) << 32);
        } else {
            const GAS f32x4* hp = (const GAS f32x4*)(Hin + (size_t)m * DM) + F.lane;
            const GAS f32x4* gp = (const GAS f32x4*)g + F.lane;
            GAS f32x4* op = (GAS f32x4*)(Hout + (size_t)m * DM) + F.lane;
            float s2 = 0.f;
#pragma unroll
            for (int j = 0; j < 16; ++j) { const f32x4 hv = hp[64 * j], gv = gp[64 * j]; const f32x4 o = hv + (v[j] * rstd) * gv; op[64 * j] = o; v[j] = o;
                s2 += (o.x * o.x + o.y * o.y) + (o.z * o.z + o.w * o.w); }
            if (MODE == 1) {
                const float rstd2 = 1.0f / sqrtf(wave_sum(s2) * (1.0f / DM) + EPS);
                GAS unsigned long long* o8 = (GAS unsigned long long*)(XN + (size_t)m * DM) + F.lane;
#pragma unroll
                for (int j = 0; j < 16; ++j) o8[64 * j] = (unsigned long long)cvtpk(v[j].x * rstd2, v[j].y * rstd2) | ((unsigned long long)cvtpk(v[j].z * rstd2, v[j].w * rstd2) << 32);
            }
        }
    }
}
__device__ __forceinline__ void latent_rows_phase(const Ctx& F, const float* CQKV, const float* CS, bf16* CQN, bf16* CKV, bf16* K) {
    const int gw = F.vcu * NWAVES + F.wave, NGW = F.G * NWAVES, lane = F.lane, l32 = lane & 31;
    for (int m = gw; m < M; m += NGW) {
        const float* row = CQKV + (size_t)m * N1;
        { const GAS f32x4* a = (const GAS f32x4*)row + lane; f32x4 v[4]; float ss = 0.f;
#pragma unroll
          for (int j = 0; j < 4; ++j) { v[j] = a[64 * j]; ss += (v[j].x * v[j].x + v[j].y * v[j].y) + (v[j].z * v[j].z + v[j].w * v[j].w); }
          const float rstd = 1.0f / sqrtf(wave_sum(ss) * (1.0f / QLORA) + EPS);
          GAS unsigned long long* o8 = (GAS unsigned long long*)(CQN + (size_t)m * QLORA) + lane;
#pragma unroll
          for (int j = 0; j < 4; ++j) o8[64 * j] = (unsigned long long)cvtpk(v[j].x * rstd, v[j].y * rstd) | ((unsigned long long)cvtpk(v[j].z * rstd, v[j].w * rstd) << 32); }
        { const GAS f32x4* a = (const GAS f32x4*)(row + QLORA) + lane; f32x4 v[2]; float ss = 0.f;
#pragma unroll
          for (int j = 0; j < 2; ++j) { v[j] = a[64 * j]; ss += (v[j].x * v[j].x + v[j].y * v[j].y) + (v[j].z * v[j].z + v[j].w * v[j].w); }
          const float rstd = 1.0f / sqrtf(wave_sum(ss) * (1.0f / KVLORA) + EPS);
          GAS unsigned long long* o8 = (GAS unsigned long long*)(CKV + (size_t)m * KVLORA) + lane;
#pragma unroll
          for (int j = 0; j < 2; ++j) o8[64 * j] = (unsigned long long)cvtpk(v[j].x * rstd, v[j].y * rstd) | ((unsigned long long)cvtpk(v[j].z * rstd, v[j].w * rstd) << 32); }
        { const float x1 = row[QLORA + KVLORA + l32], x2 = row[QLORA + KVLORA + 32 + l32];
          const float co = CS[(size_t)m * 64 + l32], si = CS[(size_t)m * 64 + 32 + l32];
          const float o1 = x1 * co - x2 * si, o2 = x2 * co + x1 * si;
          const int a = (2 * l32) & 31, which = l32 >> 4;
          const float a0 = __shfl(o1, a), a1 = __shfl(o1, a + 1), b0 = __shfl(o2, a), b1 = __shfl(o2, a + 1);
          const unsigned w = cvtpk(which ? b0 : a0, which ? b1 : a1);
          GAS unsigned* kd = (GAS unsigned*)(K + (size_t)m * QW + DNOPE) + l32;
#pragma unroll
          for (int it = 0; it < 16; ++it) { const int head = 2 * it + (lane >> 5); kd[head * (DQK / 2)] = w; } }
    }
}
__device__ __forceinline__ void q_rope_phase(const Ctx& F, const float* QF, const float* CS, bf16* Q) {
    const int gw = F.vcu * NWAVES + F.wave, NGW = F.G * NWAVES, lane = F.lane, l32 = lane & 31;
    for (int m = gw; m < M; m += NGW) {
        const float* qrow = QF + (size_t)m * QW; bf16* qo = Q + (size_t)m * QW;
        const float co = CS[(size_t)m * 64 + l32], si = CS[(size_t)m * 64 + 32 + l32];
        const int a = (2 * l32) & 31, which = l32 >> 4;
#pragma unroll 4
        for (int h = 0; h < NH; ++h) {
            const int base = h * DQK;
            const f32x2v nv = *(const GAS f32x2v*)(qrow + base + 2 * lane);
            *(GAS unsigned*)(qo + base + 2 * lane) = cvtpk(nv.x * QS0, nv.y * QS0);
            const float x1 = qrow[base + DNOPE + l32], x2 = qrow[base + DNOPE + 32 + l32];
            const float o1 = (x1 * co - x2 * si) * QS0, o2 = (x2 * co + x1 * si) * QS0;
            const float a0 = __shfl(o1, a), a1 = __shfl(o1, a + 1), b0 = __shfl(o2, a), b1 = __shfl(o2, a + 1);
            const unsigned w = cvtpk(which ? b0 : a0, which ? b1 : a1);
            if (lane < 32) *(GAS unsigned*)(qo + base + DNOPE + 2 * lane) = w;
        }
    }
}
__device__ __forceinline__ void conv_act_phase(const Ctx& F, const bf16* U, const float* cw, const float* cb, bf16* ACT) {
    constexpr int NCC = DFF / 8, NRC = M / 32;
    const int gt = F.vcu * (NWAVES * 64) + F.tid, NT = F.G * NWAVES * 64;
    for (int task = gt; task < NCC * NRC; task += NT) {
        const int rc = task / NCC, cc = task - rc * NCC, j0 = 8 * cc, m0 = 32 * rc;
        float wg[3][8], wv[3][8], bg[8], bv[8];
#pragma unroll
        for (int t = 0; t < 3; ++t)
#pragma unroll
            for (int e = 0; e < 2; ++e) { const f32x4 x = *(const GAS f32x4*)(cw + (size_t)t * DFF2 + j0 + 4 * e), y = *(const GAS f32x4*)(cw + (size_t)t * DFF2 + DFF + j0 + 4 * e);
                wg[t][4 * e] = x.x; wg[t][4 * e + 1] = x.y; wg[t][4 * e + 2] = x.z; wg[t][4 * e + 3] = x.w; wv[t][4 * e] = y.x; wv[t][4 * e + 1] = y.y; wv[t][4 * e + 2] = y.z; wv[t][4 * e + 3] = y.w; }
#pragma unroll
        for (int e = 0; e < 2; ++e) { const f32x4 x = *(const GAS f32x4*)(cb + j0 + 4 * e), y = *(const GAS f32x4*)(cb + DFF + j0 + 4 * e);
            bg[4 * e] = x.x; bg[4 * e + 1] = x.y; bg[4 * e + 2] = x.z; bg[4 * e + 3] = x.w; bv[4 * e] = y.x; bv[4 * e + 1] = y.y; bv[4 * e + 2] = y.z; bv[4 * e + 3] = y.w; }
        float g2[8], g1[8], v2[8], v1[8];
        const bool has_prev = (m0 % SEQ) != 0;
#define UNPK(dst, w4) do { dst[0] = __uint_as_float((w4).x << 16); dst[1] = __uint_as_float((w4).x & 0xffff0000u); dst[2] = __uint_as_float((w4).y << 16); dst[3] = __uint_as_float((w4).y & 0xffff0000u); \
                           dst[4] = __uint_as_float((w4).z << 16); dst[5] = __uint_as_float((w4).z & 0xffff0000u); dst[6] = __uint_as_float((w4).w << 16); dst[7] = __uint_as_float((w4).w & 0xffff0000u); } while (0)
        if (has_prev) { const v4u a = *(const GAS v4u*)(U + (size_t)(m0 - 2) * DFF2 + j0), b = *(const GAS v4u*)(U + (size_t)(m0 - 1) * DFF2 + j0);
                        const v4u c = *(const GAS v4u*)(U + (size_t)(m0 - 2) * DFF2 + DFF + j0), d = *(const GAS v4u*)(U + (size_t)(m0 - 1) * DFF2 + DFF + j0);
                        UNPK(g2, a); UNPK(g1, b); UNPK(v2, c); UNPK(v1, d); }
        else {
#pragma unroll
            for (int e = 0; e < 8; ++e) { g2[e] = 0.f; g1[e] = 0.f; v2[e] = 0.f; v1[e] = 0.f; } }
#pragma unroll 2
        for (int r = 0; r < 32; ++r) {
            const v4u a = *(const GAS v4u*)(U + (size_t)(m0 + r) * DFF2 + j0), c = *(const GAS v4u*)(U + (size_t)(m0 + r) * DFF2 + DFF + j0);
            float g0[8], v0[8], o[8]; UNPK(g0, a); UNPK(v0, c);
#pragma unroll
            for (int e = 0; e < 8; ++e) { const float gg = bg[e] + wg[0][e] * g2[e] + wg[1][e] * g1[e] + wg[2][e] * g0[e], vv = bv[e] + wv[0][e] * v2[e] + wv[1][e] * v1[e] + wv[2][e] * v0[e];
                o[e] = gg * __builtin_amdgcn_rcpf(1.0f + __builtin_amdgcn_exp2f(-gg * LOG2E)) * vv; g2[e] = g1[e]; g1[e] = g0[e]; v2[e] = v1[e]; v1[e] = v0[e]; }
            v4u w; w.x = cvtpk(o[0], o[1]); w.y = cvtpk(o[2], o[3]); w.z = cvtpk(o[4], o[5]); w.w = cvtpk(o[6], o[7]);
            *(GAS v4u*)(ACT + (size_t)(m0 + r) * DFF + j0) = w;
        }
#undef UNPK
    }
}

constexpr int MLA_KB = 64 * 400, MLA_VB = 128 * 144, MLA_V0 = 2 * MLA_KB;
__device__ __forceinline__ void mla_unit(LAS unsigned char* lds, const bf16* __restrict__ Q, const bf16* __restrict__ K, const bf16* __restrict__ VT, bf16* __restrict__ O, int b, int h, int qb) {
    const int tid = threadIdx.x, lane = tid & 63, wid = __builtin_amdgcn_readfirstlane(tid >> 6), l32 = lane & 31, hi = lane >> 5;
    const int NT = 4 * (qb + 1), rowb = b * SEQ;
    unsigned kgo[3], klo[3], vgo[2], vlo[2];
#pragma unroll
    for (int i = 0; i < 3; ++i) { const int idx = tid + 512 * i, row = idx / 24, c = idx - row * 24; kgo[i] = (unsigned)(((rowb + row) * QW + h * DQK + 8 * c) * 2); klo[i] = (unsigned)(row * 400 + 16 * c); }
#pragma unroll
    for (int i = 0; i < 2; ++i) { const int idx = tid + 512 * i, d = idx >> 3, c = idx & 7; vgo[i] = (unsigned)(((h * DV + d) * M + rowb + 8 * c) * 2); vlo[i] = (unsigned)(d * 144 + 16 * c); }
    const char* Kb = (const char*)K; const char* Vb = (const char*)VT;
    const int qrow = rowb + 256 * qb + 32 * wid + l32;
    bf16x8 qr[12];
#pragma unroll
    for (int d0 = 0; d0 < 12; ++d0) qr[d0] = *(const GAS bf16x8*)(Q + (size_t)qrow * QW + h * DQK + 16 * d0 + 8 * hi);
    v4u sk[3], sv[2];
#pragma unroll
    for (int i = 0; i < 3; ++i) sk[i] = *(const GAS v4u*)(Kb + kgo[i]);
#pragma unroll
    for (int i = 0; i < 2; ++i) sv[i] = *(const GAS v4u*)(Vb + vgo[i]);
#pragma unroll
    for (int i = 0; i < 3; ++i) *(LAS v4u*)(lds + klo[i]) = sk[i];
#pragma unroll
    for (int i = 0; i < 2; ++i) *(LAS v4u*)(lds + MLA_V0 + vlo[i]) = sv[i];
    __syncthreads();
    float m_run = -1e30f, lsum = 0.f;
    f32x16 o[4];
#pragma unroll
    for (int d = 0; d < 4; ++d)
#pragma unroll
        for (int r = 0; r < 16; ++r) o[d][r] = 0.f;
    const int kfb = pi32(l32) * 400 + 16 * hi, vfb = l32 * 144 + 16 * hi;
    const int qpos = 256 * qb + 32 * wid + l32;
    for (int t = 0; t < NT; ++t) {
        const int bs = t & 1; const bool more = (t + 1) < NT;
        if (more) { const unsigned ko = (unsigned)(t + 1) * (unsigned)(64 * QW * 2), vo = (unsigned)(t + 1) * 128u;
#pragma unroll
            for (int i = 0; i < 3; ++i) sk[i] = *(const GAS v4u*)(Kb + (kgo[i] + ko));
#pragma unroll
            for (int i = 0; i < 2; ++i) sv[i] = *(const GAS v4u*)(Vb + (vgo[i] + vo)); }
        const bool active = 64 * t <= 256 * qb + 32 * wid + 31;
        if (active) {
            const LAS unsigned char* kp = lds + bs * MLA_KB + kfb;
            const LAS unsigned char* vp = lds + MLA_V0 + bs * MLA_VB + vfb;
            f32x16 p0, p1;
#pragma unroll
            for (int r = 0; r < 16; ++r) { p0[r] = 0.f; p1[r] = 0.f; }
#pragma unroll
            for (int d0 = 0; d0 < 12; ++d0) {
                const bf16x8 k0 = *(const LAS bf16x8*)(kp + 32 * d0), k1 = *(const LAS bf16x8*)(kp + 32 * 400 + 32 * d0);
                p0 = __builtin_amdgcn_mfma_f32_32x32x16_bf16(k0, qr[d0], p0, 0, 0, 0);
                p1 = __builtin_amdgcn_mfma_f32_32x32x16_bf16(k1, qr[d0], p1, 0, 0, 0);
            }
            if (64 * t + 63 > 256 * qb + 32 * wid) {
                const int kb0 = 64 * t + 8 * hi;
#pragma unroll
                for (int r = 0; r < 16; ++r) { const int key = kb0 + 16 * (r >> 3) + (r & 7);
                    if (key > qpos) p0[r] = -__builtin_inff(); if (key + 32 > qpos) p1[r] = -__builtin_inff(); }
            }
            float mx = p0[0];
#pragma unroll
            for (int r = 1; r < 16; ++r) mx = fmaxf(mx, p0[r]);
#pragma unroll
            for (int r = 0; r < 16; ++r) mx = fmaxf(mx, p1[r]);
            mx = fmaxf(mx, __shfl_xor(mx, 32));
            const float m_new = fmaxf(m_run, mx);
            const float alpha = __builtin_amdgcn_exp2f(m_run - m_new);
            m_run = m_new;
            float ps = 0.f;
#pragma unroll
            for (int r = 0; r < 16; ++r) { p0[r] = __builtin_amdgcn_exp2f(p0[r] - m_new); p1[r] = __builtin_amdgcn_exp2f(p1[r] - m_new); ps += p0[r] + p1[r]; }
            lsum = lsum * alpha + ps;
#pragma unroll
            for (int d = 0; d < 4; ++d)
#pragma unroll
                for (int r = 0; r < 16; ++r) o[d][r] *= alpha;
            const bf16x8 pb0 = PACK8(p0, 0), pb1 = PACK8(p0, 8), pb2 = PACK8(p1, 0), pb3 = PACK8(p1, 8);
#pragma unroll
            for (int d = 0; d < 4; ++d) {
                const bf16x8 v0 = *(const LAS bf16x8*)(vp + d * 32 * 144 + 0), v1 = *(const LAS bf16x8*)(vp + d * 32 * 144 + 32);
                const bf16x8 v2 = *(const LAS bf16x8*)(vp + d * 32 * 144 + 64), v3 = *(const LAS bf16x8*)(vp + d * 32 * 144 + 96);
                o[d] = __builtin_amdgcn_mfma_f32_32x32x16_bf16(v0, pb0, o[d], 0, 0, 0);
                o[d] = __builtin_amdgcn_mfma_f32_32x32x16_bf16(v1, pb1, o[d], 0, 0, 0);
                o[d] = __builtin_amdgcn_mfma_f32_32x32x16_bf16(v2, pb2, o[d], 0, 0, 0);
                o[d] = __builtin_amdgcn_mfma_f32_32x32x16_bf16(v3, pb3, o[d], 0, 0, 0);
            }
        }
        if (more) { const int nb = bs ^ 1;
#pragma unroll
            for (int i = 0; i < 3; ++i) *(LAS v4u*)(lds + nb * MLA_KB + klo[i]) = sk[i];
#pragma unroll
            for (int i = 0; i < 2; ++i) *(LAS v4u*)(lds + MLA_V0 + nb * MLA_VB + vlo[i]) = sv[i]; }
        __syncthreads();
    }
    const float ltot = lsum + __shfl_xor(lsum, 32);
    const float inv = 1.0f / ltot;
    bf16* orow = O + (size_t)qrow * DM + h * DV + 4 * hi;
#pragma unroll
    for (int d = 0; d < 4; ++d)
#pragma unroll
        for (int a = 0; a < 4; ++a) { u32x2v w; w.x = cvtpk(o[d][4 * a] * inv, o[d][4 * a + 1] * inv); w.y = cvtpk(o[d][4 * a + 2] * inv, o[d][4 * a + 3] * inv);
            *(GAS u32x2v*)(orow + 32 * d + 8 * a) = w; }
}
__device__ __forceinline__ void mla_attn_phase(const Ctx& F, const bf16* Q, const bf16* K, const bf16* VT, bf16* O) {
    for (int L = F.vcu; L < BATCH * NH * 8; L += F.G) {
        const int bh = L >> 3, p = L & 7;
        mla_unit(F.lds, Q, K, VT, O, bh / NH, bh % NH, 15 - p);
        mla_unit(F.lds, Q, K, VT, O, bh / NH, bh % NH, p);
    }
}

constexpr int SWA_KBYTES = 256 * 144, SWA_VROW = 528;
__device__ __forceinline__ void swa_unit(LAS unsigned char* lds, const bf16* __restrict__ QK, const bf16* __restrict__ VT, bf16* __restrict__ O, const float* __restrict__ sinks, int b, int g, int n) {
    const int tid = threadIdx.x, lane = tid & 63, wid = __builtin_amdgcn_readfirstlane(tid >> 6), l32 = lane & 31, hi = lane >> 5;
    const int rowb = b * SEQ, kv0 = rowb + WIN * (n - 1);
#pragma unroll
    for (int i = 0; i < 4; ++i) { const int idx = tid + 512 * i, kk = idx >> 3, c = idx & 7; v4u v = (v4u){0u, 0u, 0u, 0u};
        if (n > 0 || kk >= WIN) v = *(const GAS v4u*)(QK + (size_t)(kv0 + kk) * QK1W + 4096 + g * SWD + 8 * c);
        *(LAS v4u*)(lds + kk * 144 + 16 * c) = v; }
#pragma unroll
    for (int i = 0; i < 4; ++i) { const int idx = tid + 512 * i, d = idx >> 5, c = idx & 31; v4u v = (v4u){0u, 0u, 0u, 0u};
        if (n > 0 || c >= 16) v = *(const GAS v4u*)(VT + (size_t)(g * SWD + d) * M + kv0 + 8 * c);
        *(LAS v4u*)(lds + SWA_KBYTES + d * SWA_VROW + 16 * c) = v; }
    __syncthreads();
    const int hh = SWKV * g + wid;
    const float slope2 = exp2f(-(float)(hh + 1) * 0.125f) * LOG2E, sink2 = sinks[hh] * LOG2E;
#pragma unroll 1
    for (int j = 0; j < 4; ++j) {
        const int qrow = rowb + WIN * n + 32 * j + l32;
        bf16x8 qr[4];
#pragma unroll
        for (int d0 = 0; d0 < 4; ++d0) qr[d0] = *(const GAS bf16x8*)(QK + (size_t)qrow * QK1W + hh * SWD + 16 * d0 + 8 * hi);
        const LAS unsigned char* kp = lds + (32 * j + pi32(l32)) * 144 + 16 * hi;
        const LAS unsigned char* vp = lds + SWA_KBYTES + l32 * SWA_VROW + 64 * j + 16 * hi;
        const int qd = WIN + l32 - 8 * hi;
        float m_run = sink2, lsum = 0.f;
        f32x16 o[2];
#pragma unroll
        for (int d = 0; d < 2; ++d)
#pragma unroll
            for (int r = 0; r < 16; ++r) o[d][r] = 0.f;
#pragma unroll 1
        for (int i = 0; i < 5; ++i) {
            f32x16 p;
#pragma unroll
            for (int r = 0; r < 16; ++r) p[r] = 0.f;
#pragma unroll
            for (int d0 = 0; d0 < 4; ++d0) p = __builtin_amdgcn_mfma_f32_32x32x16_bf16(*(const LAS bf16x8*)(kp + i * 32 * 144 + 32 * d0), qr[d0], p, 0, 0, 0);
            float mx = -__builtin_inff();
#pragma unroll
            for (int r = 0; r < 16; ++r) { const int dist = qd - 32 * i - 16 * (r >> 3) - (r & 7), kk = 32 * (j + i) + 16 * (r >> 3) + 8 * hi + (r & 7);
                const bool valid = ((unsigned)dist < (unsigned)WIN) && (n > 0 || kk >= WIN);
                const float s = valid ? p[r] - slope2 * (float)dist : -__builtin_inff(); p[r] = s; mx = fmaxf(mx, s); }
            mx = fmaxf(mx, __shfl_xor(mx, 32));
            const float m_new = fmaxf(m_run, mx), alpha = __builtin_amdgcn_exp2f(m_run - m_new);
            m_run = m_new;
            float ps = 0.f;
#pragma unroll
            for (int r = 0; r < 16; ++r) { p[r] = __builtin_amdgcn_exp2f(p[r] - m_new); ps += p[r]; }
            lsum = lsum * alpha + ps;
#pragma unroll
            for (int d = 0; d < 2; ++d)
#pragma unroll
                for (int r = 0; r < 16; ++r) o[d][r] *= alpha;
            const bf16x8 pa = PACK8(p, 0), pb = PACK8(p, 8);
#pragma unroll
            for (int d = 0; d < 2; ++d) {
                o[d] = __builtin_amdgcn_mfma_f32_32x32x16_bf16(*(const LAS bf16x8*)(vp + d * 32 * SWA_VROW + 64 * i), pa, o[d], 0, 0, 0);
                o[d] = __builtin_amdgcn_mfma_f32_32x32x16_bf16(*(const LAS bf16x8*)(vp + d * 32 * SWA_VROW + 64 * i + 32), pb, o[d], 0, 0, 0);
            }
        }
        lsum += __shfl_xor(lsum, 32);
        lsum += __builtin_amdgcn_exp2f(sink2 - m_run);
        const float inv = 1.0f / lsum;
        bf16* orow = O + (size_t)qrow * DM + hh * SWD + 4 * hi;
#pragma unroll
        for (int d = 0; d < 2; ++d)
#pragma unroll
            for (int a = 0; a < 4; ++a) { u32x2v w; w.x = cvtpk(o[d][4 * a] * inv, o[d][4 * a + 1] * inv); w.y = cvtpk(o[d][4 * a + 2] * inv, o[d][4 * a + 3] * inv);
                *(GAS u32x2v*)(orow + 32 * d + 8 * a) = w; }
    }
    __syncthreads();
}
__device__ __forceinline__ void swa_attn_phase(const Ctx& F, const bf16* QK, const bf16* VT, bf16* O, const float* sinks) {
    constexpr int NB = SEQ / WIN;
    for (int L = F.vcu; L < BATCH * SWKV * NB; L += F.G) { const int n = L % NB, bg = L / NB; swa_unit(F.lds, QK, VT, O, sinks, bg / SWKV, bg % SWKV, n); }
}

struct Args { const float* in[23]; float* out; unsigned char* ws; WJob jobs[NJOBS]; int nitems, ph_lo, ph_hi, pad; };
constexpr int NPHASE = 20;

__global__ void __launch_bounds__(NWAVES * 64, 2) yoco_fwd(Args args) {
    extern __shared__ __attribute__((aligned(16))) unsigned char lds_raw[];
    Ctx F;
    F.lds = (LAS unsigned char*)lds_raw;
    volatile LAS unsigned* MISC = (volatile LAS unsigned*)(F.lds + MISC_OFF);
    F.tid = threadIdx.x; F.lane = F.tid & 63; F.wave = __builtin_amdgcn_readfirstlane(F.tid >> 6);
    F.G = gridDim.x; { const int bx = blockIdx.x; F.vcu = (F.G % 8 == 0) ? (bx % 8) * (F.G / 8) + bx / 8 : bx; }
    unsigned char* ws = args.ws;
    gu32* ctl = (gu32*)(ws + WS_CTL);
    for (int u = F.tid; u < (LDS_BYTES - LDSCTL_OFF) / 4; u += NWAVES * 64) ((LAS unsigned*)(F.lds + LDSCTL_OFF))[u] = 0u;
    __syncthreads();
    XcdBarrier bar = xcd_barrier_post((unsigned*)(ctl + CW_BAR), MISC + 8);
    const int lo = args.ph_lo, hi = args.ph_hi;
#ifndef PH_MASK
#define PH_MASK 0xFFFFFu
#endif
#define IN(k) ((((PH_MASK) >> (k)) & 1u) && lo <= (k) && (k) < hi)
#define SEAM(k) do { if (IN(k) && IN((k) + 1)) xcd_barrier(bar); } while (0)

    const float* x = args.in[0]; const int* pos = (const int*)args.in[1];
    const float* n_mix_post = args.in[3]; const float* n_ffn_post = args.in[5];
    const float* sinks = args.in[17]; const float* conv_w = args.in[20]; const float* conv_b = args.in[21];
    float* H = args.out;
    float* CS = (float*)(ws + WS_CS);
    bf16* W1T = (bf16*)(ws + WS_W1T); bf16* WUQT = (bf16*)(ws + WS_WUQT); bf16* WKNT = (bf16*)(ws + WS_WKNT); bf16* WVT = (bf16*)(ws + WS_WVT);
    bf16* WO0T = (bf16*)(ws + WS_WO0T); bf16* WIN0T = (bf16*)(ws + WS_WIN0T); bf16* WOUT0T = (bf16*)(ws + WS_WOUT0T);
    bf16* WQK1T = (bf16*)(ws + WS_WQK1T); bf16* WV1T = (bf16*)(ws + WS_WV1T); bf16* WO1T = (bf16*)(ws + WS_WO1T); bf16* WIN1T = (bf16*)(ws + WS_WIN1T); bf16* WOUT1T = (bf16*)(ws + WS_WOUT1T);
    bf16* XN = (bf16*)(ws + WS_XN); float* CQKV = (float*)(ws + WS_CQKV); bf16* CQN = (bf16*)(ws + WS_CQN); bf16* CKV = (bf16*)(ws + WS_CKV);
    float* QF = (float*)(ws + WS_QF); bf16* Q = (bf16*)(ws + WS_Q); bf16* K = (bf16*)(ws + WS_K); bf16* VT = (bf16*)(ws + WS_VT); bf16* O = (bf16*)(ws + WS_O);
    float* AF = (float*)(ws + WS_AF); bf16* U = (bf16*)(ws + WS_U); bf16* ACT = (bf16*)(ws + WS_ACT); bf16* QK1 = (bf16*)(ws + WS_QK1); bf16* VT1 = (bf16*)(ws + WS_VT1);
    LAS unsigned char* ring = F.lds + RING_OFF;
    const int cid = (int)blockIdx.x;
#define GEMM_F32(Ap, Bp, Mv, Nv, Kv, Cp, ldcv) do { pg8::Gemm g_{(const pg8::bf16_t*)(Ap), (const pg8::bf16_t*)(Bp), (Mv), (Nv), (Kv)}; pg8::StaticOrder S_; S_.init((Mv), (Nv), F.G, cid); \
        pg8::EpiF32 E_{(Cp), (ldcv)}; pg8::gemm_phase<pg8::EpiF32, pg8::StaticOrder, true, true>(ring, g_, S_, E_); } while (0)
#define GEMM_BF16(Ap, Bp, Mv, Nv, Kv, Op, ldcv, gsv, gstv, scv, s0v) do { pg8::Gemm g_{(const pg8::bf16_t*)(Ap), (const pg8::bf16_t*)(Bp), (Mv), (Nv), (Kv)}; pg8::StaticOrder S_; S_.init((Mv), (Nv), F.G, cid); \
        pg8::EpiBf16Map E_{(pg8::bf16_t*)(Op), (ldcv), (gsv), (gstv), (scv), (s0v)}; pg8::gemm_phase<pg8::EpiBf16Map, pg8::StaticOrder, true, true>(ring, g_, S_, E_); } while (0)

    if (IN(0)) {
        LAS float* scr = (LAS float*)(ring + F.wave * 16384);
        const int gw = F.vcu * NWAVES + F.wave, NGW = F.G * NWAVES;
        for (int it = gw; it < args.nitems; it += NGW) {
            int j = 0;
#pragma unroll
            for (int q = 1; q < NJOBS; ++q) j += (it >= args.jobs[q].item0) ? 1 : 0;
            const WJob& J = args.jobs[j];
            wt_item(J.W, J.gain, J.WT, J.ldw, J.K, J.ncols, J.col0, J.gs, J.gsrc, J.drow0, scr, it - J.item0, F.lane);
        }
        { const int gt = F.vcu * (NWAVES * 64) + F.tid, NT = F.G * NWAVES * 64;
          for (int idx = gt; idx < M * 32; idx += NT) { const int m = idx >> 5, i = idx & 31; float s, c; sincos_d((float)pos[m] * kFreq[i], s, c); CS[(size_t)m * 64 + i] = c; CS[(size_t)m * 64 + 32 + i] = s; } }
        rows_phase<0>(F, x, nullptr, nullptr, nullptr, XN);
    }
    SEAM(0);
    if (IN(1)) GEMM_F32(XN, W1T, M, N1, DM, CQKV, N1);
    SEAM(1);
    if (IN(2)) latent_rows_phase(F, CQKV, CS, CQN, CKV, K);
    SEAM(2);
    if (IN(3)) {
        GEMM_F32(CQN, WUQT, M, QW, QLORA, QF, QW);
        GEMM_BF16(CKV, WKNT, M, 4096, KVLORA, K, QW, DNOPE, DQK, 0, 1.f);
        GEMM_BF16(WVT, CKV, 4096, M, KVLORA, VT, M, 1 << 30, 0, 0, 1.f);
    }
    SEAM(3);
    if (IN(4)) q_rope_phase(F, QF, CS, Q);
    SEAM(4);
    if (IN(5)) mla_attn_phase(F, Q, K, VT, O);
    SEAM(5);
    if (IN(6)) GEMM_F32(O, WO0T, M, DM, DM, AF, DM);
    SEAM(6);
    if (IN(7)) rows_phase<1>(F, AF, x, n_mix_post, H, XN);
    SEAM(7);
    if (IN(8)) GEMM_BF16(XN, WIN0T, M, DFF2, DM, U, DFF2, 1 << 30, 0, 0, 1.f);
    SEAM(8);
    if (IN(9)) conv_act_phase(F, U, conv_w, conv_b, ACT);
    SEAM(9);
    if (IN(10)) GEMM_F32(ACT, WOUT0T, M, DM, DFF, AF, DM);
    SEAM(10);
    if (IN(11)) rows_phase<1>(F, AF, H, n_ffn_post, H, XN);
    SEAM(11);
    if (IN(12)) {
        GEMM_BF16(XN, WQK1T, M, QK1W, DM, QK1, QK1W, 1 << 30, 0, 4096, QS1);
        GEMM_BF16(WV1T, XN, 512, M, DM, VT1, M, 1 << 30, 0, 0, 1.f);
    }
    SEAM(12);
    if (IN(13)) swa_attn_phase(F, QK1, VT1, O, sinks);
    SEAM(13);
    if (IN(14)) GEMM_F32(O, WO1T, M, DM, DM, AF, DM);
    SEAM(14);
    if (IN(15)) rows_phase<1>(F, AF, H, n_mix_post + DM, H, XN);
    SEAM(15);
    if (IN(16)) GEMM_BF16(XN, WIN1T, M, DFF2, DM, U, DFF2, 1 << 30, 0, 0, 1.f);
    SEAM(16);
    if (IN(17)) conv_act_phase(F, U, conv_w + (size_t)3 * DFF2, conv_b + DFF2, ACT);
    SEAM(17);
    if (IN(18)) GEMM_F32(ACT, WOUT1T, M, DM, DFF, AF, DM);
    SEAM(18);
    if (IN(19)) rows_phase<2>(F, AF, H, n_ffn_post + DM, H, nullptr);
#undef IN
#undef SEAM
}

#ifndef MK_SPLIT
#define MK_SPLIT 0
#endif
extern "C" void kernel_launch(void* const* d_in, const int* in_sizes, int n_in, void* d_out, int out_size, void* d_ws, size_t ws_size, hipStream_t stream) {
    static int grid = 0;
    if (grid == 0) {
        if (n_in != 23 || out_size != M * DM || ws_size < WS_END) { fprintf(stderr, "kernel_launch: unexpected shapes (n_in %d, out %d, ws %zu < %zu)\n", n_in, out_size, ws_size, (size_t)WS_END); grid = -1; return; }
        int dev = 0, cus = 0, per_cu = 0;
        if (hipGetDevice(&dev) != hipSuccess || hipDeviceGetAttribute(&cus, hipDeviceAttributeMultiprocessorCount, dev) != hipSuccess) { grid = -1; return; }
        if (hipFuncSetAttribute((const void*)yoco_fwd, hipFuncAttributeMaxDynamicSharedMemorySize, LDS_BYTES) != hipSuccess) { fprintf(stderr, "kernel_launch: hipFuncSetAttribute failed\n"); grid = -1; return; }
        if (hipOccupancyMaxActiveBlocksPerMultiprocessor(&per_cu, (const void*)yoco_fwd, NWAVES * 64, LDS_BYTES) != hipSuccess || per_cu < 1)
            fprintf(stderr, "kernel_launch: occupancy query reports %d workgroups per CU\n", per_cu);
        (void)hipGetLastError();
        grid = cus;
    }
    if (grid < 0) return;
    (void)hipMemsetAsync((char*)d_ws + WS_CTL, 0, CTL_ZERO_BYTES, stream);
    Args a; memset(&a, 0, sizeof(a));
    for (int i = 0; i < 23; ++i) a.in[i] = (const float*)d_in[i];
    a.out = (float*)d_out; a.ws = (unsigned char*)d_ws;
    unsigned char* ws = (unsigned char*)d_ws;
    const float* nmp = a.in[2]; const float* nfp = a.in[4];
    int nj = 0, items = 0;
    auto add = [&](const float* W, const float* gain, size_t wt_off, int ldw, int K, int ncols, int col0, int gs, int gsrc, int drow0) {
        WJob& J = a.jobs[nj++]; J.W = W; J.gain = gain; J.WT = (bf16*)(ws + wt_off); J.ldw = ldw; J.K = K; J.ncols = ncols; J.col0 = col0; J.gs = gs; J.gsrc = gsrc; J.drow0 = drow0; J.item0 = items;
        items += (K / 64) * (ncols / 32); };
    const int BIG = 1 << 30;
    add(a.in[6],  nmp,        WS_W1T,   QLORA,  DM,     QLORA,  0, BIG, 0, 0);
    add(a.in[9],  nmp,        WS_W1T,   576,    DM,     576,    0, BIG, 0, QLORA);
    add(a.in[8],  a.in[7],    WS_WUQT,  QW,     QLORA,  QW,     0, BIG, 0, 0);
    add(a.in[11], a.in[10],   WS_WKNT,  8192,   KVLORA, 4096,   0, 128, 256, 0);
    add(a.in[11], a.in[10],   WS_WVT,   8192,   KVLORA, 4096, 128, 128, 256, 0);
    add(a.in[12], nullptr,    WS_WO0T,  DM,     DM,     DM,     0, BIG, 0, 0);
    add(a.in[19], nfp,        WS_WIN0T, DFF2,   DM,     DFF2,   0, BIG, 0, 0);
    add(a.in[22], nullptr,    WS_WOUT0T,DM,     DFF,    DM,     0, BIG, 0, 0);
    add(a.in[16], nmp + DM,   WS_WQK1T, DM,     DM,     DM,     0, BIG, 0, 0);
    add(a.in[14], a.in[13],   WS_WQK1T, 512,    DM,     512,    0, BIG, 0, 4096);
    add(a.in[15], a.in[13],   WS_WV1T,  512,    DM,     512,    0, BIG, 0, 0);
    add(a.in[18], nullptr,    WS_WO1T,  DM,     DM,     DM,     0, BIG, 0, 0);
    add(a.in[19] + (size_t)DM * DFF2, nfp + DM, WS_WIN1T, DFF2, DM, DFF2, 0, BIG, 0, 0);
    add(a.in[22] + (size_t)DFF * DM,  nullptr,  WS_WOUT1T, DM,  DFF, DM,  0, BIG, 0, 0);
    a.nitems = items;
#if MK_SPLIT
    for (int p = 0; p < NPHASE; ++p) { a.ph_lo = p; a.ph_hi = p + 1; hipLaunchKernelGGL(yoco_fwd, dim3(grid), dim3(NWAVES * 64), LDS_BYTES, stream, a); }
#else
    a.ph_lo = 0; a.ph_hi = NPHASE;
    hipLaunchKernelGGL(yoco_fwd, dim3(grid), dim3(NWAVES * 64), LDS_BYTES, stream, a);
#endif
    const hipError_t le = hipPeekAtLastError();
    if (le != hipSuccess) fprintf(stderr, "kernel_launch: launch failed: %s\n", hipGetErrorName(le));
}
```

```cpp
#include <hip/hip_runtime.h>
#include <cstdio>
#include <cstdint>
#include <cstring>
namespace pg8 {
#define PG8_LAS __attribute__((address_space(3)))
typedef unsigned short bf16_t;
typedef short bf16x8 __attribute__((ext_vector_type(8)));
typedef float f32x4 __attribute__((ext_vector_type(4)));
typedef unsigned u32x4 __attribute__((ext_vector_type(4)));
constexpr int BM = 256, BK = 64, HALF = 128, HTB = HALF * BK * 2  , STAGE_BYTES = 8 * HTB, NXCD = 8, WGM = 8;

__host__ __device__ __forceinline__ int lds_byte(int r, int c) { const int st = (r >> 4) * 2 + (c >> 5), rr = r & 15, cc = c & 31, ob = rr * 64 + cc * 2; return st * 1024 + (ob ^ (((ob >> 9) & 1) << 5)); }
__host__ __device__ __forceinline__ void stage_rc(int b, int& R, int& C) { const int st = b / 1024, sb = b % 1024, swz = sb ^ (((sb >> 9) & 1) << 5); R = (st >> 1) * 16 + swz / 64; C = (st & 1) * 32 + (swz % 64) / 2; }
__host__ __device__ __forceinline__ int perm32(int rho) { const int n = rho >> 4, i = rho & 15; return 8 * (i >> 2) + 4 * n + (i & 3); }

struct Unit { int pm, pn; };
struct Gemm { const bf16_t* A; const bf16_t* Bt; int M, N, K; int tA, tB, zig, k0; };
__host__ __device__ __forceinline__ size_t tiled_off(int row, int col, int K) { return ((((size_t)(row >> 8) * (size_t)(K >> 6) + (size_t)(col >> 6)) * 256 + (size_t)(row & 255)) << 6) + (size_t)(col & 63); }

struct StaticOrder {
    int nM, nN, nwg, G, c, flipn;
    __host__ __device__ void init(int M, int N, int G_, int c_, int flipn_ = 0) { nM = M / BM; nN = N / BM; nwg = nM * nN; G = G_; c = c_; flipn = flipn_; }
    __host__ __device__ bool next(int i, Unit& u) const {
        const long L = (long)i * G + c; if (L >= nwg) return false;
        int wgid = (int)L; { const int q = nwg / NXCD, r = nwg % NXCD, xcd = wgid % NXCD, off = wgid / NXCD; wgid = (xcd < r ? xcd * (q + 1) : r * (q + 1) + (xcd - r) * q) + off; }
        const int nig = WGM * nN, gid = wgid / nig, fm = gid * WGM, gsz = (nM - fm) < WGM ? (nM - fm) : WGM;
        u.pm = fm + ((wgid % nig) % gsz); u.pn = (wgid % nig) / gsz; if (flipn) u.pn = nN - 1 - u.pn; return true;
    }
    __device__ __forceinline__ void a_ready(const Unit&) const {}
    __device__ __forceinline__ void done(const Unit&) const {}
};

__device__ __forceinline__ unsigned cvt_pk_bf16(float lo, float hi) { unsigned r; asm volatile("v_cvt_pk_bf16_f32 %0, %1, %2" : "=v"(r) : "v"(lo), "v"(hi)); return r; }
typedef float f32x2 __attribute__((ext_vector_type(2)));
struct EpiF32 {
    static constexpr bool PERM = false, AFTER_DRAIN = false;
    float* C; int ldc; const float* rs;
    __device__ __forceinline__ void operator()(const f32x4 (&acc)[2][2][4][2], const Unit& u, int wr, int wc, int fr, int fq) const {
        const int row0 = u.pm * BM + wr * 64 + fr, col0 = u.pn * BM + wc * 32 + 4 * fq;
#pragma unroll
        for (int ai = 0; ai < 2; ++ai)
#pragma unroll
            for (int m = 0; m < 4; ++m) { const int row = row0 + ai * HALF + m * 16; float* rowp = C + (size_t)row * ldc + col0; const float s = rs ? rs[row] : 1.f;
#pragma unroll
                for (int bj = 0; bj < 2; ++bj)
#pragma unroll
                    for (int n = 0; n < 2; ++n) *(f32x4*)(rowp + bj * HALF + n * 16) = acc[ai][bj][m][n] * s; }
    }
};
struct EpiBf16Map {
    static constexpr bool PERM = true, AFTER_DRAIN = false;
    bf16_t* O; int ldc; int gs, gstride; int scale_cols; float scale0; const float* rs;
    __device__ __forceinline__ void operator()(const f32x4 (&acc)[2][2][4][2], const Unit& u, int wr, int wc, int fr, int fq) const {
        const int row0 = u.pm * BM + wr * 64 + fr;
        int dcol[2]; float sc[2];
#pragma unroll
        for (int bj = 0; bj < 2; ++bj) { const int ch = u.pn * BM + bj * HALF, grp = ch / gs; dcol[bj] = grp * gstride + (ch - grp * gs) + wc * 32 + 8 * fq; sc[bj] = ch < scale_cols ? scale0 : 1.f; }
#pragma unroll
        for (int ai = 0; ai < 2; ++ai)
#pragma unroll
            for (int m = 0; m < 4; ++m) { const int row = row0 + ai * HALF + m * 16; bf16_t* rowp = O + (size_t)row * ldc; const float s = rs ? rs[row] : 1.f;
#pragma unroll
                for (int bj = 0; bj < 2; ++bj) { const f32x4 v0 = acc[ai][bj][m][0] * (sc[bj] * s), v1 = acc[ai][bj][m][1] * (sc[bj] * s);
                    u32x4 w; w.x = cvt_pk_bf16(v0[0], v0[1]); w.y = cvt_pk_bf16(v0[2], v0[3]); w.z = cvt_pk_bf16(v1[0], v1[1]); w.w = cvt_pk_bf16(v1[2], v1[3]);
                    *(u32x4*)(rowp + dcol[bj]) = w; } }
    }
};

struct EpiQRope {
    static constexpr bool PERM = true, AFTER_DRAIN = false;
    bf16_t* Q; const float* CS; float qs;
    __device__ __forceinline__ void operator()(const f32x4 (&acc)[2][2][4][2], const Unit& u, int wr, int wc, int fr, int fq) const {
        typedef unsigned u32x2 __attribute__((ext_vector_type(2)));
        const int row0 = u.pm * BM + wr * 64 + fr;
#pragma unroll
        for (int bj = 0; bj < 2; ++bj) {
            const int c0 = u.pn * BM + bj * HALF + wc * 32 + 8 * fq, head = c0 / 192, cl = c0 - head * 192;
            if (cl < 128) {
#pragma unroll
                for (int ai = 0; ai < 2; ++ai)
#pragma unroll
                    for (int m = 0; m < 4; ++m) { const f32x4 v0 = acc[ai][bj][m][0] * qs, v1 = acc[ai][bj][m][1] * qs;
                        u32x4 w; w.x = cvt_pk_bf16(v0[0], v0[1]); w.y = cvt_pk_bf16(v0[2], v0[3]); w.z = cvt_pk_bf16(v1[0], v1[1]); w.w = cvt_pk_bf16(v1[2], v1[3]);
                        *(u32x4*)(Q + (size_t)(row0 + ai * HALF + m * 16) * 6144 + c0) = w; }
            } else {
                const int p0 = (cl - 128) >> 1;
#pragma unroll
                for (int ai = 0; ai < 2; ++ai)
#pragma unroll
                    for (int m = 0; m < 4; ++m) { const int row = row0 + ai * HALF + m * 16;
                        const f32x4 c4 = *(const f32x4*)(CS + (size_t)row * 64 + p0), s4 = *(const f32x4*)(CS + (size_t)row * 64 + 32 + p0);
                        const f32x4 x = acc[ai][bj][m][0], y = acc[ai][bj][m][1];
                        const float a0 = (x[0] * c4[0] - x[1] * s4[0]) * qs, b0 = (x[1] * c4[0] + x[0] * s4[0]) * qs, a1 = (x[2] * c4[1] - x[3] * s4[1]) * qs, b1 = (x[3] * c4[1] + x[2] * s4[1]) * qs;
                        const float a2 = (y[0] * c4[2] - y[1] * s4[2]) * qs, b2 = (y[1] * c4[2] + y[0] * s4[2]) * qs, a3 = (y[2] * c4[3] - y[3] * s4[3]) * qs, b3 = (y[3] * c4[3] + y[2] * s4[3]) * qs;
                        bf16_t* qp = Q + (size_t)row * 6144 + head * 192 + 128 + p0;
                        u32x2 w1; w1.x = cvt_pk_bf16(a0, a1); w1.y = cvt_pk_bf16(a2, a3); *(u32x2*)qp = w1;
                        u32x2 w2; w2.x = cvt_pk_bf16(b0, b1); w2.y = cvt_pk_bf16(b2, b3); *(u32x2*)(qp + 32) = w2; }
            }
        }
    }
};

struct EpiConvAct {
    static constexpr bool PERM = true, AFTER_DRAIN = false, APERM = true;
    bf16_t* ACT; float* PART; float* HALO; const float* cw; const float* cb; const float* rs;
    static constexpr int DFF = 11008;
    static constexpr int ATILED = 1;
    __device__ __forceinline__ static float shr1f(float x) { return __builtin_bit_cast(float, __builtin_amdgcn_update_dpp(0, __builtin_bit_cast(int, x), 0x111, 0xF, 0xF, true)); }
    __device__ __forceinline__ static f32x4 shr1(const f32x4 v) { f32x4 r; r.x = shr1f(v.x); r.y = shr1f(v.y); r.z = shr1f(v.z); r.w = shr1f(v.w); return r; }
    __device__ __forceinline__ static float silu_mul(float g, float v) { return g * __builtin_amdgcn_rcpf(1.0f + __builtin_amdgcn_exp2f(g * -1.4426950408889634f)) * v; }
    __device__ __forceinline__ void operator()(const f32x4 (&acc)[2][2][4][2], const Unit& u, int wr, int wc, int fr, int fq) const {
        typedef unsigned u32x2 __attribute__((ext_vector_type(2)));
        const int j0 = u.pn * HALF + wc * 32 + 8 * fq;
        u32x2 keep[2][4];
#pragma unroll
        for (int n = 0; n < 2; ++n) {
            const int j = j0 + 4 * n;
            const f32x4 wg0 = *(const f32x4*)(cw + j), wg1 = *(const f32x4*)(cw + 2 * DFF + j), wg2 = *(const f32x4*)(cw + 4 * DFF + j), bg = *(const f32x4*)(cb + j);
            const f32x4 wv0 = *(const f32x4*)(cw + DFF + j), wv1 = *(const f32x4*)(cw + 3 * DFF + j), wv2 = *(const f32x4*)(cw + 5 * DFF + j), bv = *(const f32x4*)(cb + DFF + j);
#pragma unroll
            for (int ai = 0; ai < 2; ++ai) {
                const int blk = 4 * u.pm + 2 * ai + wr;
                const f32x4 rsv = *(const f32x4*)(rs + u.pm * BM + ai * HALF + wr * 64 + 4 * fr);
                f32x4 ug[4], uv[4];
#pragma unroll
                for (int m = 0; m < 4; ++m) { ug[m] = acc[ai][0][m][n] * rsv[m]; uv[m] = acc[ai][1][m][n] * rsv[m]; }
                const f32x4 g3 = shr1(ug[3]), g2 = shr1(ug[2]), v3 = shr1(uv[3]), v2 = shr1(uv[2]);
#pragma unroll
                for (int m = 0; m < 4; ++m) {
                    const f32x4 gc = ug[m], vc = uv[m];
                    const f32x4 gp1 = (m == 0) ? g3 : ug[m - 1 < 0 ? 0 : m - 1], gp2 = (m == 0) ? g2 : (m == 1) ? g3 : ug[m - 2 < 0 ? 0 : m - 2];
                    const f32x4 vp1 = (m == 0) ? v3 : uv[m - 1 < 0 ? 0 : m - 1], vp2 = (m == 0) ? v2 : (m == 1) ? v3 : uv[m - 2 < 0 ? 0 : m - 2];
                    const f32x4 G = bg + wg0 * gp2 + wg1 * gp1 + wg2 * gc, V = bv + wv0 * vp2 + wv1 * vp1 + wv2 * vc;
                    if (m < 2) { if (fr == 0) { float* pp = PART + ((size_t)(blk * 2 + m) * 2) * DFF + j; *(f32x4*)pp = G; *(f32x4*)(pp + DFF) = V; } }
                    else       { if (fr == 15) { float* hp = HALO + ((size_t)(blk * 2 + (m - 2)) * 2) * DFF + j; *(f32x4*)hp = gc; *(f32x4*)(hp + DFF) = vc; } }
                    u32x2 w; w.x = cvt_pk_bf16(silu_mul(G[0], V[0]), silu_mul(G[1], V[1])); w.y = cvt_pk_bf16(silu_mul(G[2], V[2]), silu_mul(G[3], V[3]));
                    if (n == 0) keep[ai][m] = w;
                    else if (!(m < 2 && fr == 0)) { u32x4 o; o.x = keep[ai][m].x; o.y = keep[ai][m].y; o.z = w.x; o.w = w.y;
                        const int row_ = u.pm * BM + ai * HALF + wr * 64 + 4 * fr + m;
                        *(u32x4*)(ACT + (ATILED ? tiled_off(row_, j0, DFF) : (size_t)row_ * DFF + j0)) = o; }
                }
            }
        }
    }
};

struct EpiNull {
    static constexpr bool PERM = true, AFTER_DRAIN = false;
    float* sink;
    __device__ __forceinline__ void operator()(const f32x4 (&acc)[2][2][4][2], const Unit& u, int wr, int wc, int fr, int fq) const {
        f32x4 s = {0.f, 0.f, 0.f, 0.f};
#pragma unroll
        for (int ai = 0; ai < 2; ++ai)
#pragma unroll
            for (int bj = 0; bj < 2; ++bj)
#pragma unroll
                for (int m = 0; m < 4; ++m)
#pragma unroll
                    for (int n = 0; n < 2; ++n) s += acc[ai][bj][m][n];
        if (s[0] + s[1] + s[2] + s[3] == 1.2345678e30f) sink[u.pm + u.pn + fr] = s[0];
    }
};

struct ZeroOrder : StaticOrder {
    __device__ bool next(int i, Unit& u) const { const bool ok = StaticOrder::next(i, u); u.pm = 0; u.pn = 0; return ok; }
};

struct ZeroAOrder : StaticOrder { __device__ bool next(int i, Unit& u) const { const bool ok = StaticOrder::next(i, u); u.pm = 0; return ok; } };
struct ZeroBOrder : StaticOrder { __device__ bool next(int i, Unit& u) const { const bool ok = StaticOrder::next(i, u); u.pn = 0; return ok; } };

struct HalfMOrder {
    StaticOrder so; int vcu; bool fast;
    __device__ void init(int M, int N, int G_, int c_, int vcu_) { so.init(M, N, G_, c_); vcu = vcu_; fast = (G_ == 256 && M == 8192 && N == 4096); }
    __device__ bool next(int i, Unit& u) const {
        if (!fast) return so.next(i, u);
        if (i >= 2) return false;
        const int x = vcu >> 5, j = vcu & 31; u.pm = 16 * i + 4 * (x >> 1) + (j & 3); u.pn = 8 * (x & 1) + (j >> 2); return true;
    }
    __device__ __forceinline__ void a_ready(const Unit&) const {}
    __device__ __forceinline__ void done(const Unit&) const {}
};

template <class E, class = void> struct epi_aperm { static constexpr bool value = false; };
template <class E> struct epi_aperm<E, decltype((void)E::APERM)> { static constexpr bool value = E::APERM; };
template <class Epi, class Sched, bool ALIGN_EPI = false, bool SP2 = false>
__device__ __forceinline__ void gemm_phase(PG8_LAS unsigned char* lds, const Gemm g, const Sched& S, const Epi& E) {
    const int tid = threadIdx.x, wid = __builtin_amdgcn_readfirstlane(tid >> 6), lane = tid & 63, wr = wid >> 2, wc = wid & 3, fr = lane & 15, fq = lane >> 4;
    const int K = g.K, nt = K / BK;
    unsigned voffA[2], voffB[2];
#pragma unroll
    for (int i = 0; i < 2; ++i) { int R, C; stage_rc(tid * 16 + i * 8192, R, C); const int Rb = Epi::PERM ? ((R & ~31) + perm32(R & 31)) : R;
        const int Ra = epi_aperm<Epi>::value ? ((R & ~63) | (4 * (R & 15) + ((R >> 4) & 3))) : R;
        voffA[i] = (unsigned)(Ra * (g.tA ? BK : K) + C) * 2u; voffB[i] = (unsigned)(Rb * (g.tB ? BK : K) + C) * 2u; }
    const long ksA = g.tA ? (long)(BM * BK * 2) : (long)(BK * 2), ksB = g.tB ? (long)(BM * BK * 2) : (long)(BK * 2);
#define PG8_REV(u_) (g.zig == 3 || (g.zig != 0 && ((((u_) ^ g.zig) & 1) != 0)))
    long kstepA = PG8_REV(0) ? -ksA : ksA, kstepB = PG8_REV(0) ? -ksB : ksB;
    const size_t hstepA = g.tA ? (size_t)(HALF * BK * 2) : (size_t)HALF * K * 2, hstepB = g.tB ? (size_t)(HALF * BK * 2) : (size_t)HALF * K * 2;
    const size_t tstepA = (size_t)BM * K * 2, tstepB = (size_t)BM * K * 2;
    const unsigned ldsw = (unsigned)wid * 1024u;
    const int aoff = lds_byte(wr * 64 + fr, fq * 8), boff = lds_byte(wc * 32 + fr, fq * 8);
#define PG8_NT_B 1
#define PG8_SA(b, h) (((b) * 2 + (h)) * HTB)
#define PG8_SB(b, h) ((4 + (b) * 2 + (h)) * HTB)
    const char* const bA_ = (const char*)g.A; const char* const bB_ = (const char*)g.Bt;
    const __amdgpu_buffer_rsrc_t srdA_ = __builtin_amdgcn_make_buffer_rsrc((void*)g.A, (short)0, (int)((size_t)g.M * K * 2), 0x00020000);
    const __amdgpu_buffer_rsrc_t srdB_ = __builtin_amdgcn_make_buffer_rsrc((void*)g.Bt, (short)0, (int)((size_t)g.N * K * 2), 0x00020000);
#define PG8_STAGE(bufoff, gbase, voff) do { _Pragma("unroll") for (int _i = 0; _i < 2; ++_i) \
        __builtin_amdgcn_raw_ptr_buffer_load_lds(srdA_, (PG8_LAS void*)(lds + (bufoff) + ldsw + _i * 8192), 16, (voff)[_i], (int)((const char*)(gbase) - bA_), 0, PG8_NT_B); } while (0)
#define PG8_STAGEB(bufoff, gbase, voff) do { _Pragma("unroll") for (int _i = 0; _i < 2; ++_i) \
        __builtin_amdgcn_raw_ptr_buffer_load_lds(srdB_, (PG8_LAS void*)(lds + (bufoff) + ldsw + _i * 8192), 16, (voff)[_i], (int)((const char*)(gbase) - bB_), 0, PG8_NT_B); } while (0)
#define PG8_LDA(dst, b, h) do { _Pragma("unroll") for (int m = 0; m < 4; ++m) _Pragma("unroll") for (int k = 0; k < 2; ++k) dst[m][k] = *(const PG8_LAS bf16x8*)(lds + PG8_SA(b, h) + aoff + m * 2048 + k * 1024); } while (0)
#define PG8_LDB(dst, b, h) do { _Pragma("unroll") for (int n = 0; n < 2; ++n) _Pragma("unroll") for (int k = 0; k < 2; ++k) dst[n][k] = *(const PG8_LAS bf16x8*)(lds + PG8_SB(b, h) + boff + n * 2048 + k * 1024); } while (0)
#define PG8_MMA(ai, bj, At, Bt) do { __builtin_amdgcn_s_setprio(1); _Pragma("unroll") for (int m = 0; m < 4; ++m) _Pragma("unroll") for (int n = 0; n < 2; ++n) _Pragma("unroll") for (int k = 0; k < 2; ++k) \
        acc[ai][bj][m][n] = __builtin_amdgcn_mfma_f32_16x16x32_bf16(Bt[n][k], At[m][k], acc[ai][bj][m][n], 0, 0, 0); __builtin_amdgcn_s_setprio(0); } while (0)
#define PG8_WAIT_V(n) asm volatile("s_waitcnt vmcnt(" #n ")" ::: "memory")
#define PG8_WAIT_L(n) asm volatile("s_waitcnt lgkmcnt(" #n ")" ::: "memory")
#define PG8_BAR __builtin_amdgcn_s_barrier()
#define PG8_LP(x) __builtin_amdgcn_s_setprio(x)
#define PG8_SCHED __builtin_amdgcn_sched_barrier(0)
    Unit cur, nxt; int ui = 0;
    if (!S.next(0, cur)) return;
    f32x4 acc[2][2][4][2];
#pragma unroll
    for (int a = 0; a < 2; ++a)
#pragma unroll
        for (int b = 0; b < 2; ++b)
#pragma unroll
            for (int m = 0; m < 4; ++m)
#pragma unroll
                for (int n = 0; n < 2; ++n) acc[a][b][m][n] = (f32x4){0.f, 0.f, 0.f, 0.f};
    bf16x8 At[4][2], B0[2][2], B1[2][2];
    const char* cA = (const char*)g.A + (size_t)cur.pm * tstepA + (PG8_REV(0) ? (long)(nt - 1) * ksA : 0l); const char* cB = (const char*)g.Bt + (size_t)cur.pn * tstepB + (PG8_REV(0) ? (long)(nt - 1) * ksB : 0l);
    S.a_ready(cur);
    if constexpr (SP2) {
        PG8_STAGEB(PG8_SB(0, 0), cB, voffB); PG8_STAGEB(PG8_SB(0, 1), cB + hstepB, voffB); PG8_STAGE(PG8_SA(0, 0), cA, voffA); PG8_STAGE(PG8_SA(0, 1), cA + hstepA, voffA);
        if (wr == 1) PG8_BAR;
        PG8_WAIT_V(2); PG8_BAR;
        PG8_STAGEB(PG8_SB(1, 0), cB + kstepB, voffB); PG8_STAGE(PG8_SA(1, 0), cA + kstepA, voffA); PG8_STAGEB(PG8_SB(1, 1), cB + hstepB + kstepB, voffB);
        PG8_WAIT_V(6); PG8_BAR;
    } else {
        PG8_STAGEB(PG8_SB(0, 0), cB, voffB); PG8_STAGE(PG8_SA(0, 0), cA, voffA); PG8_STAGEB(PG8_SB(0, 1), cB + hstepB, voffB); PG8_STAGE(PG8_SA(0, 1), cA + hstepA, voffA);
        if (wr == 1) PG8_BAR;
        PG8_WAIT_V(4); PG8_BAR;
        PG8_STAGEB(PG8_SB(1, 0), cB + kstepB, voffB); PG8_STAGE(PG8_SA(1, 0), cA + kstepA, voffA); PG8_STAGEB(PG8_SB(1, 1), cB + hstepB + kstepB, voffB);
        PG8_WAIT_V(6); PG8_BAR;
    }
    for (;;) {
        const bool has_next = S.next(ui + 1, nxt);
        const bool nrev = PG8_REV(ui + 1);
        const long nkstepA = has_next ? (nrev ? -ksA : ksA) : kstepA, nkstepB = has_next ? (nrev ? -ksB : ksB) : kstepB;
        const char* nA = has_next ? (const char*)g.A + (size_t)nxt.pm * tstepA + (nrev ? (long)(nt - 1) * ksA : 0l) : cA; const char* nB = has_next ? (const char*)g.Bt + (size_t)nxt.pn * tstepB + (nrev ? (long)(nt - 1) * ksB : 0l) : cB;
        if constexpr (SP2) {
            if (wr == 0) {
                for (int t = 0; t < nt; t += 2) {
            const bool last = (t == nt - 2);
            const char* a1 = cA + (long)(t + 1) * kstepA;
            const char* a2 = last ? nA : cA + (long)(t + 2) * kstepA; const char* b2 = last ? nB : cB + (long)(t + 2) * kstepB;
            const char* a3 = a2 + (last ? nkstepA : kstepA); const char* b3 = b2 + (last ? nkstepB : kstepB);
            if (last && has_next) S.a_ready(nxt);
            PG8_LP(2); PG8_LDB(B0, 0, 0); PG8_LDB(B1, 0, 1); PG8_SCHED; PG8_LDA(At, 0, 0); PG8_STAGE(PG8_SA(1, 1), a1 + hstepA, voffA);
            PG8_WAIT_L(0); PG8_LP(0); PG8_BAR; PG8_MMA(0, 0, At, B0); PG8_MMA(0, 1, At, B1); PG8_WAIT_V(8); PG8_BAR; PG8_SCHED;
            PG8_LP(2); PG8_LDA(At, 0, 1); PG8_STAGEB(PG8_SB(0, 0), b2, voffB); PG8_STAGEB(PG8_SB(0, 1), b2 + hstepB, voffB); PG8_STAGE(PG8_SA(0, 0), a2, voffA);
            PG8_WAIT_L(0); PG8_LP(0); PG8_BAR; PG8_MMA(1, 0, At, B0); PG8_MMA(1, 1, At, B1); PG8_WAIT_V(8); PG8_BAR; PG8_SCHED;
            PG8_LP(2); PG8_LDB(B0, 1, 0); PG8_LDB(B1, 1, 1); PG8_SCHED; PG8_LDA(At, 1, 0); PG8_STAGE(PG8_SA(0, 1), a2 + hstepA, voffA);
            PG8_WAIT_L(0); PG8_LP(0); PG8_BAR; PG8_MMA(0, 0, At, B0); PG8_MMA(0, 1, At, B1); PG8_WAIT_V(8); PG8_BAR; PG8_SCHED;
            PG8_LP(2); PG8_LDA(At, 1, 1); PG8_STAGEB(PG8_SB(1, 0), b3, voffB); PG8_STAGEB(PG8_SB(1, 1), b3 + hstepB, voffB); PG8_STAGE(PG8_SA(1, 0), a3, voffA);
            PG8_WAIT_L(0); PG8_LP(0); PG8_BAR; PG8_MMA(1, 0, At, B0); PG8_MMA(1, 1, At, B1); PG8_WAIT_V(8); PG8_BAR; PG8_SCHED;
                }
            } else {
                for (int t = 0; t < nt; t += 2) {
            const bool last = (t == nt - 2);
            const char* a1 = cA + (long)(t + 1) * kstepA;
            const char* a2 = last ? nA : cA + (long)(t + 2) * kstepA; const char* b2 = last ? nB : cB + (long)(t + 2) * kstepB;
            const char* a3 = a2 + (last ? nkstepA : kstepA); const char* b3 = b2 + (last ? nkstepB : kstepB);
            if (last && has_next) S.a_ready(nxt);
            PG8_LP(2); PG8_LDB(B0, 0, 0); PG8_LDB(B1, 0, 1); PG8_SCHED; PG8_LDA(At, 0, 0); PG8_STAGE(PG8_SA(1, 1), a1 + hstepA, voffA);
            PG8_WAIT_V(8); PG8_WAIT_L(0); PG8_LP(0); PG8_BAR; PG8_MMA(0, 0, At, B0); PG8_MMA(0, 1, At, B1); PG8_BAR; PG8_SCHED;
            PG8_LP(2); PG8_LDA(At, 0, 1); PG8_STAGEB(PG8_SB(0, 0), b2, voffB); PG8_STAGEB(PG8_SB(0, 1), b2 + hstepB, voffB); PG8_STAGE(PG8_SA(0, 0), a2, voffA);
            PG8_WAIT_V(8); PG8_WAIT_L(0); PG8_LP(0); PG8_BAR; PG8_MMA(1, 0, At, B0); PG8_MMA(1, 1, At, B1); PG8_BAR; PG8_SCHED;
            PG8_LP(2); PG8_LDB(B0, 1, 0); PG8_LDB(B1, 1, 1); PG8_SCHED; PG8_LDA(At, 1, 0); PG8_STAGE(PG8_SA(0, 1), a2 + hstepA, voffA);
            PG8_WAIT_V(8); PG8_WAIT_L(0); PG8_LP(0); PG8_BAR; PG8_MMA(0, 0, At, B0); PG8_MMA(0, 1, At, B1); PG8_BAR; PG8_SCHED;
            PG8_LP(2); PG8_LDA(At, 1, 1); PG8_STAGEB(PG8_SB(1, 0), b3, voffB); PG8_STAGEB(PG8_SB(1, 1), b3 + hstepB, voffB); PG8_STAGE(PG8_SA(1, 0), a3, voffA);
            PG8_WAIT_V(8); PG8_WAIT_L(0); PG8_LP(0); PG8_BAR; PG8_MMA(1, 0, At, B0); PG8_MMA(1, 1, At, B1); PG8_BAR; PG8_SCHED;
                }
            }
        } else {
            for (int t = 0; t < nt; t += 2) {
            const bool last = (t == nt - 2);
            const char* a1 = cA + (long)(t + 1) * kstepA;
            const char* a2 = last ? nA : cA + (long)(t + 2) * kstepA; const char* b2 = last ? nB : cB + (long)(t + 2) * kstepB;
            const char* a3 = a2 + (last ? nkstepA : kstepA); const char* b3 = b2 + (last ? nkstepB : kstepB);
            if (last && has_next) S.a_ready(nxt);
            PG8_LDB(B0, 0, 0); PG8_SCHED; PG8_LDA(At, 0, 0); PG8_STAGE(PG8_SA(1, 1), a1 + hstepA, voffA);
            PG8_WAIT_L(8); PG8_BAR; PG8_WAIT_L(0); PG8_MMA(0, 0, At, B0); PG8_BAR; PG8_SCHED;
            PG8_LDB(B1, 0, 1); PG8_STAGEB(PG8_SB(0, 0), b2, voffB);
            PG8_BAR; PG8_WAIT_L(0); PG8_MMA(0, 1, At, B1); PG8_BAR;
            PG8_LDA(At, 0, 1); PG8_STAGE(PG8_SA(0, 0), a2, voffA);
            PG8_BAR; PG8_WAIT_L(0); PG8_MMA(1, 0, At, B0); PG8_BAR; PG8_SCHED;
            PG8_STAGEB(PG8_SB(0, 1), b2 + hstepB, voffB);
            PG8_WAIT_V(6); PG8_BAR; PG8_MMA(1, 1, At, B1); PG8_BAR;
            PG8_LDB(B0, 1, 0); PG8_SCHED; PG8_LDA(At, 1, 0); PG8_STAGE(PG8_SA(0, 1), a2 + hstepA, voffA);
            PG8_WAIT_L(8); PG8_BAR; PG8_WAIT_L(0); PG8_MMA(0, 0, At, B0); PG8_BAR; PG8_SCHED;
            PG8_LDB(B1, 1, 1); PG8_STAGEB(PG8_SB(1, 0), b3, voffB);
            PG8_BAR; PG8_WAIT_L(0); PG8_MMA(0, 1, At, B1); PG8_BAR;
            PG8_LDA(At, 1, 1); PG8_STAGE(PG8_SA(1, 0), a3, voffA);
            PG8_BAR; PG8_WAIT_L(0); PG8_MMA(1, 0, At, B0); PG8_BAR; PG8_SCHED;
            PG8_STAGEB(PG8_SB(1, 1), b3 + hstepB, voffB);
            PG8_WAIT_V(6); PG8_BAR; PG8_MMA(1, 1, At, B1); PG8_BAR;
            }
        }
        if constexpr (ALIGN_EPI) { if (wr == 0) PG8_BAR; }
        if constexpr (!Epi::AFTER_DRAIN) { E(acc, cur, wr, wc, fr, fq); S.done(cur); }
        if (!has_next) break;
#pragma unroll
        for (int a = 0; a < 2; ++a)
#pragma unroll
            for (int b = 0; b < 2; ++b)
#pragma unroll
                for (int m = 0; m < 4; ++m)
#pragma unroll
                    for (int n = 0; n < 2; ++n) acc[a][b][m][n] = (f32x4){0.f, 0.f, 0.f, 0.f};
        cur = nxt; cA = nA; cB = nB; kstepA = nkstepA; kstepB = nkstepB; ++ui;
        if constexpr (ALIGN_EPI) { if (wr == 1) PG8_BAR; }
    }
    PG8_WAIT_V(0);
    if constexpr (!ALIGN_EPI) { if (wr == 0) PG8_BAR; }
    PG8_BAR;
    if constexpr (Epi::AFTER_DRAIN) { E.fused(acc, cur, wr, wc, fr, fq, lds, wid, lane); S.done(cur); }
#undef PG8_REV
#undef PG8_SA
#undef PG8_SB
#undef PG8_STAGE
#undef PG8_LDA
#undef PG8_LDB
#undef PG8_MMA
#undef PG8_WAIT_V
#undef PG8_WAIT_L
#undef PG8_BAR
#undef PG8_LP
#undef PG8_SCHED
}
}

constexpr int BATCH = 2, SEQ = 4096, DM = 4096, M = BATCH * SEQ;
constexpr int QLORA = 1024, KVLORA = 512, NH = 32, DQK = 192, DNOPE = 128, DROPE = 64, DV = 128;
constexpr int N1 = 1792;
constexpr int QW = NH * DQK;
constexpr int DFF = 11008, DFF2 = 22016;
constexpr int SWH = 64, SWKV = 8, SWD = 64, WIN = 128, QK1W = 4096 + 512 + 512;
constexpr float EPS = 1e-6f;
constexpr float LOG2E = 1.4426950408889634f;
constexpr float QS0 = (float)(0.07216878364870322 * 1.4426950408889634);
constexpr float QS1 = (float)(0.125 * 1.4426950408889634);
constexpr int NWAVES = 8;
constexpr int FLIP_IN = 0;
constexpr int ZIG_OUT = 1, ZIG_DEF = 0;
constexpr int K0IN_ON = 0;
constexpr int XTILED = 0;
constexpr bool LEADB_IN = false;
constexpr int WTILED = 1;

constexpr size_t MiB = 1u << 20;
constexpr size_t WS_CTL = 0, CTL_ZERO_BYTES = 1 * MiB;
constexpr size_t WS_CS    = 2 * MiB;
constexpr size_t WS_RS    = 6 * MiB;
constexpr size_t WS_W1T   = 8 * MiB;
constexpr size_t WS_WUQT  = WS_W1T   + (size_t)N1 * DM * 2;
constexpr size_t WS_WKNT  = WS_WUQT  + (size_t)QW * QLORA * 2;
constexpr size_t WS_WVT   = WS_WKNT  + (size_t)4096 * KVLORA * 2;
constexpr size_t WS_WO0T  = WS_WVT   + (size_t)4096 * KVLORA * 2;
constexpr size_t WS_WIN0T = WS_WO0T  + (size_t)DM * DM * 2;
constexpr size_t WS_WOUT0T= WS_WIN0T + (size_t)DFF2 * DM * 2;
constexpr size_t WS_WQK1T = WS_WOUT0T+ (size_t)DM * DFF * 2;
constexpr size_t WS_WV1T  = WS_WQK1T + (size_t)QK1W * DM * 2;
constexpr size_t WS_WO1T  = WS_WV1T  + (size_t)512 * DM * 2;
constexpr size_t WS_WIN1T = WS_WO1T  + (size_t)DM * DM * 2;
constexpr size_t WS_WOUT1T= WS_WIN1T + (size_t)DFF2 * DM * 2;
constexpr size_t WS_XN    = WS_WOUT1T+ (size_t)DM * DFF * 2;
constexpr size_t WS_CQKV  = WS_XN    + (size_t)M * DM * 2;
constexpr size_t WS_CQN   = WS_CQKV  + (size_t)M * N1 * 4;
constexpr size_t WS_CKV   = WS_CQN   + (size_t)M * QLORA * 2;
constexpr size_t WS_QF    = WS_CKV   + (size_t)M * KVLORA * 2;
constexpr size_t WS_Q     = WS_QF    + (size_t)M * QW * 4;
constexpr size_t WS_K     = WS_Q     + (size_t)M * QW * 2;
constexpr size_t WS_VT    = WS_K     + (size_t)M * QW * 2;
constexpr size_t WS_O     = WS_VT    + (size_t)4096 * M * 2;
constexpr size_t WS_AF    = WS_O     + (size_t)M * DM * 2;
constexpr size_t WS_U     = WS_AF    + (size_t)M * DM * 4;
constexpr size_t WS_ACT   = WS_U     + (size_t)M * DFF2 * 2;
constexpr size_t WS_QK1   = WS_ACT   + (size_t)M * DFF * 2;
constexpr size_t WS_VT1   = WS_QK1   + (size_t)M * QK1W * 2;
constexpr size_t WS_END   = WS_VT1   + (size_t)512 * M * 2;
constexpr int CW_BAR = 4096;

constexpr int RING_OFF = 0, RING_BYTES = 131072;
constexpr int LDSCTL_OFF = RING_BYTES, MISC_OFF = LDSCTL_OFF + 320;
constexpr int JOBS_OFF = LDSCTL_OFF + 1024;
constexpr int LDS_BYTES = 147456;
#define GAS __attribute__((address_space(1)))
#define LAS __attribute__((address_space(3)))
typedef unsigned short bf16;
typedef unsigned v4u __attribute__((ext_vector_type(4)));
typedef float f32x4 __attribute__((ext_vector_type(4)));
typedef short bf16x8 __attribute__((ext_vector_type(8)));
typedef GAS unsigned gu32;
typedef GAS unsigned long long gu64;
#define RLX_AGENT __ATOMIC_RELAXED, __HIP_MEMORY_SCOPE_AGENT
#define LDS_WAIT() asm volatile("s_waitcnt lgkmcnt(0)" ::: "memory")
#define VM_WAIT() asm volatile("s_waitcnt vmcnt(0)" ::: "memory")
__device__ __forceinline__ unsigned long long rt() { return __builtin_amdgcn_s_memrealtime(); }
__device__ __forceinline__ unsigned f2bf(float f) { unsigned u = __builtin_bit_cast(unsigned, f); return (u + 0x7fffu + ((u >> 16) & 1u)) >> 16; }
__device__ __forceinline__ unsigned pk2(float lo, float hi) { return f2bf(lo) | (f2bf(hi) << 16); }

#define XB_TMO      128
#define XB_XCNT(j)  (256  + 64 * (j))
#define XB_XSUB(j)  (1280 + 64 * (j))
#define XB_XGEN(j)  (2304 + 64 * (j))
#define XB_TOP      3328
#define XB_TOPGEN   3392
#define XCD_BAR_WORDS 3456
#define XB_SPIN_CAP (1u << 18)

__device__ __forceinline__ unsigned xb_ld(unsigned* p)              { return __hip_atomic_load(p, __ATOMIC_RELAXED, __HIP_MEMORY_SCOPE_AGENT); }
__device__ __forceinline__ unsigned xb_add(unsigned* p, unsigned v) { return __hip_atomic_fetch_add(p, v, __ATOMIC_RELAXED, __HIP_MEMORY_SCOPE_AGENT); }
__device__ __forceinline__ unsigned xb_xcc_id() { return (unsigned)__builtin_amdgcn_s_getreg((3 << 11) | 20) & 0xFu; }
#define XB_SPIN(cond, bar) do { unsigned _sp = 0; while (cond) { __builtin_amdgcn_s_sleep(1); \
    if ((++_sp & 255u) == 0u) { if (xb_ld(&(bar)[XB_TMO])) break; if (_sp > XB_SPIN_CAP) { atomicAdd(&(bar)[XB_TMO], 1u); break; } } } } while (0)

struct XcdBarrier {
    unsigned* bar; unsigned x;
    volatile LAS unsigned* st;
};

__device__ __forceinline__ XcdBarrier xcd_barrier_post(unsigned* bar, volatile LAS unsigned* st) {
    XcdBarrier b; b.bar = bar; b.x = xb_xcc_id(); b.st = st;
    if (threadIdx.x == 0) (void)xb_add(&bar[XB_XCNT(b.x)], 1u);
    return b;
}
__device__ __forceinline__ void xcd_barrier_complete(unsigned* bar, unsigned x, unsigned& nloc, unsigned& nx) {
    const unsigned G = gridDim.x * gridDim.y * gridDim.z;
    unsigned sum, cnt, mine, sp = 0u;
    for (;;) {
        sum = 0u; cnt = 0u; mine = 0u;
#pragma unroll
        for (unsigned j = 0; j < 16; ++j) { const unsigned c = xb_ld(&bar[XB_XCNT(j)]); sum += c; cnt += (c > 0u) ? 1u : 0u; mine = (j == x) ? c : mine; }
        if (sum == G) break;
        __builtin_amdgcn_s_sleep(1);
        if ((++sp & 255u) == 0u) { if (xb_ld(&bar[XB_TMO])) break; if (sp > XB_SPIN_CAP) { atomicAdd(&bar[XB_TMO], 1u); break; } }
    }
    nloc = mine > 0u ? mine : 1u; nx = cnt > 0u ? cnt : 1u;
}

__device__ __forceinline__ void xcd_barrier(const XcdBarrier& b) {
    asm volatile("s_waitcnt vmcnt(0)" ::: "memory");
    __syncthreads();
    if (threadIdx.x == 0) {
        unsigned* bar = b.bar;
        __builtin_amdgcn_s_waitcnt(0);
        unsigned nloc = b.st[0], nx = b.st[1];
        if (nloc == 0u) { xcd_barrier_complete(bar, b.x, nloc, nx); b.st[0] = nloc; b.st[1] = nx; }
        const unsigned old = xb_add(&bar[XB_XSUB(b.x)], 1u);
        const unsigned gen = old / nloc;
        if (old + 1u == (gen + 1u) * nloc) {
            __builtin_amdgcn_fence(__ATOMIC_RELEASE, "agent");
            asm volatile("s_waitcnt vmcnt(0)" ::: "memory");
            const unsigned og = xb_add(&bar[XB_TOP], 1u);
            const unsigned tg = og / nx;
            if (og + 1u == (tg + 1u) * nx) xb_add(&bar[XB_TOPGEN], 1u);
            else XB_SPIN(xb_ld(&bar[XB_TOPGEN]) == tg, bar);
            __builtin_amdgcn_fence(__ATOMIC_ACQUIRE, "agent");
            xb_add(&bar[XB_XGEN(b.x)], 1u);
            asm volatile("s_waitcnt vmcnt(0)" ::: "memory");
        } else {
            XB_SPIN(xb_ld(&bar[XB_XGEN(b.x)]) == gen, bar);
            __builtin_amdgcn_fence(__ATOMIC_ACQUIRE, "agent");
            asm volatile("s_waitcnt vmcnt(0)" ::: "memory");
        }
    }
    __syncthreads();
}

typedef float f32x16 __attribute__((ext_vector_type(16)));
typedef float f32x2v __attribute__((ext_vector_type(2)));
typedef unsigned u32x2v __attribute__((ext_vector_type(2)));
__device__ __forceinline__ unsigned cvtpk(float lo, float hi) { unsigned r; asm volatile("v_cvt_pk_bf16_f32 %0, %1, %2" : "=v"(r) : "v"(lo), "v"(hi)); return r; }
#define PACK8(P, B) __builtin_bit_cast(bf16x8, (v4u){cvtpk(P[(B) + 0], P[(B) + 1]), cvtpk(P[(B) + 2], P[(B) + 3]), cvtpk(P[(B) + 4], P[(B) + 5]), cvtpk(P[(B) + 6], P[(B) + 7])})
__device__ __forceinline__ float wave_sum(float v) {
#pragma unroll
    for (int o = 1; o < 64; o <<= 1) v += __shfl_xor(v, o);
    return v;
}
__device__ __forceinline__ int pi32(int m) { return (m & ~0xC) | ((m & 4) << 1) | ((m & 8) >> 1); }
__constant__ float kFreq[32] = {
    1.000000000e+00f, 7.498942614e-01f, 5.623413324e-01f, 4.216965139e-01f, 3.162277639e-01f, 2.371373773e-01f, 1.778279394e-01f, 1.333521307e-01f,
    1.000000015e-01f, 7.498941571e-02f, 5.623413250e-02f, 4.216965288e-02f, 3.162277490e-02f, 2.371373773e-02f, 1.778279431e-02f, 1.333521493e-02f,
    9.999999776e-03f, 7.498941850e-03f, 5.623413250e-03f, 4.216964822e-03f, 3.162277630e-03f, 2.371373586e-03f, 1.778279431e-03f, 1.333521446e-03f,
    1.000000047e-03f, 7.498942432e-04f, 5.623413017e-04f, 4.216965172e-04f, 3.162277571e-04f, 2.371373703e-04f, 1.778279402e-04f, 1.333521504e-04f};

struct Ctx { LAS unsigned char* lds; int tid, lane, wave, vcu, G; };

struct WJob { const float* W; const float* gain; bf16* WT; int ldw, K, ncols, col0, gs, gsrc, drow0, item0, mode, pad; };
constexpr int NJOBS = 14;
__device__ __forceinline__ void wt_item(const float* W, const float* gain, bf16* WT, int ldw, int K, int ncols, int col0, int gs, int gsrc, int drow0, LAS float* scr, int item, int lane) {
    const int nblk = ncols / 32, kb = item / nblk, nb = item - kb * nblk, k0 = 64 * kb, n0 = 32 * nb;
    const int grp = n0 / gs, sc0 = col0 + grp * gsrc + (n0 - grp * gs);
    const float* src = W + (size_t)k0 * ldw + sc0 + (lane & 31);
#pragma unroll 8
    for (int i = 0; i < 32; ++i) { const int kk = 2 * i + (lane >> 5); float w = src[(size_t)kk * ldw]; if (gain) w *= gain[k0 + kk]; scr[kk * 33 + (lane & 31)] = w; }
    LDS_WAIT(); asm volatile("" ::: "memory");
    const int c = lane & 7;
#pragma unroll
    for (int j = 0; j < 4; ++j) { const int n = (lane >> 3) + 8 * j; const LAS float* s = scr + (8 * c) * 33 + n;
        v4u o; o.x = cvtpk(s[0 * 33], s[1 * 33]); o.y = cvtpk(s[2 * 33], s[3 * 33]); o.z = cvtpk(s[4 * 33], s[5 * 33]); o.w = cvtpk(s[6 * 33], s[7 * 33]);
        *(GAS v4u*)(WT + (WTILED ? pg8::tiled_off(drow0 + n0 + n, k0 + 8 * c, K) : (size_t)(drow0 + n0 + n) * K + k0 + 8 * c)) = o; }
    LDS_WAIT(); asm volatile("" ::: "memory");
}
struct WTile { const float* src; const float* gain; const float* gsafe; bf16* dst; int ldw, K, n0, mode, drow0; };
__device__ __forceinline__ bool wt_decode(const LAS WJob* jobs, int nblkjobs, int ntiles, int T, int lane, int wave, WTile& t, int hole_lo = 0x7fffffff, int hole_len = 0) {
    if (T >= hole_lo) T += hole_len;
    if (T >= ntiles) return false;
    int j = 0;
    for (int q = 1; q < nblkjobs; ++q) j += (T >= jobs[q].item0) ? 1 : 0;
    const LAS WJob& J = jobs[j];
    const int lt = T - J.item0, nblk = J.ncols >> 8, kb = lt / nblk, nb = lt - kb * nblk, k0 = 64 * kb, n0 = 256 * nb;
    const int nn = n0 + 4 * (lane ^ wave), grp = nn / J.gs, sc = J.col0 + grp * J.gsrc + (nn - grp * J.gs);
    t.src = J.W + (size_t)(k0 + 8 * wave) * J.ldw + sc; t.gain = J.gain ? J.gain + k0 : nullptr; t.gsafe = J.W; t.dst = WTILED ? J.WT + (size_t)kb * 16384 : J.WT + (size_t)J.drow0 * J.K + k0; t.drow0 = J.drow0; t.ldw = J.ldw; t.K = J.K; t.n0 = n0; t.mode = J.mode;
    return true;
}
__device__ __forceinline__ void wt_block_phase(const Ctx& F, const LAS WJob* jobs, int nblkjobs, int tile_lo, int ntiles, int rank, int nranks, int hole_lo = 0x7fffffff, int hole_len = 0) {
    const int lane = F.lane, wave = F.wave, kcl = lane & 7, nl = lane >> 3;
#define WT_ISSUE(t, b, g0, g1) do { const GAS float* gp_ = (const GAS float*)((t).gain ? (t).gain : (t).gsafe) + 8 * kcl; \
        asm volatile("global_load_dwordx4 %0, %1, off" : "=v"(g0) : "v"(gp_) : "memory"); asm volatile("global_load_dwordx4 %0, %1, off offset:16" : "=v"(g1) : "v"(gp_) : "memory");     \
        asm volatile("" ::: "memory"); \
        _Pragma("unroll") for (int i = 0; i < 8; ++i) __builtin_amdgcn_global_load_lds((const GAS unsigned*)((t).src + (size_t)i * (t).ldw), (LAS unsigned*)(F.lds + (b) * 65536 + (8 * wave + i) * 1024), 16, 0, 2); \
        asm volatile("" ::: "memory"); } while (0)
#define WT_STEP(X, bx, gx0, gx1, Y, hy, by, gy0, gy1) do { \
        asm volatile("s_waitcnt vmcnt(0) lgkmcnt(0)\n\ts_barrier" : "+v"(gx0), "+v"(gx1) :: "memory"); \
        T += nranks; hy = wt_decode(jobs, nblkjobs, ntiles, T, lane, wave, Y, hole_lo, hole_len); \
        if (hy) WT_ISSUE(Y, by, gy0, gy1); \
        {   const LAS unsigned char* buf = F.lds + (bx) * 65536; \
            const f32x4 one4 = {1.f, 1.f, 1.f, 1.f}; const f32x4 ga = (X).gain ? gx0 : one4, gb = (X).gain ? gx1 : one4; \
            _Pragma("unroll") for (int c = 0; c < 4; ++c) { const int n = 8 * (wave + 8 * c) + nl; \
                const LAS unsigned char* p = buf + (8 * kcl) * 1024 + ((((n >> 2) ^ kcl)) << 4) + ((n & 3) << 2); \
                float v[8]; \
                _Pragma("unroll") for (int e = 0; e < 8; ++e) v[e] = *(const LAS float*)(p + e * 1024); \
                v4u o; o.x = cvtpk(v[0] * ga.x, v[1] * ga.y); o.y = cvtpk(v[2] * ga.z, v[3] * ga.w); o.z = cvtpk(v[4] * gb.x, v[5] * gb.y); o.w = cvtpk(v[6] * gb.z, v[7] * gb.w); \
                int dn = (X).n0 + n; \
                if ((X).mode == 1) { const int hd = dn / DQK; int cl = dn - hd * DQK; if (cl >= DNOPE) { const int w = (cl - DNOPE) >> 5, pp = (cl - DNOPE) & 31; cl = DNOPE + 2 * pp + w; } dn = hd * DQK + cl; } \
                else if ((X).mode == 2) { dn = dn < DFF ? ((dn >> 7) * 256 + (dn & 127)) : (((dn - DFF) >> 7) * 256 + 128 + ((dn - DFF) & 127)); } \
                if (WTILED) { dn += (X).drow0; *(GAS v4u*)((X).dst + (size_t)(dn >> 8) * ((size_t)(X).K << 8) + ((dn & 255) << 6) + 8 * kcl) = o; } \
                else *(GAS v4u*)((X).dst + (size_t)dn * (X).K + 8 * kcl) = o; } } } while (0)
    WTile A, B;
    f32x4 gA0, gA1, gB0, gB1;
    gA0 = gA1 = gB0 = gB1 = (f32x4){1.f, 1.f, 1.f, 1.f};
    int T = tile_lo + rank;
    bool hA = wt_decode(jobs, nblkjobs, ntiles, T, lane, wave, A, hole_lo, hole_len), hB = false;
    if (!hA) return;
    WT_ISSUE(A, 0, gA0, gA1);
    for (;;) {
        WT_STEP(A, 0, gA0, gA1, B, hB, 1, gB0, gB1);
        if (!hB) break;
        WT_STEP(B, 1, gB0, gB1, A, hA, 0, gA0, gA1);
        if (!hA) break;
    }
    asm volatile("s_waitcnt vmcnt(0) lgkmcnt(0)\n\ts_barrier" ::: "memory");
#undef WT_STEP
#undef WT_ISSUE
}
__device__ __forceinline__ void sincos_d(float angf, float& s, float& c) {
    const double x = (double)angf;
    const double kd = __builtin_rint(x * 0.63661977236758134308);
    double r = __builtin_fma(-kd, 1.57079632679489655800e+00, x);
    r = __builtin_fma(-kd, 6.12323399573676603587e-17, r);
    const int k = (int)kd;
    const double r2 = r * r;
    double sp = 1.0 / 6227020800.0;
    sp = sp * r2 - 1.0 / 39916800.0; sp = sp * r2 + 1.0 / 362880.0; sp = sp * r2 - 1.0 / 5040.0; sp = sp * r2 + 1.0 / 120.0; sp = sp * r2 - 1.0 / 6.0; sp = sp * r2 + 1.0; sp = sp * r;
    double cp = -1.0 / 87178291200.0;
    cp = cp * r2 + 1.0 / 479001600.0; cp = cp * r2 - 1.0 / 3628800.0; cp = cp * r2 + 1.0 / 40320.0; cp = cp * r2 - 1.0 / 720.0; cp = cp * r2 + 1.0 / 24.0; cp = cp * r2 - 0.5; cp = cp * r2 + 1.0;
    const int q = k & 3;
    const double ss = (q == 0) ? sp : (q == 1) ? cp : (q == 2) ? -sp : -cp;
    const double cc = (q == 0) ? cp : (q == 1) ? -sp : (q == 2) ? -cp : sp;
    s = (float)ss; c = (float)cc;
}

template <int MODE, bool HF32>
__device__ __forceinline__ void rows_phase(const Ctx& F, const void* src, const void* Hin, const float* g, float* outf, bf16* HB, float* RS) {
    const int gw = F.vcu * NWAVES + F.wave, NGW = F.G * NWAVES;
#define UNPK8(dst, w) do { dst[0] = (f32x4){__uint_as_float((w).x << 16), __uint_as_float((w).x & 0xffff0000u), __uint_as_float((w).y << 16), __uint_as_float((w).y & 0xffff0000u)}; \
                           dst[1] = (f32x4){__uint_as_float((w).z << 16), __uint_as_float((w).z & 0xffff0000u), __uint_as_float((w).w << 16), __uint_as_float((w).w & 0xffff0000u)}; } while (0)
    for (int m = gw; m < M; m += NGW) {
        if (MODE == 0) {
            const GAS f32x4* a = (const GAS f32x4*)((const float*)src + (size_t)m * DM) + F.lane;
            f32x4 v[16]; float ss = 0.f;
#pragma unroll
            for (int j = 0; j < 16; ++j) { v[j] = a[64 * j]; ss += (v[j].x * v[j].x + v[j].y * v[j].y) + (v[j].z * v[j].z + v[j].w * v[j].w); }
            const float rstd = 1.0f / sqrtf(wave_sum(ss) * (1.0f / DM) + EPS);
            if (F.lane == 0) RS[m] = rstd;
            GAS unsigned long long* o8 = (GAS unsigned long long*)(HB + (size_t)m * DM) + F.lane;
#pragma unroll
            for (int j = 0; j < 16; ++j) o8[64 * j] = (unsigned long long)cvtpk(v[j].x, v[j].y) | ((unsigned long long)cvtpk(v[j].z, v[j].w) << 32);
        } else {
            const GAS v4u* a = (const GAS v4u*)((const bf16*)src + (size_t)m * DM) + F.lane;
            f32x4 v[8][2]; float ss = 0.f;
#pragma unroll
            for (int j = 0; j < 8; ++j) { const v4u w = a[64 * j]; UNPK8(v[j], w);
#pragma unroll
                for (int e = 0; e < 2; ++e) ss += (v[j][e].x * v[j][e].x + v[j][e].y * v[j][e].y) + (v[j][e].z * v[j][e].z + v[j][e].w * v[j][e].w); }
            const float rstd = 1.0f / sqrtf(wave_sum(ss) * (1.0f / DM) + EPS);
            const GAS f32x4* gp = (const GAS f32x4*)g + 2 * F.lane;
            float s2 = 0.f;
#pragma unroll
            for (int j = 0; j < 8; ++j) {
                f32x4 hv[2];
                if (HF32) { const GAS f32x4* hp = (const GAS f32x4*)((const float*)Hin + (size_t)m * DM) + 2 * F.lane; hv[0] = hp[128 * j]; hv[1] = hp[128 * j + 1]; }
                else      { const v4u w = ((const GAS v4u*)((const bf16*)Hin + (size_t)m * DM) + F.lane)[64 * j]; UNPK8(hv, w); }
#pragma unroll
                for (int e = 0; e < 2; ++e) { const f32x4 gv = gp[128 * j + e]; const f32x4 o = hv[e] + (v[j][e] * rstd) * gv; v[j][e] = o; s2 += (o.x * o.x + o.y * o.y) + (o.z * o.z + o.w * o.w); }
            }
            if (MODE == 1) {
                const float rstd2 = 1.0f / sqrtf(wave_sum(s2) * (1.0f / DM) + EPS);
                if (F.lane == 0) RS[m] = rstd2;
                GAS v4u* o16 = (GAS v4u*)(HB + (size_t)m * DM) + F.lane;
#pragma unroll
                for (int j = 0; j < 8; ++j) { v4u w; w.x = cvtpk(v[j][0].x, v[j][0].y); w.y = cvtpk(v[j][0].z, v[j][0].w); w.z = cvtpk(v[j][1].x, v[j][1].y); w.w = cvtpk(v[j][1].z, v[j][1].w); o16[64 * j] = w; }
            } else {
                GAS f32x4* op = (GAS f32x4*)(outf + (size_t)m * DM) + 2 * F.lane;
#pragma unroll
                for (int j = 0; j < 8; ++j) { op[128 * j] = v[j][0]; op[128 * j + 1] = v[j][1]; }
            }
        }
    }
#undef UNPK8
}
__device__ __forceinline__ void latent_rows_phase(const Ctx& F, const float* CQKV, const float* CS, bf16* CQN, bf16* CKV, bf16* K) {
    const int gw = F.vcu * NWAVES + F.wave, NGW = F.G * NWAVES, lane = F.lane, l32 = lane & 31;
    for (int m = gw; m < M; m += NGW) {
        const float* row = CQKV + (size_t)m * N1;
        { const GAS f32x4* a = (const GAS f32x4*)row + lane; f32x4 v[4]; float ss = 0.f;
#pragma unroll
          for (int j = 0; j < 4; ++j) { v[j] = a[64 * j]; ss += (v[j].x * v[j].x + v[j].y * v[j].y) + (v[j].z * v[j].z + v[j].w * v[j].w); }
          const float rstd = 1.0f / sqrtf(wave_sum(ss) * (1.0f / QLORA) + EPS);
          GAS unsigned long long* o8 = (GAS unsigned long long*)(CQN + (size_t)m * QLORA) + lane;
#pragma unroll
          for (int j = 0; j < 4; ++j) o8[64 * j] = (unsigned long long)cvtpk(v[j].x * rstd, v[j].y * rstd) | ((unsigned long long)cvtpk(v[j].z * rstd, v[j].w * rstd) << 32); }
        { const GAS f32x4* a = (const GAS f32x4*)(row + QLORA) + lane; f32x4 v[2]; float ss = 0.f;
#pragma unroll
          for (int j = 0; j < 2; ++j) { v[j] = a[64 * j]; ss += (v[j].x * v[j].x + v[j].y * v[j].y) + (v[j].z * v[j].z + v[j].w * v[j].w); }
          const float rstd = 1.0f / sqrtf(wave_sum(ss) * (1.0f / KVLORA) + EPS);
          GAS unsigned long long* o8 = (GAS unsigned long long*)(CKV + (size_t)m * KVLORA) + lane;
#pragma unroll
          for (int j = 0; j < 2; ++j) o8[64 * j] = (unsigned long long)cvtpk(v[j].x * rstd, v[j].y * rstd) | ((unsigned long long)cvtpk(v[j].z * rstd, v[j].w * rstd) << 32); }
        { const float x1 = row[QLORA + KVLORA + l32], x2 = row[QLORA + KVLORA + 32 + l32];
          const float co = CS[(size_t)m * 64 + l32], si = CS[(size_t)m * 64 + 32 + l32];
          const float o1 = x1 * co - x2 * si, o2 = x2 * co + x1 * si;
          const int a = (2 * l32) & 31, which = l32 >> 4;
          const float a0 = __shfl(o1, a), a1 = __shfl(o1, a + 1), b0 = __shfl(o2, a), b1 = __shfl(o2, a + 1);
          const unsigned w = cvtpk(which ? b0 : a0, which ? b1 : a1);
          GAS unsigned* kd = (GAS unsigned*)(K + (size_t)m * QW + DNOPE) + l32;
#pragma unroll
          for (int it = 0; it < 16; ++it) { const int head = 2 * it + (lane >> 5); kd[head * (DQK / 2)] = w; } }
    }
}
__device__ __forceinline__ void q_rope_phase(const Ctx& F, const float* QF, const float* CS, bf16* Q) {
    const int gw = F.vcu * NWAVES + F.wave, NGW = F.G * NWAVES, lane = F.lane, l32 = lane & 31;
    for (int m = gw; m < M; m += NGW) {
        const float* qrow = QF + (size_t)m * QW; bf16* qo = Q + (size_t)m * QW;
        const float co = CS[(size_t)m * 64 + l32], si = CS[(size_t)m * 64 + 32 + l32];
        const int a = (2 * l32) & 31, which = l32 >> 4;
#pragma unroll 4
        for (int h = 0; h < NH; ++h) {
            const int base = h * DQK;
            const f32x2v nv = *(const GAS f32x2v*)(qrow + base + 2 * lane);
            *(GAS unsigned*)(qo + base + 2 * lane) = cvtpk(nv.x * QS0, nv.y * QS0);
            const float x1 = qrow[base + DNOPE + l32], x2 = qrow[base + DNOPE + 32 + l32];
            const float o1 = (x1 * co - x2 * si) * QS0, o2 = (x2 * co + x1 * si) * QS0;
            const float a0 = __shfl(o1, a), a1 = __shfl(o1, a + 1), b0 = __shfl(o2, a), b1 = __shfl(o2, a + 1);
            const unsigned w = cvtpk(which ? b0 : a0, which ? b1 : a1);
            if (lane < 32) *(GAS unsigned*)(qo + base + DNOPE + 2 * lane) = w;
        }
    }
}
__device__ __forceinline__ void conv_fix_phase(const Ctx& F, const float* PART, const float* HALO, const float* cw, const float* cb, bf16* ACT) {
    constexpr int NJ = DFF / 4, NB = M / 64;
    const int gt = F.vcu * (NWAVES * 64) + F.tid, NT = F.G * NWAVES * 64;
    for (int it = gt; it < NB * 2 * NJ; it += NT) {
        const int j = 4 * (it % NJ), br = it / NJ, r = br & 1, blk = br >> 1;
        const float* pp = PART + ((size_t)(blk * 2 + r) * 2) * DFF + j;
        f32x4 G = *(const GAS f32x4*)pp, V = *(const GAS f32x4*)(pp + DFF);
        if ((blk % (SEQ / 64)) != 0) {
            const float* h0 = HALO + ((size_t)((blk - 1) * 2 + 0) * 2) * DFF + j; const float* h1 = HALO + ((size_t)((blk - 1) * 2 + 1) * 2) * DFF + j;
            const f32x4 wg0 = *(const GAS f32x4*)(cw + j), wg1 = *(const GAS f32x4*)(cw + DFF2 + j), wv0 = *(const GAS f32x4*)(cw + DFF + j), wv1 = *(const GAS f32x4*)(cw + DFF2 + DFF + j);
            const f32x4 g62 = *(const GAS f32x4*)h0, v62 = *(const GAS f32x4*)(h0 + DFF), g63 = *(const GAS f32x4*)h1, v63 = *(const GAS f32x4*)(h1 + DFF);
            if (r == 0) { G += wg0 * g62 + wg1 * g63; V += wv0 * v62 + wv1 * v63; }
            else        { G += wg0 * g63;             V += wv0 * v63; }
        }
        float o[4];
#pragma unroll
        for (int e = 0; e < 4; ++e) o[e] = G[e] * __builtin_amdgcn_rcpf(1.0f + __builtin_amdgcn_exp2f(-G[e] * LOG2E)) * V[e];
        u32x2v w; w.x = cvtpk(o[0], o[1]); w.y = cvtpk(o[2], o[3]);
        *(GAS u32x2v*)(ACT + (pg8::EpiConvAct::ATILED ? pg8::tiled_off(64 * blk + r, j, DFF) : (size_t)(64 * blk + r) * DFF + j)) = w;
    }
}

constexpr bool PIGGY = false;
constexpr int PG_LDS = 98304;
struct PgState {
    int next_T, end_T;
    int job, job_end, kb, nb, nblk;
    int cnt; bool pend0, pend1;
};
constexpr int PG_STASH = 131072 + 4096;
__device__ __forceinline__ void pg_setjob(PgState& S, const LAS WJob* jobs, int nblkjobs) {
    const int T = S.next_T;
    int j = 0;
    for (int q = 1; q < nblkjobs; ++q) j += (T >= jobs[q].item0) ? 1 : 0;
    S.job = j; S.job_end = (j + 1 < nblkjobs) ? jobs[j + 1].item0 : 0x7fffffff;
    S.nblk = jobs[j].ncols >> 8;
    const int lt = T - jobs[j].item0; S.kb = lt / S.nblk; S.nb = lt - S.kb * S.nblk;
}
__device__ __forceinline__ void pg_issue(PgState& S, int step_T, int sub, const LAS WJob* jobs, int nblkjobs, LAS unsigned char* ldsw, LAS unsigned* stash, int wid, int lane) {
    if (S.next_T >= S.job_end) pg_setjob(S, jobs, nblkjobs);
    const LAS WJob& J = jobs[S.job];
    const int ldw = J.ldw, K = J.K;
    const int k0 = 128 * S.kb + 64 * (sub >> 2) + 8 * wid, n0 = 256 * S.nb + 64 * (sub & 3);
    const float* src = J.W + ((size_t)k0 * ldw + J.col0 + n0) + ((lane >> 4) * ldw + 4 * (lane & 15));
    __builtin_amdgcn_global_load_lds((const GAS unsigned*)src, (LAS unsigned*)ldsw, 16, 0, 0);
    __builtin_amdgcn_global_load_lds((const GAS unsigned*)(src + (size_t)4 * ldw), (LAS unsigned*)(ldsw + 1024), 16, 0, 0);
    int dn0 = n0;
    if (J.mode == 2) dn0 = n0 < DFF ? ((n0 >> 7) * 256 + (n0 & 127)) : (((n0 - DFF) >> 7) * 256 + 128 + ((n0 - DFF) & 127));
    const unsigned long long dst = (unsigned long long)(J.WT + (size_t)(J.drow0 + dn0) * K + k0), gp = J.gain ? (unsigned long long)(J.gain + k0) : 0ull;
    if (lane == 0) { stash[0] = (unsigned)dst; stash[1] = (unsigned)(dst >> 32); stash[2] = (unsigned)gp; stash[3] = (unsigned)(gp >> 32); stash[4] = (unsigned)K; }
    S.next_T += step_T; S.nb += step_T;
    while (S.nb >= S.nblk) { S.nb -= S.nblk; ++S.kb; }
    ++S.cnt;
}
typedef float f32x8s __attribute__((ext_vector_type(8)));
__device__ __forceinline__ void pg_consume(const LAS unsigned char* ldsw, const LAS unsigned* stash, int lane) {
    const unsigned d0 = stash[0], d1 = stash[1], g0_ = stash[2], g1_ = stash[3], K = stash[4];
    const unsigned long long gu = ((unsigned long long)(unsigned)__builtin_amdgcn_readfirstlane((int)g1_) << 32) | (unsigned)__builtin_amdgcn_readfirstlane((int)g0_);
    f32x8s g = {1.f, 1.f, 1.f, 1.f, 1.f, 1.f, 1.f, 1.f};
    if (gu != 0ull) asm volatile("s_load_dwordx8 %0, %1, 0x0" : "=s"(g) : "s"(gu));
    float v[8];
#pragma unroll
    for (int e = 0; e < 8; ++e) v[e] = *(const LAS float*)(ldsw + e * 256 + 4 * lane);
    asm volatile("s_waitcnt lgkmcnt(0)" : "+s"(g) :: "memory");
    v4u o; o.x = cvtpk(v[0] * g[0], v[1] * g[1]); o.y = cvtpk(v[2] * g[2], v[3] * g[3]); o.z = cvtpk(v[4] * g[4], v[5] * g[5]); o.w = cvtpk(v[6] * g[6], v[7] * g[7]);
    bf16* dst = (bf16*)(((unsigned long long)d1 << 32) | d0) + (size_t)lane * K;
    *(GAS v4u*)dst = o;
}

constexpr int MLA_KB = 64 * 384, MLA_VB = 128 * 128, MLA_V0 = 2 * MLA_KB;
template <int VAR>
__device__ __forceinline__ void mla_unit(LAS unsigned char* lds, const bf16* __restrict__ Q, const bf16* __restrict__ K, const bf16* __restrict__ VT, bf16* __restrict__ O, int b, int h, int qb, PgState& PS, const LAS WJob* jobs, int pg_step, int pg_sub) {
    const int tid = threadIdx.x, lane = tid & 63, wid = __builtin_amdgcn_readfirstlane(tid >> 6), l32 = lane & 31, hi = lane >> 5;
    const int NT = 4 * (qb + 1), rowb = b * SEQ;
    unsigned kgo[3], vgo[2];
#pragma unroll
    for (int i = 0; i < 3; ++i) { const int s_ = 64 * (3 * wid + i) + lane, row = s_ / 24, pos = s_ - 24 * row, c = (pos & ~7) | ((pos & 7) ^ ((row >> 1) & 7));
        kgo[i] = (unsigned)(((rowb + row) * QW + h * DQK + 8 * c) * 2); }
#pragma unroll
    for (int i = 0; i < 2; ++i) { const int s_ = 64 * (2 * wid + i) + lane, d = s_ >> 3, pos = s_ & 7, c = pos ^ ((d >> 1) & 7);
        vgo[i] = (unsigned)(((h * DV + d) * M + rowb + 8 * c) * 2); }
    const char* Kb = (const char*)K; const char* Vb = (const char*)VT;
    const __amdgpu_buffer_rsrc_t srdK = __builtin_amdgcn_make_buffer_rsrc((void*)Kb, (short)0, (int)((size_t)M * QW * 2), 0x00020000);
    const __amdgpu_buffer_rsrc_t srdV = __builtin_amdgcn_make_buffer_rsrc((void*)Vb, (short)0, (int)((size_t)NH * DV * M * 2), 0x00020000);
#define MLA_DMA(t_, kslot, vslot) do { \
        _Pragma("unroll") for (int i = 0; i < 3; ++i) __builtin_amdgcn_raw_ptr_buffer_load_lds(srdK, (LAS void*)(lds + (kslot) * MLA_KB + (3 * wid + i) * 1024), 16, kgo[i], (int)((unsigned)(t_) * (unsigned)(64 * QW * 2)), 0, 0); \
        _Pragma("unroll") for (int i = 0; i < 2; ++i) __builtin_amdgcn_raw_ptr_buffer_load_lds(srdV, (LAS void*)(lds + MLA_V0 + (vslot) * MLA_VB + (2 * wid + i) * 1024), 16, vgo[i], (int)((unsigned)(t_) * 128u), 0, 0); } while (0)
    MLA_DMA(0, 0, 0);
    const int qrow = rowb + 256 * qb + 32 * wid + l32;
    bf16x8 qr[12];
#pragma unroll
    for (int d0 = 0; d0 < 12; ++d0) qr[d0] = *(const GAS bf16x8*)(Q + (size_t)qrow * QW + h * DQK + 16 * d0 + 8 * hi);
    float m_run = -1e30f, lsum = 0.f;
    f32x16 o[4];
#pragma unroll
    for (int d = 0; d < 4; ++d)
#pragma unroll
        for (int r = 0; r < 16; ++r) o[d][r] = 0.f;
    int kfb[4], vfb[4];
    { const int kr = pi32(l32), fk = (kr >> 1) & 7, fv = (l32 >> 1) & 7;
#pragma unroll
      for (int j = 0; j < 4; ++j) { kfb[j] = kr * 384 + 16 * ((2 * j + hi) ^ fk); vfb[j] = l32 * 128 + 16 * ((2 * j + hi) ^ fv); } }
    const int qpos = 256 * qb + 32 * wid + l32;
    const bool halfB = wid >= 4;
    bf16x8 pb0, pb1, pb2, pb3;
#pragma unroll
    for (int e = 0; e < 8; ++e) { pb0[e] = 0; pb1[e] = 0; pb2[e] = 0; pb3[e] = 0; }
#define MLA_VLD(dst, d_) do { dst[0] = *(const LAS bf16x8*)(vp_ + vfb[0] + (d_) * 4096); dst[1] = *(const LAS bf16x8*)(vp_ + vfb[1] + (d_) * 4096); \
                              dst[2] = *(const LAS bf16x8*)(vp_ + vfb[2] + (d_) * 4096); dst[3] = *(const LAS bf16x8*)(vp_ + vfb[3] + (d_) * 4096); } while (0)
#define MLA_PVD(d_, vv) do { o[d_] = __builtin_amdgcn_mfma_f32_32x32x16_bf16(vv[0], pb0, o[d_], 0, 0, 0); o[d_] = __builtin_amdgcn_mfma_f32_32x32x16_bf16(vv[1], pb1, o[d_], 0, 0, 0); \
                             o[d_] = __builtin_amdgcn_mfma_f32_32x32x16_bf16(vv[2], pb2, o[d_], 0, 0, 0); o[d_] = __builtin_amdgcn_mfma_f32_32x32x16_bf16(vv[3], pb3, o[d_], 0, 0, 0); } while (0)
#define MLA_PV(vslot) do { const LAS unsigned char* vp_ = lds + MLA_V0 + (vslot) * MLA_VB; bf16x8 va[4], vb[4], vc[4]; \
        MLA_VLD(va, 0); MLA_VLD(vb, 1); MLA_VLD(vc, 2); __builtin_amdgcn_sched_barrier(0); MLA_PVD(0, va); __builtin_amdgcn_sched_barrier(0); \
        MLA_VLD(va, 3); __builtin_amdgcn_sched_barrier(0); MLA_PVD(1, vb); __builtin_amdgcn_sched_barrier(0); \
        MLA_PVD(2, vc); __builtin_amdgcn_sched_barrier(0); MLA_PVD(3, va); __builtin_amdgcn_sched_barrier(0); } while (0)
    __syncthreads();
    int vs = 0;
    for (int t = 0; t < NT; ++t) {
        const int bs = t & 1; const bool more = (t + 1) < NT;
        const int vs_prev = (vs == 0) ? 2 : vs - 1, vs_next = (vs == 2) ? 0 : vs + 1;
        if (more && VAR != 1 && VAR != 3 && VAR != 4) MLA_DMA(t + 1, bs ^ 1, vs_next);
        bool pg_st = false, pg_is = false;
        if (VAR == 0 && PIGGY) {
            const int slot = PS.cnt & 1;
            LAS unsigned char* ldsw = lds + PG_LDS + slot * 16384 + wid * 2048;
            LAS unsigned* stash = (LAS unsigned*)(lds + PG_STASH + wid * 64 + slot * 32);
            if (slot == 0 ? PS.pend0 : PS.pend1) { pg_consume(ldsw, stash, lane); pg_st = true; if (slot == 0) PS.pend0 = false; else PS.pend1 = false; }
            if (PS.next_T < PS.end_T) { pg_issue(PS, pg_step, pg_sub, jobs, NJOBS - 1, ldsw, stash, wid, lane); pg_is = true; if (slot == 0) PS.pend0 = true; else PS.pend1 = true; }
        }
        const bool active = (VAR != 2) && (64 * t <= 256 * qb + 32 * wid + 31);
        if (VAR != 2 && halfB && t > 0 && (64 * (t - 1) <= 256 * qb + 32 * wid + 31)) MLA_PV(vs_prev);
        if (active) {
            const LAS unsigned char* kp = lds + bs * MLA_KB;
            f32x16 p0, p1;
#pragma unroll
            for (int r = 0; r < 16; ++r) { p0[r] = 0.f; p1[r] = 0.f; }
            {
                bf16x8 ka[4], kc[4];
#define MLA_KLD(d0_, slot_) do { ka[slot_] = *(const LAS bf16x8*)(kp + kfb[(d0_) & 3] + 128 * ((d0_) >> 2)); kc[slot_] = *(const LAS bf16x8*)(kp + kfb[(d0_) & 3] + 128 * ((d0_) >> 2) + 32 * 384); } while (0)
                MLA_KLD(0, 0); MLA_KLD(1, 1); MLA_KLD(2, 2);
                __builtin_amdgcn_sched_barrier(0);
#pragma unroll
                for (int d0 = 0; d0 < 12; ++d0) {
                    if (d0 + 3 < 12) MLA_KLD(d0 + 3, (d0 + 3) & 3);
                    __builtin_amdgcn_sched_barrier(0);
                    p0 = __builtin_amdgcn_mfma_f32_32x32x16_bf16(ka[d0 & 3], qr[d0], p0, 0, 0, 0);
                    p1 = __builtin_amdgcn_mfma_f32_32x32x16_bf16(kc[d0 & 3], qr[d0], p1, 0, 0, 0);
                    __builtin_amdgcn_sched_barrier(0);
                }
#undef MLA_KLD
            }
            if (VAR != 3 && VAR != 4) {
            if (64 * t + 63 > 256 * qb + 32 * wid) {
                const int kb0 = 64 * t + 8 * hi;
#pragma unroll
                for (int r = 0; r < 16; ++r) { const int key = kb0 + 16 * (r >> 3) + (r & 7);
                    if (key > qpos) p0[r] = -__builtin_inff(); if (key + 32 > qpos) p1[r] = -__builtin_inff(); }
            }
            float mx = p0[0];
#pragma unroll
            for (int r = 1; r < 16; ++r) mx = fmaxf(mx, p0[r]);
#pragma unroll
            for (int r = 0; r < 16; ++r) mx = fmaxf(mx, p1[r]);
            mx = fmaxf(mx, __shfl_xor(mx, 32));
            if (__any(mx > m_run + 8.0f)) {
                const float m_new = fmaxf(m_run, mx), alpha = __builtin_amdgcn_exp2f(m_run - m_new);
                m_run = m_new; lsum *= alpha;
#pragma unroll
                for (int d = 0; d < 4; ++d)
#pragma unroll
                    for (int r = 0; r < 16; ++r) o[d][r] *= alpha;
            }
            float ps = 0.f, ps1 = 0.f;
#pragma unroll
            for (int r = 0; r < 16; ++r) { p0[r] = __builtin_amdgcn_exp2f(p0[r] - m_run); p1[r] = __builtin_amdgcn_exp2f(p1[r] - m_run);
                asm("v_add_f32 %0, %0, %1" : "+v"(ps) : "v"(p0[r])); asm("v_add_f32 %0, %0, %1" : "+v"(ps1) : "v"(p1[r])); }
            lsum += ps + ps1;
            }
            pb0 = PACK8(p0, 0); pb1 = PACK8(p0, 8); pb2 = PACK8(p1, 0); pb3 = PACK8(p1, 8);
            if (!halfB) MLA_PV(vs);
        }
        if (VAR != 0 || !PIGGY || (!pg_st && !pg_is)) __syncthreads();
        else if (pg_st && pg_is) asm volatile("s_waitcnt vmcnt(3) lgkmcnt(0)\n\ts_barrier" ::: "memory");
        else if (pg_is)          asm volatile("s_waitcnt vmcnt(2) lgkmcnt(0)\n\ts_barrier" ::: "memory");
        else                     asm volatile("s_waitcnt vmcnt(1) lgkmcnt(0)\n\ts_barrier" ::: "memory");
        vs = vs_next;
    }
    if (VAR != 2 && halfB && (64 * (NT - 1) <= 256 * qb + 32 * wid + 31)) MLA_PV((vs == 0) ? 2 : vs - 1);
    __syncthreads();
#undef MLA_PV
#undef MLA_PVD
#undef MLA_VLD
#undef MLA_DMA
    const float ltot = lsum + __shfl_xor(lsum, 32);
    const float inv = 1.0f / ltot;
    bf16* orow = O + (size_t)qrow * DM + h * DV + 8 * hi;
#pragma unroll
    for (int d = 0; d < 4; ++d)
#pragma unroll
        for (int j = 0; j < 2; ++j) {
            const unsigned e0 = cvtpk(o[d][8 * j] * inv, o[d][8 * j + 1] * inv), e1 = cvtpk(o[d][8 * j + 2] * inv, o[d][8 * j + 3] * inv);
            const unsigned q0 = cvtpk(o[d][8 * j + 4] * inv, o[d][8 * j + 5] * inv), q1 = cvtpk(o[d][8 * j + 6] * inv, o[d][8 * j + 7] * inv);
            const auto s0 = __builtin_amdgcn_permlane32_swap(e0, q0, false, false), s1 = __builtin_amdgcn_permlane32_swap(e1, q1, false, false);
            v4u w; w.x = s0[0]; w.y = s1[0]; w.z = s0[1]; w.w = s1[1];
            *(GAS v4u*)(orow + 32 * d + 16 * j) = w; }
}
template <int VAR>
__device__ __forceinline__ void mla_attn_phase(const Ctx& F, const bf16* Q, const bf16* K, const bf16* VT, bf16* O, const LAS WJob* jobs, int pg_lo, int pg_hi) {
    PgState PS;
    const int pg_step = F.G >> 3, pg_sub = F.vcu & 7;
    PS.next_T = pg_lo + (F.vcu >> 3); PS.end_T = (VAR == 0 && PIGGY) ? pg_hi : 0; PS.job = 0; PS.job_end = 0; PS.kb = 0; PS.nb = 0; PS.nblk = 1; PS.cnt = 0; PS.pend0 = false; PS.pend1 = false;
    for (int L = F.vcu; L < BATCH * NH * 8; L += F.G) {
        const int bh = L >> 3, p = L & 7;
        mla_unit<VAR>(F.lds, Q, K, VT, O, bh / NH, bh % NH, 15 - p, PS, jobs, pg_step, pg_sub);
        mla_unit<VAR>(F.lds, Q, K, VT, O, bh / NH, bh % NH, p, PS, jobs, pg_step, pg_sub);
    }
    if (VAR == 0 && PIGGY) {
        asm volatile("s_waitcnt vmcnt(0)" ::: "memory");
        if (PS.pend0) { pg_consume(F.lds + PG_LDS + F.wave * 2048, (const LAS unsigned*)(F.lds + PG_STASH + F.wave * 64), F.lane); PS.pend0 = false; }
        if (PS.pend1) { pg_consume(F.lds + PG_LDS + 16384 + F.wave * 2048, (const LAS unsigned*)(F.lds + PG_STASH + F.wave * 64 + 32), F.lane); PS.pend1 = false; }
        while (PS.next_T < PS.end_T) { LAS unsigned char* ldsw = F.lds + PG_LDS + F.wave * 2048; LAS unsigned* stash = (LAS unsigned*)(F.lds + PG_STASH + F.wave * 64);
            pg_issue(PS, pg_step, pg_sub, jobs, NJOBS - 1, ldsw, stash, F.wave, F.lane); asm volatile("s_waitcnt vmcnt(0)" ::: "memory"); pg_consume(ldsw, stash, F.lane); }
    }
}

constexpr int SWA_KBYTES = 256 * 144, SWA_VROW = 528;
struct SwaStage { v4u k[4], v[4]; };
__device__ __forceinline__ void swa_load(SwaStage& S, const bf16* __restrict__ QK, int b, int g, int n) {
    const int tid = threadIdx.x, kv0 = b * SEQ + WIN * (n - 1);
#pragma unroll
    for (int i = 0; i < 4; ++i) { const int idx = tid + 512 * i, kk = idx >> 3, c = idx & 7; S.k[i] = (v4u){0u, 0u, 0u, 0u}; S.v[i] = (v4u){0u, 0u, 0u, 0u};
        if (n > 0 || kk >= WIN) { S.k[i] = *(const GAS v4u*)(QK + (size_t)(kv0 + kk) * QK1W + 4096 + g * SWD + 8 * c); S.v[i] = *(const GAS v4u*)(QK + (size_t)(kv0 + kk) * QK1W + 4608 + g * SWD + 8 * c); } }
}
__device__ __forceinline__ void swa_store(const SwaStage& S, LAS unsigned char* lds) {
    const int tid = threadIdx.x;
#pragma unroll
    for (int i = 0; i < 4; ++i) { const int idx = tid + 512 * i, kk = idx >> 3, c = idx & 7;
        *(LAS v4u*)(lds + kk * 144 + 16 * c) = S.k[i];
        const v4u v = S.v[i];
        LAS unsigned short* vt = (LAS unsigned short*)(lds + SWA_KBYTES + (8 * c) * SWA_VROW + 2 * kk);
        vt[0 * (SWA_VROW / 2)] = (unsigned short)(v.x & 0xffffu); vt[1 * (SWA_VROW / 2)] = (unsigned short)(v.x >> 16); vt[2 * (SWA_VROW / 2)] = (unsigned short)(v.y & 0xffffu); vt[3 * (SWA_VROW / 2)] = (unsigned short)(v.y >> 16);
        vt[4 * (SWA_VROW / 2)] = (unsigned short)(v.z & 0xffffu); vt[5 * (SWA_VROW / 2)] = (unsigned short)(v.z >> 16); vt[6 * (SWA_VROW / 2)] = (unsigned short)(v.w & 0xffffu); vt[7 * (SWA_VROW / 2)] = (unsigned short)(v.w >> 16); }
}
__device__ __forceinline__ void swa_compute(LAS unsigned char* lds, const bf16* __restrict__ QK, bf16* __restrict__ O, const float* __restrict__ sinks, int b, int g, int n) {
    const int tid = threadIdx.x, lane = tid & 63, wid = __builtin_amdgcn_readfirstlane(tid >> 6), l32 = lane & 31, hi = lane >> 5;
    const int rowb = b * SEQ;
    const int hh = SWKV * g + wid;
    const float slope2 = exp2f(-(float)(hh + 1) * 0.125f) * LOG2E, sink2 = sinks[hh] * LOG2E;
#pragma unroll 1
    for (int jj = 0; jj < 2; ++jj) {
        bf16x8 qr[2][4];
#pragma unroll
        for (int u = 0; u < 2; ++u)
#pragma unroll
            for (int d0 = 0; d0 < 4; ++d0) qr[u][d0] = *(const GAS bf16x8*)(QK + (size_t)(rowb + WIN * n + 32 * jj + 64 * u + l32) * QK1W + hh * SWD + 16 * d0 + 8 * hi);
        const int qd = WIN + l32 - 8 * hi;
        float m_run[2] = {sink2, sink2}, lsum[2] = {0.f, 0.f};
        f32x16 o[2][2];
#pragma unroll
        for (int u = 0; u < 2; ++u)
#pragma unroll
            for (int d = 0; d < 2; ++d)
#pragma unroll
                for (int r = 0; r < 16; ++r) o[u][d][r] = 0.f;
#pragma unroll 1
        for (int i = 0; i < 5; ++i) {
#pragma unroll
            for (int u = 0; u < 2; ++u) {
                const int j = jj + 2 * u;
                const LAS unsigned char* kp = lds + (32 * j + pi32(l32)) * 144 + 16 * hi;
                const LAS unsigned char* vp = lds + SWA_KBYTES + l32 * SWA_VROW + 64 * j + 16 * hi;
                f32x16 p;
#pragma unroll
                for (int r = 0; r < 16; ++r) p[r] = 0.f;
#pragma unroll
                for (int d0 = 0; d0 < 4; ++d0) p = __builtin_amdgcn_mfma_f32_32x32x16_bf16(*(const LAS bf16x8*)(kp + i * 32 * 144 + 32 * d0), qr[u][d0], p, 0, 0, 0);
                float mx = -__builtin_inff();
#pragma unroll
                for (int r = 0; r < 16; ++r) { const int dist = qd - 32 * i - 16 * (r >> 3) - (r & 7), kk = 32 * (j + i) + 16 * (r >> 3) + 8 * hi + (r & 7);
                    const bool valid = ((unsigned)dist < (unsigned)WIN) && (n > 0 || kk >= WIN);
                    const float sc = valid ? p[r] - slope2 * (float)dist : -__builtin_inff(); p[r] = sc; mx = fmaxf(mx, sc); }
                mx = fmaxf(mx, __shfl_xor(mx, 32));
                const float m_new = fmaxf(m_run[u], mx), alpha = __builtin_amdgcn_exp2f(m_run[u] - m_new);
                m_run[u] = m_new;
                float ps = 0.f;
#pragma unroll
                for (int r = 0; r < 16; ++r) { p[r] = __builtin_amdgcn_exp2f(p[r] - m_new); ps += p[r]; }
                lsum[u] = lsum[u] * alpha + ps;
#pragma unroll
                for (int d = 0; d < 2; ++d)
#pragma unroll
                    for (int r = 0; r < 16; ++r) o[u][d][r] *= alpha;
                const bf16x8 pa = PACK8(p, 0), pb = PACK8(p, 8);
#pragma unroll
                for (int d = 0; d < 2; ++d) {
                    o[u][d] = __builtin_amdgcn_mfma_f32_32x32x16_bf16(*(const LAS bf16x8*)(vp + d * 32 * SWA_VROW + 64 * i), pa, o[u][d], 0, 0, 0);
                    o[u][d] = __builtin_amdgcn_mfma_f32_32x32x16_bf16(*(const LAS bf16x8*)(vp + d * 32 * SWA_VROW + 64 * i + 32), pb, o[u][d], 0, 0, 0);
                }
            }
        }
#pragma unroll
        for (int u = 0; u < 2; ++u) {
            const int j = jj + 2 * u; const int qrow = rowb + WIN * n + 32 * j + l32;
            float ls = lsum[u] + __shfl_xor(lsum[u], 32);
            ls += __builtin_amdgcn_exp2f(sink2 - m_run[u]);
            const float inv = 1.0f / ls;
            bf16* orow = O + (size_t)qrow * DM + hh * SWD + 8 * hi;
#pragma unroll
            for (int d = 0; d < 2; ++d)
#pragma unroll
                for (int j2 = 0; j2 < 2; ++j2) {
                    const unsigned e0 = cvtpk(o[u][d][8 * j2] * inv, o[u][d][8 * j2 + 1] * inv), e1 = cvtpk(o[u][d][8 * j2 + 2] * inv, o[u][d][8 * j2 + 3] * inv);
                    const unsigned q0 = cvtpk(o[u][d][8 * j2 + 4] * inv, o[u][d][8 * j2 + 5] * inv), q1 = cvtpk(o[u][d][8 * j2 + 6] * inv, o[u][d][8 * j2 + 7] * inv);
                    const auto s0 = __builtin_amdgcn_permlane32_swap(e0, q0, false, false), s1 = __builtin_amdgcn_permlane32_swap(e1, q1, false, false);
                    v4u w; w.x = s0[0]; w.y = s1[0]; w.z = s0[1]; w.w = s1[1];
                    *(GAS v4u*)(orow + 32 * d + 16 * j2) = w; }
        }
    }
}
__device__ __forceinline__ void swa_attn_phase(const Ctx& F, const bf16* QK, bf16* O, const float* sinks) {
    constexpr int NB = SEQ / WIN, NU = BATCH * SWKV * NB;
    int L = F.vcu;
    if (L >= NU) return;
    SwaStage S;
    swa_load(S, QK, (L / NB) / SWKV, (L / NB) % SWKV, L % NB);
    swa_store(S, F.lds);
    __syncthreads();
    for (;;) {
        const int Ln = L + F.G; const bool more = Ln < NU;
        if (more) swa_load(S, QK, (Ln / NB) / SWKV, (Ln / NB) % SWKV, Ln % NB);
        swa_compute(F.lds, QK, O, sinks, (L / NB) / SWKV, (L / NB) % SWKV, L % NB);
        if (!more) break;
        __syncthreads();
        swa_store(S, F.lds);
        __syncthreads();
        L = Ln;
    }
    __syncthreads();
}

struct Args { const float* in[23]; float* out; unsigned char* ws; WJob jobs[NJOBS]; int nitems, ntiles, ph_lo, ph_hi; int qb[8]; };
constexpr int NPHASE = 20;

__global__ void __launch_bounds__(NWAVES * 64, 2) yoco_fwd(Args args) {
    extern __shared__ __attribute__((aligned(16))) unsigned char lds_raw[];
    Ctx F;
    F.lds = (LAS unsigned char*)lds_raw;
    volatile LAS unsigned* MISC = (volatile LAS unsigned*)(F.lds + MISC_OFF);
    F.tid = threadIdx.x; F.lane = F.tid & 63; F.wave = __builtin_amdgcn_readfirstlane(F.tid >> 6);
    F.G = gridDim.x; { const int bx = blockIdx.x; F.vcu = (F.G % 8 == 0) ? (bx % 8) * (F.G / 8) + bx / 8 : bx; }
    unsigned char* ws = args.ws;
    gu32* ctl = (gu32*)(ws + WS_CTL);
    for (int u = F.tid; u < (LDS_BYTES - LDSCTL_OFF) / 4; u += NWAVES * 64) ((LAS unsigned*)(F.lds + LDSCTL_OFF))[u] = 0u;
    __syncthreads();
    const LAS WJob* ljobs = (const LAS WJob*)(F.lds + JOBS_OFF);
    if (F.tid == 0) {
#pragma unroll
        for (int q = 0; q < NJOBS; ++q) { LAS WJob* d = (LAS WJob*)(F.lds + JOBS_OFF) + q; d->W = args.jobs[q].W; d->gain = args.jobs[q].gain; d->WT = args.jobs[q].WT; d->ldw = args.jobs[q].ldw; d->K = args.jobs[q].K;
            d->ncols = args.jobs[q].ncols; d->col0 = args.jobs[q].col0; d->gs = args.jobs[q].gs; d->gsrc = args.jobs[q].gsrc; d->drow0 = args.jobs[q].drow0; d->item0 = args.jobs[q].item0; d->mode = args.jobs[q].mode; d->pad = 0; }
    }
    __syncthreads();
    XcdBarrier bar = xcd_barrier_post((unsigned*)(ctl + CW_BAR), MISC + 8);
    const int lo = args.ph_lo, hi = args.ph_hi;
#ifndef PH_MASK
#define PH_MASK 0xFFFFFu
#endif
#define IN(k) ((((PH_MASK) >> (k)) & 1u) && lo <= (k) && (k) < hi)
#define SEAM(k) do { if (IN(k) && IN((k) + 1)) xcd_barrier(bar); } while (0)
#ifndef DUP_MASK
#define DUP_MASK 0u
#endif
#define REPS(k) ((((DUP_MASK) >> (k)) & 1u) ? 2 : 1)

    const float* x = args.in[0]; const int* pos = (const int*)args.in[1];
    const float* n_mix_post = args.in[3]; const float* n_ffn_post = args.in[5];
    const float* sinks = args.in[17]; const float* conv_w = args.in[20]; const float* conv_b = args.in[21];
    float* H = args.out;
    float* CS = (float*)(ws + WS_CS); float* RS = (float*)(ws + WS_RS);
    bf16* W1T = (bf16*)(ws + WS_W1T); bf16* WUQT = (bf16*)(ws + WS_WUQT); bf16* WKNT = (bf16*)(ws + WS_WKNT); bf16* WVT = (bf16*)(ws + WS_WVT);
    bf16* WO0T = (bf16*)(ws + WS_WO0T); bf16* WIN0T = (bf16*)(ws + WS_WIN0T); bf16* WOUT0T = (bf16*)(ws + WS_WOUT0T);
    bf16* WQK1T = (bf16*)(ws + WS_WQK1T); bf16* WV1T = (bf16*)(ws + WS_WV1T); bf16* WO1T = (bf16*)(ws + WS_WO1T); bf16* WIN1T = (bf16*)(ws + WS_WIN1T); bf16* WOUT1T = (bf16*)(ws + WS_WOUT1T);
    bf16* XN = (bf16*)(ws + WS_XN); float* CQKV = (float*)(ws + WS_CQKV); bf16* CQN = (bf16*)(ws + WS_CQN); bf16* CKV = (bf16*)(ws + WS_CKV);
    float* QF = (float*)(ws + WS_QF); bf16* Q = (bf16*)(ws + WS_Q); bf16* K = (bf16*)(ws + WS_K); bf16* VT = (bf16*)(ws + WS_VT); bf16* O = (bf16*)(ws + WS_O);
    bf16* AF = (bf16*)(ws + WS_AF); float* PART = (float*)(ws + WS_U); float* HALO = PART + (size_t)(M / 64) * 4 * DFF; bf16* ACT = (bf16*)(ws + WS_ACT); bf16* QK1 = (bf16*)(ws + WS_QK1); bf16* VT1 = (bf16*)(ws + WS_VT1);
    LAS unsigned char* ring = F.lds + RING_OFF;
    const int cid = (int)blockIdx.x;
    const int xcd_ = cid & 7;
    const int K0_IN = K0IN_ON ? (xcd_ >> 1) * 16 : 0;
    const int K0_OUT = 0;
#define GEMM_F32(Ap, Bp, Mv, Nv, Kv, Cp, ldcv, rsv) do { pg8::Gemm g_{(const pg8::bf16_t*)(Ap), (const pg8::bf16_t*)(Bp), (Mv), (Nv), (Kv), XTILED, WTILED, ZIG_DEF, 0}; pg8::StaticOrder S_; S_.init((Mv), (Nv), F.G, cid); \
        pg8::EpiF32 E_{(Cp), (ldcv), (rsv)}; pg8::gemm_phase<pg8::EpiF32, pg8::StaticOrder, true, true>(ring, g_, S_, E_); } while (0)
#define GEMM_BF16(Ap, Bp, Mv, Nv, Kv, Op, ldcv, gsv, gstv, scv, s0v, rsv) GEMM_BF16T(Ap, Bp, Mv, Nv, Kv, Op, ldcv, gsv, gstv, scv, s0v, rsv, 0)
#define GEMM_BF16T(Ap, Bp, Mv, Nv, Kv, Op, ldcv, gsv, gstv, scv, s0v, rsv, tAv) do { pg8::Gemm g_{(const pg8::bf16_t*)(Ap), (const pg8::bf16_t*)(Bp), (Mv), (Nv), (Kv), (tAv), WTILED, (((const void*)(Ap) == (const void*)ACT) ? ZIG_OUT : ZIG_DEF), 0}; pg8::StaticOrder S_; S_.init((Mv), (Nv), F.G, cid); \
        pg8::EpiBf16Map E_{(pg8::bf16_t*)(Op), (ldcv), (gsv), (gstv), (scv), (s0v), (rsv)}; pg8::gemm_phase<pg8::EpiBf16Map, pg8::StaticOrder, true, true>(ring, g_, S_, E_); } while (0)

#define GEMM_BF16_HM(Ap, Bp, Mv, Nv, Kv, Op, ldcv) do { pg8::Gemm g_{(const pg8::bf16_t*)(Ap), (const pg8::bf16_t*)(Bp), (Mv), (Nv), (Kv), 0, WTILED, ZIG_DEF, 0}; pg8::HalfMOrder S_; S_.init((Mv), (Nv), F.G, cid, F.vcu); \
        pg8::EpiBf16Map E_{(pg8::bf16_t*)(Op), (ldcv), 1 << 30, 0, 0, 1.f, nullptr}; pg8::gemm_phase<pg8::EpiBf16Map, pg8::HalfMOrder, true, true>(ring, g_, S_, E_); } while (0)
#define GEMM_CONV(Ap, Bp, cwp, cbp) do { pg8::Gemm g_{(const pg8::bf16_t*)(Ap), (const pg8::bf16_t*)(Bp), M, DFF2, DM, XTILED, WTILED, ZIG_DEF, K0_IN}; pg8::StaticOrder S_; S_.init(M, DFF2, F.G, cid, FLIP_IN); \
        pg8::EpiConvAct E_{(pg8::bf16_t*)ACT, PART, HALO, (cwp), (cbp), RS}; pg8::gemm_phase<pg8::EpiConvAct, pg8::StaticOrder, true, true>(ring, g_, S_, E_); } while (0)
#define TAIL_CONVERT(nwg, q) do { const int rem_ = (nwg) % F.G; if (rem_ == 0 || cid >= rem_) wt_block_phase(F, ljobs, NJOBS - 1, args.qb[q], args.qb[(q) + 1], rem_ == 0 ? cid : cid - rem_, rem_ == 0 ? F.G : F.G - rem_); } while (0)
    if (IN(0)) for (int rep_ = 0; rep_ < REPS(0); ++rep_) { if (rep_) xcd_barrier(bar);
        LAS float* scr = (LAS float*)(ring + F.wave * 16384);
        const int gw = F.vcu * NWAVES + F.wave, NGW = F.G * NWAVES;
        wt_block_phase(F, ljobs, NJOBS - 1, args.qb[0], args.qb[1], F.vcu, F.G, args.qb[6], args.qb[7] - args.qb[6]);
        { const WJob& J = args.jobs[NJOBS - 1];
          for (int it = gw; it < args.nitems; it += NGW) wt_item(J.W, J.gain, J.WT, J.ldw, J.K, J.ncols, J.col0, J.gs, J.gsrc, J.drow0, scr, it, F.lane); }
        { const int gt = F.vcu * (NWAVES * 64) + F.tid, NT = F.G * NWAVES * 64;
          for (int idx = gt; idx < M * 32; idx += NT) { const int m = idx >> 5, i = idx & 31; float s, c; sincos_d((float)pos[m] * kFreq[i], s, c); CS[(size_t)m * 64 + i] = c; CS[(size_t)m * 64 + 32 + i] = s; } }
        rows_phase<0, true>(F, x, nullptr, nullptr, nullptr, XN, RS);
    }
#if defined(DUP_P0)
    { xcd_barrier(bar);
        LAS float* scr = (LAS float*)(ring + F.wave * 16384);
        const int gw = F.vcu * NWAVES + F.wave, NGW = F.G * NWAVES;
        wt_block_phase(F, ljobs, NJOBS - 1, args.qb[0], args.qb[1], F.vcu, F.G);
        { const WJob& J = args.jobs[NJOBS - 1];
          for (int it = gw; it < args.nitems; it += NGW) wt_item(J.W, J.gain, J.WT, J.ldw, J.K, J.ncols, J.col0, J.gs, J.gsrc, J.drow0, scr, it, F.lane); }
        { const int gt = F.vcu * (NWAVES * 64) + F.tid, NT = F.G * NWAVES * 64;
          for (int idx = gt; idx < M * 32; idx += NT) { const int m = idx >> 5, i = idx & 31; float s, c; sincos_d((float)pos[m] * kFreq[i], s, c); CS[(size_t)m * 64 + i] = c; CS[(size_t)m * 64 + 32 + i] = s; } }
        rows_phase<0, true>(F, x, nullptr, nullptr, nullptr, XN, RS);
    }
#endif
#if defined(DUP_P0W)
    { xcd_barrier(bar); wt_block_phase(F, ljobs, NJOBS - 1, args.qb[0], args.qb[1], F.vcu, F.G, args.qb[6], args.qb[7] - args.qb[6]); }
#endif
    SEAM(0);
    if (IN(1)) for (int rep_ = 0; rep_ < REPS(1); ++rep_) { if (rep_) xcd_barrier(bar); GEMM_F32(XN, W1T, M, N1, DM, CQKV, N1, RS); TAIL_CONVERT((M / 256) * (N1 / 256), 1); }
    SEAM(1);
    if (IN(2)) for (int rep_ = 0; rep_ < REPS(2); ++rep_) { if (rep_) xcd_barrier(bar); latent_rows_phase(F, CQKV, CS, CQN, CKV, K); }
    SEAM(2);
    if (IN(3)) for (int rep_ = 0; rep_ < REPS(3); ++rep_) { if (rep_) xcd_barrier(bar);
        { pg8::Gemm g_{(const pg8::bf16_t*)CQN, (const pg8::bf16_t*)WUQT, M, QW, QLORA, 0, WTILED, ZIG_DEF, 0}; pg8::StaticOrder S_; S_.init(M, QW, F.G, cid);
          pg8::EpiQRope E_{(pg8::bf16_t*)Q, CS, QS0}; pg8::gemm_phase<pg8::EpiQRope, pg8::StaticOrder, true, true>(ring, g_, S_, E_); }
        GEMM_BF16(CKV, WKNT, M, 4096, KVLORA, K, QW, DNOPE, DQK, 0, 1.f, nullptr);
        { pg8::Gemm g_{(const pg8::bf16_t*)WVT, (const pg8::bf16_t*)CKV, 4096, M, KVLORA, WTILED, 0, ZIG_DEF, 0}; pg8::StaticOrder S_; S_.init(4096, M, F.G, cid);
          pg8::EpiBf16Map E_{(pg8::bf16_t*)VT, M, 1 << 30, 0, 0, 1.f, nullptr}; pg8::gemm_phase<pg8::EpiBf16Map, pg8::StaticOrder, true, true>(ring, g_, S_, E_); }
    }
#if defined(DUP_P3)
    { xcd_barrier(bar);
        { pg8::Gemm g_{(const pg8::bf16_t*)CQN, (const pg8::bf16_t*)WUQT, M, QW, QLORA, 0, WTILED, ZIG_DEF, 0}; pg8::StaticOrder S_; S_.init(M, QW, F.G, cid);
          pg8::EpiQRope E_{(pg8::bf16_t*)Q, CS, QS0}; pg8::gemm_phase<pg8::EpiQRope, pg8::StaticOrder, true, true>(ring, g_, S_, E_); }
        GEMM_BF16(CKV, WKNT, M, 4096, KVLORA, K, QW, DNOPE, DQK, 0, 1.f, nullptr);
        { pg8::Gemm g_{(const pg8::bf16_t*)WVT, (const pg8::bf16_t*)CKV, 4096, M, KVLORA, WTILED, 0, ZIG_DEF, 0}; pg8::StaticOrder S_; S_.init(4096, M, F.G, cid);
          pg8::EpiBf16Map E_{(pg8::bf16_t*)VT, M, 1 << 30, 0, 0, 1.f, nullptr}; pg8::gemm_phase<pg8::EpiBf16Map, pg8::StaticOrder, true, true>(ring, g_, S_, E_); }
    }
#endif
    SEAM(3);
    if (IN(5)) for (int rep_ = 0; rep_ < REPS(5); ++rep_) { if (rep_) xcd_barrier(bar); mla_attn_phase<0>(F, Q, K, VT, O, ljobs, args.qb[6], args.qb[7]); }
#if defined(DUP_P5V1)
    xcd_barrier(bar); mla_attn_phase<1>(F, Q, K, VT, (bf16*)(ws + WS_QF), ljobs, 0, 0);
#endif
#if defined(DUP_P5V4)
    xcd_barrier(bar); mla_attn_phase<4>(F, Q, K, VT, (bf16*)(ws + WS_QF), ljobs, 0, 0);
#endif
#if defined(DUP_P5V3)
    xcd_barrier(bar); mla_attn_phase<3>(F, Q, K, VT, (bf16*)(ws + WS_QF), ljobs, 0, 0);
#endif
#if defined(DUP_P5V2)
    xcd_barrier(bar); mla_attn_phase<2>(F, Q, K, VT, (bf16*)(ws + WS_QF), ljobs, 0, 0);
#endif
    SEAM(5);
    if (IN(6)) for (int rep_ = 0; rep_ < REPS(6); ++rep_) { if (rep_) xcd_barrier(bar); GEMM_BF16(O, WO0T, M, DM, DM, AF, DM, 1 << 30, 0, 0, 1.f, nullptr); }
    SEAM(6);
    if (IN(7)) for (int rep_ = 0; rep_ < REPS(7); ++rep_) { if (rep_) xcd_barrier(bar); rows_phase<1, false>(F, AF, XN, n_mix_post, nullptr, XN, RS);     }
    SEAM(7);
    if (IN(8)) for (int rep_ = 0; rep_ < REPS(8); ++rep_) { if (rep_) xcd_barrier(bar); GEMM_CONV(XN, WIN0T, conv_w, conv_b); TAIL_CONVERT((M / 256) * (DFF2 / 256), 2); }
#if defined(DUP_P8)
    xcd_barrier(bar); GEMM_CONV(XN, WIN0T, conv_w, conv_b);
#endif
#if defined(DUP_P8ZERO)
    xcd_barrier(bar); { pg8::Gemm g_{(const pg8::bf16_t*)XN, (const pg8::bf16_t*)WIN0T, M, DFF2, DM, 0, WTILED, ZIG_DEF, 0}; pg8::ZeroOrder S_; S_.init(M, DFF2, F.G, cid);
        pg8::EpiNull E_{(float*)(ws + WS_QF)}; pg8::gemm_phase<pg8::EpiNull, pg8::ZeroOrder, true, true>(ring, g_, S_, E_); }
#endif
#if defined(DUP_P8SHORT)
    xcd_barrier(bar); { pg8::Gemm g_{(const pg8::bf16_t*)XN, (const pg8::bf16_t*)WIN0T, M, 44032, 2048, 0, WTILED, ZIG_DEF, 0}; pg8::ZeroOrder S_; S_.init(M, 44032, F.G, cid);
        pg8::EpiNull E_{(float*)(ws + WS_QF)}; pg8::gemm_phase<pg8::EpiNull, pg8::ZeroOrder, true, true>(ring, g_, S_, E_); }
#endif
#if defined(DUP_P8NULL)
    xcd_barrier(bar); { pg8::Gemm g_{(const pg8::bf16_t*)XN, (const pg8::bf16_t*)WIN0T, M, DFF2, DM, 0, WTILED, ZIG_DEF, 0}; pg8::StaticOrder S_; S_.init(M, DFF2, F.G, cid);
        pg8::EpiNull E_{(float*)(ws + WS_QF)}; pg8::gemm_phase<pg8::EpiNull, pg8::StaticOrder, true, true>(ring, g_, S_, E_); }
#endif
#if defined(DUP_P10)
    xcd_barrier(bar); xcd_barrier(bar);
#endif
#if defined(BAR20)
    for (int q_ = 0; q_ < 20; ++q_) xcd_barrier(bar);
#endif
    SEAM(8);
    if (IN(9)) for (int rep_ = 0; rep_ < REPS(9); ++rep_) { if (rep_) xcd_barrier(bar); conv_fix_phase(F, PART, HALO, conv_w, conv_b, ACT); }
    SEAM(9);
    if (IN(10)) for (int rep_ = 0; rep_ < REPS(10); ++rep_) { if (rep_) xcd_barrier(bar); GEMM_BF16T(ACT, WOUT0T, M, DM, DFF, AF, DM, 1 << 30, 0, 0, 1.f, nullptr, pg8::EpiConvAct::ATILED); }
#if defined(DUP_P10ZERO)
    xcd_barrier(bar); { pg8::Gemm g_{(const pg8::bf16_t*)ACT, (const pg8::bf16_t*)WOUT0T, M, DM, DFF, pg8::EpiConvAct::ATILED, WTILED, ZIG_DEF, 0}; pg8::ZeroOrder S_; S_.init(M, DM, F.G, cid);
        pg8::EpiNull E_{(float*)(ws + WS_QF)}; pg8::gemm_phase<pg8::EpiNull, pg8::ZeroOrder, true, true>(ring, g_, S_, E_); }
#endif
#if defined(DUP_P10HM)
    xcd_barrier(bar); { pg8::Gemm g_{(const pg8::bf16_t*)ACT, (const pg8::bf16_t*)WOUT0T, M, DM, DFF, pg8::EpiConvAct::ATILED, WTILED, ZIG_DEF, 0}; pg8::HalfMOrder S_; S_.init(M, DM, F.G, cid, F.vcu);
        pg8::EpiNull E_{(float*)(ws + WS_QF)}; pg8::gemm_phase<pg8::EpiNull, pg8::HalfMOrder, true, true>(ring, g_, S_, E_); }
#endif
#if defined(DUP_P10ZA)
    xcd_barrier(bar); { pg8::Gemm g_{(const pg8::bf16_t*)ACT, (const pg8::bf16_t*)WOUT0T, M, DM, DFF, pg8::EpiConvAct::ATILED, WTILED, ZIG_DEF, 0}; pg8::ZeroAOrder S_; S_.init(M, DM, F.G, cid);
        pg8::EpiNull E_{(float*)(ws + WS_QF)}; pg8::gemm_phase<pg8::EpiNull, pg8::ZeroAOrder, true, true>(ring, g_, S_, E_); }
#endif
#if defined(DUP_P10ZB)
    xcd_barrier(bar); { pg8::Gemm g_{(const pg8::bf16_t*)ACT, (const pg8::bf16_t*)WOUT0T, M, DM, DFF, pg8::EpiConvAct::ATILED, WTILED, ZIG_DEF, 0}; pg8::ZeroBOrder S_; S_.init(M, DM, F.G, cid);
        pg8::EpiNull E_{(float*)(ws + WS_QF)}; pg8::gemm_phase<pg8::EpiNull, pg8::ZeroBOrder, true, true>(ring, g_, S_, E_); }
#endif
#if defined(DUP_P10NULL)
    xcd_barrier(bar); { pg8::Gemm g_{(const pg8::bf16_t*)ACT, (const pg8::bf16_t*)WOUT0T, M, DM, DFF, pg8::EpiConvAct::ATILED, WTILED, ZIG_DEF, 0}; pg8::StaticOrder S_; S_.init(M, DM, F.G, cid);
        pg8::EpiNull E_{(float*)(ws + WS_QF)}; pg8::gemm_phase<pg8::EpiNull, pg8::StaticOrder, true, true>(ring, g_, S_, E_); }
#endif
    SEAM(10);
    if (IN(11)) for (int rep_ = 0; rep_ < REPS(11); ++rep_) { if (rep_) xcd_barrier(bar); rows_phase<1, false>(F, AF, XN, n_ffn_post, nullptr, XN, RS); }
    SEAM(11);
    if (IN(12)) for (int rep_ = 0; rep_ < REPS(12); ++rep_) { if (rep_) xcd_barrier(bar);
        GEMM_BF16T(XN, WQK1T, M, QK1W, DM, QK1, QK1W, 1 << 30, 0, 4096, QS1, RS, XTILED);
        TAIL_CONVERT((M / 256) * (QK1W / 256), 3);
    }
    SEAM(12);
    if (IN(13)) for (int rep_ = 0; rep_ < REPS(13); ++rep_) { if (rep_) xcd_barrier(bar); swa_attn_phase(F, QK1, O, sinks); }
    SEAM(13);
    if (IN(14)) for (int rep_ = 0; rep_ < REPS(14); ++rep_) { if (rep_) xcd_barrier(bar); GEMM_BF16(O, WO1T, M, DM, DM, AF, DM, 1 << 30, 0, 0, 1.f, nullptr); }
    SEAM(14);
    if (IN(15)) for (int rep_ = 0; rep_ < REPS(15); ++rep_) { if (rep_) xcd_barrier(bar); rows_phase<1, false>(F, AF, XN, n_mix_post + DM, nullptr, XN, RS); }
    SEAM(15);
    if (IN(16)) for (int rep_ = 0; rep_ < REPS(16); ++rep_) { if (rep_) xcd_barrier(bar); GEMM_CONV(XN, WIN1T, conv_w + (size_t)3 * DFF2, conv_b + DFF2); TAIL_CONVERT((M / 256) * (DFF2 / 256), 4); }
    SEAM(16);
    if (IN(17)) for (int rep_ = 0; rep_ < REPS(17); ++rep_) { if (rep_) xcd_barrier(bar); conv_fix_phase(F, PART, HALO, conv_w + (size_t)3 * DFF2, conv_b + DFF2, ACT); }
    SEAM(17);
    if (IN(18)) for (int rep_ = 0; rep_ < REPS(18); ++rep_) { if (rep_) xcd_barrier(bar); GEMM_BF16T(ACT, WOUT1T, M, DM, DFF, AF, DM, 1 << 30, 0, 0, 1.f, nullptr, pg8::EpiConvAct::ATILED); }
    SEAM(18);
    if (IN(19)) for (int rep_ = 0; rep_ < REPS(19); ++rep_) { if (rep_) xcd_barrier(bar); rows_phase<2, false>(F, AF, XN, n_ffn_post + DM, H, nullptr, nullptr); }
#undef IN
#undef SEAM
}

#ifndef MK_SPLIT
#define MK_SPLIT 0
#endif
extern "C" void kernel_launch(void* const* d_in, const int* in_sizes, int n_in, void* d_out, int out_size, void* d_ws, size_t ws_size, hipStream_t stream) {
    static int grid = 0;
    if (grid == 0) {
        if (n_in != 23 || out_size != M * DM || ws_size < WS_END) { fprintf(stderr, "kernel_launch: unexpected shapes (n_in %d, out %d, ws %zu < %zu)\n", n_in, out_size, ws_size, (size_t)WS_END); grid = -1; return; }
        int dev = 0, cus = 0, per_cu = 0;
        if (hipGetDevice(&dev) != hipSuccess || hipDeviceGetAttribute(&cus, hipDeviceAttributeMultiprocessorCount, dev) != hipSuccess) { grid = -1; return; }
        if (hipFuncSetAttribute((const void*)yoco_fwd, hipFuncAttributeMaxDynamicSharedMemorySize, LDS_BYTES) != hipSuccess) { fprintf(stderr, "kernel_launch: hipFuncSetAttribute failed\n"); grid = -1; return; }
        if (hipOccupancyMaxActiveBlocksPerMultiprocessor(&per_cu, (const void*)yoco_fwd, NWAVES * 64, LDS_BYTES) != hipSuccess || per_cu < 1)
            fprintf(stderr, "kernel_launch: occupancy query reports %d workgroups per CU\n", per_cu);
        (void)hipGetLastError();
        grid = cus;
    }
    if (grid < 0) return;
    (void)hipMemsetAsync((char*)d_ws + WS_CTL, 0, 65536, stream);
    Args a; memset(&a, 0, sizeof(a));
    for (int i = 0; i < 23; ++i) a.in[i] = (const float*)d_in[i];
    a.out = (float*)d_out; a.ws = (unsigned char*)d_ws;
    unsigned char* ws = (unsigned char*)d_ws;
    const float* nmp = a.in[2]; const float* nfp = a.in[4];
    int nj = 0, tiles = 0;
    auto add = [&](const float* W, const float* gain, size_t wt_off, int ldw, int K, int ncols, int col0, int gs, int gsrc, int drow0, int mode = 0) {
        WJob& J = a.jobs[nj++]; J.W = W; J.gain = gain; J.WT = (bf16*)(ws + wt_off); J.ldw = ldw; J.K = K; J.ncols = ncols; J.col0 = col0; J.gs = gs; J.gsrc = gsrc; J.drow0 = drow0; J.item0 = tiles; J.mode = mode; J.pad = 0;
        tiles += (K / 64) * (ncols / 256); };
    const int BIG = 1 << 30;
    add(a.in[6],  nmp,        WS_W1T,   QLORA,  DM,     QLORA,  0, BIG, 0, 0);
    add(a.in[8],  a.in[7],    WS_WUQT,  QW,     QLORA,  QW,     0, BIG, 0, 0, 1);
    add(a.in[11], a.in[10],   WS_WKNT,  8192,   KVLORA, 4096,   0, 128, 256, 0);
    add(a.in[11], a.in[10],   WS_WVT,   8192,   KVLORA, 4096, 128, 128, 256, 0);
    add(a.in[12], nullptr,    WS_WO0T,  DM,     DM,     DM,     0, BIG, 0, 0);
    add(a.in[19], nfp,        WS_WIN0T, DFF2,   DM,     DFF2,   0, BIG, 0, 0, 2);
    add(a.in[22], nullptr,    WS_WOUT0T,DM,     DFF,    DM,     0, BIG, 0, 0);
    add(a.in[16], nmp + DM,   WS_WQK1T, DM,     DM,     DM,     0, BIG, 0, 0);
    add(a.in[14], a.in[13],   WS_WQK1T, 512,    DM,     512,    0, BIG, 0, 4096);
    add(a.in[15], a.in[13],   WS_WQK1T, 512,    DM,     512,    0, BIG, 0, 4608);
    add(a.in[18], nullptr,    WS_WO1T,  DM,     DM,     DM,     0, BIG, 0, 0);
    add(a.in[19] + (size_t)DM * DFF2, nfp + DM, WS_WIN1T, DFF2, DM, DFF2, 0, BIG, 0, 0, 2);
    add(a.in[22] + (size_t)DFF * DM,  nullptr,  WS_WOUT1T, DM,  DFF, DM,  0, BIG, 0, 0);
    { auto idle = [&](int nwg) { const int rem = nwg % grid; return rem ? grid - rem : 0; };
      const int c16 = 27 * idle((M / 256) * (DFF2 / 256)), c12 = 27 * idle((M / 256) * (QK1W / 256)), c8 = c16, c1 = 24 * idle((M / 256) * (N1 / 256));
      const int lim16 = a.jobs[12].item0  , lim12 = a.jobs[10].item0  , lim8 = a.jobs[6].item0  , lim1 = a.jobs[1].item0  ;
      int t4 = tiles - c16; if (t4 < lim16) t4 = lim16;
      int t3 = t4 - c12;    if (t3 < lim12) t3 = lim12;
      int t2 = t3 - c8;     if (t2 < lim8)  t2 = lim8;
      int t1 = t2 - c1;     if (t1 < lim1)  t1 = lim1;
      int att_lo = a.jobs[4].item0, att_hi = (PIGGY && grid % 8 == 0) ? att_lo + (grid * 136) / 8 : att_lo; if (att_hi > t1) att_hi = t1; if (att_hi < att_lo) att_hi = att_lo;
      a.qb[0] = 0; a.qb[1] = t1; a.qb[2] = t2; a.qb[3] = t3; a.qb[4] = t4; a.qb[5] = tiles; a.qb[6] = att_lo; a.qb[7] = att_hi; }
    a.ntiles = tiles;
    { WJob& J = a.jobs[nj++]; J.W = a.in[9]; J.gain = nmp; J.WT = (bf16*)(ws + WS_W1T); J.ldw = 576; J.K = DM; J.ncols = 576; J.col0 = 0; J.gs = BIG; J.gsrc = 0; J.drow0 = QLORA; J.item0 = 0; J.mode = 0; J.pad = 0; }
    const int items = (DM / 64) * (576 / 32);
    a.nitems = items;
#if MK_SPLIT
    for (int p = 0; p < NPHASE; ++p) { a.ph_lo = p; a.ph_hi = p + 1; hipLaunchKernelGGL(yoco_fwd, dim3(grid), dim3(NWAVES * 64), LDS_BYTES, stream, a); }
#else
    a.ph_lo = 0; a.ph_hi = NPHASE;
    hipLaunchKernelGGL(yoco_fwd, dim3(grid), dim3(NWAVES * 64), LDS_BYTES, stream, a);
#endif
    const hipError_t le = hipPeekAtLastError();
    if (le != hipSuccess) fprintf(stderr, "kernel_launch: launch failed: %s\n", hipGetErrorName(le));
}
```

```cpp
#include <hip/hip_runtime.h>
#include <cstdio>
#include <cstdint>
#include <cstring>
namespace pg8 {
#define PG8_LAS __attribute__((address_space(3)))
typedef unsigned short bf16_t;
typedef short bf16x8 __attribute__((ext_vector_type(8)));
typedef float f32x4 __attribute__((ext_vector_type(4)));
typedef unsigned u32x4 __attribute__((ext_vector_type(4)));
constexpr int BM = 256, BK = 64, HALF = 128, HTB = HALF * BK * 2  , STAGE_BYTES = 8 * HTB, NXCD = 8, WGM = 8;

__host__ __device__ __forceinline__ int lds_byte(int r, int c) { const int st = (r >> 4) * 2 + (c >> 5), rr = r & 15, cc = c & 31, ob = rr * 64 + cc * 2; return st * 1024 + (ob ^ (((ob >> 9) & 1) << 5)); }
__host__ __device__ __forceinline__ void stage_rc(int b, int& R, int& C) { const int st = b / 1024, sb = b % 1024, swz = sb ^ (((sb >> 9) & 1) << 5); R = (st >> 1) * 16 + swz / 64; C = (st & 1) * 32 + (swz % 64) / 2; }
__host__ __device__ __forceinline__ int perm32(int rho) { const int n = rho >> 4, i = rho & 15; return 8 * (i >> 2) + 4 * n + (i & 3); }

struct Unit { int pm, pn; };
struct Gemm { const bf16_t* A; const bf16_t* Bt; int M, N, K; int tA, tB, zig, k0; };
__host__ __device__ __forceinline__ size_t tiled_off(int row, int col, int K) { return ((((size_t)(row >> 8) * (size_t)(K >> 6) + (size_t)(col >> 6)) * 256 + (size_t)(row & 255)) << 6) + (size_t)(col & 63); }

struct StaticOrder {
    int nM, nN, nwg, G, c, flipn;
    __host__ __device__ void init(int M, int N, int G_, int c_, int flipn_ = 0) { nM = M / BM; nN = N / BM; nwg = nM * nN; G = G_; c = c_; flipn = flipn_; }
    __host__ __device__ bool next(int i, Unit& u) const {
        const long L = (long)i * G + c; if (L >= nwg) return false;
        int wgid = (int)L; { const int q = nwg / NXCD, r = nwg % NXCD, xcd = wgid % NXCD, off = wgid / NXCD; wgid = (xcd < r ? xcd * (q + 1) : r * (q + 1) + (xcd - r) * q) + off; }
        const int nig = WGM * nN, gid = wgid / nig, fm = gid * WGM, gsz = (nM - fm) < WGM ? (nM - fm) : WGM;
        u.pm = fm + ((wgid % nig) % gsz); u.pn = (wgid % nig) / gsz; if (flipn) u.pn = nN - 1 - u.pn; return true;
    }
    __device__ __forceinline__ void a_ready(const Unit&) const {}
    __device__ __forceinline__ void done(const Unit&) const {}
};

__device__ __forceinline__ unsigned cvt_pk_bf16(float lo, float hi) { unsigned r; asm volatile("v_cvt_pk_bf16_f32 %0, %1, %2" : "=v"(r) : "v"(lo), "v"(hi)); return r; }
typedef float f32x2 __attribute__((ext_vector_type(2)));
struct EpiF32 {
    static constexpr bool PERM = false, AFTER_DRAIN = false;
    float* C; int ldc; const float* rs;
    __device__ __forceinline__ void operator()(const f32x4 (&acc)[2][2][4][2], const Unit& u, int wr, int wc, int fr, int fq) const {
        const int row0 = u.pm * BM + wr * 64 + fr, col0 = u.pn * BM + wc * 32 + 4 * fq;
#pragma unroll
        for (int ai = 0; ai < 2; ++ai)
#pragma unroll
            for (int m = 0; m < 4; ++m) { const int row = row0 + ai * HALF + m * 16; float* rowp = C + (size_t)row * ldc + col0; const float s = rs ? rs[row] : 1.f;
#pragma unroll
                for (int bj = 0; bj < 2; ++bj)
#pragma unroll
                    for (int n = 0; n < 2; ++n) *(f32x4*)(rowp + bj * HALF + n * 16) = acc[ai][bj][m][n] * s; }
    }
};
struct EpiBf16Map {
    static constexpr bool PERM = true, AFTER_DRAIN = false;
    bf16_t* O; int ldc; int gs, gstride; int scale_cols; float scale0; const float* rs;
    __device__ __forceinline__ void operator()(const f32x4 (&acc)[2][2][4][2], const Unit& u, int wr, int wc, int fr, int fq) const {
        const int row0 = u.pm * BM + wr * 64 + fr;
        int dcol[2]; float sc[2];
#pragma unroll
        for (int bj = 0; bj < 2; ++bj) { const int ch = u.pn * BM + bj * HALF, grp = ch / gs; dcol[bj] = grp * gstride + (ch - grp * gs) + wc * 32 + 8 * fq; sc[bj] = ch < scale_cols ? scale0 : 1.f; }
#pragma unroll
        for (int ai = 0; ai < 2; ++ai)
#pragma unroll
            for (int m = 0; m < 4; ++m) { const int row = row0 + ai * HALF + m * 16; bf16_t* rowp = O + (size_t)row * ldc; const float s = rs ? rs[row] : 1.f;
#pragma unroll
                for (int bj = 0; bj < 2; ++bj) { const f32x4 v0 = acc[ai][bj][m][0] * (sc[bj] * s), v1 = acc[ai][bj][m][1] * (sc[bj] * s);
                    u32x4 w; w.x = cvt_pk_bf16(v0[0], v0[1]); w.y = cvt_pk_bf16(v0[2], v0[3]); w.z = cvt_pk_bf16(v1[0], v1[1]); w.w = cvt_pk_bf16(v1[2], v1[3]);
                    *(u32x4*)(rowp + dcol[bj]) = w; } }
    }
};

struct EpiQRope {
    static constexpr bool PERM = true, AFTER_DRAIN = false;
    bf16_t* Q; const float* CS; float qs;
    __device__ __forceinline__ void operator()(const f32x4 (&acc)[2][2][4][2], const Unit& u, int wr, int wc, int fr, int fq) const {
        typedef unsigned u32x2 __attribute__((ext_vector_type(2)));
        const int row0 = u.pm * BM + wr * 64 + fr;
#pragma unroll
        for (int bj = 0; bj < 2; ++bj) {
            const int c0 = u.pn * BM + bj * HALF + wc * 32 + 8 * fq, head = c0 / 192, cl = c0 - head * 192;
            if (cl < 128) {
#pragma unroll
                for (int ai = 0; ai < 2; ++ai)
#pragma unroll
                    for (int m = 0; m < 4; ++m) { const f32x4 v0 = acc[ai][bj][m][0] * qs, v1 = acc[ai][bj][m][1] * qs;
                        u32x4 w; w.x = cvt_pk_bf16(v0[0], v0[1]); w.y = cvt_pk_bf16(v0[2], v0[3]); w.z = cvt_pk_bf16(v1[0], v1[1]); w.w = cvt_pk_bf16(v1[2], v1[3]);
                        *(u32x4*)(Q + (size_t)(row0 + ai * HALF + m * 16) * 6144 + c0) = w; }
            } else {
                const int p0 = (cl - 128) >> 1;
#pragma unroll
                for (int ai = 0; ai < 2; ++ai)
#pragma unroll
                    for (int m = 0; m < 4; ++m) { const int row = row0 + ai * HALF + m * 16;
                        const f32x4 c4 = *(const f32x4*)(CS + (size_t)row * 64 + p0), s4 = *(const f32x4*)(CS + (size_t)row * 64 + 32 + p0);
                        const f32x4 x = acc[ai][bj][m][0], y = acc[ai][bj][m][1];
                        const float a0 = (x[0] * c4[0] - x[1] * s4[0]) * qs, b0 = (x[1] * c4[0] + x[0] * s4[0]) * qs, a1 = (x[2] * c4[1] - x[3] * s4[1]) * qs, b1 = (x[3] * c4[1] + x[2] * s4[1]) * qs;
                        const float a2 = (y[0] * c4[2] - y[1] * s4[2]) * qs, b2 = (y[1] * c4[2] + y[0] * s4[2]) * qs, a3 = (y[2] * c4[3] - y[3] * s4[3]) * qs, b3 = (y[3] * c4[3] + y[2] * s4[3]) * qs;
                        bf16_t* qp = Q + (size_t)row * 6144 + head * 192 + 128 + p0;
                        u32x2 w1; w1.x = cvt_pk_bf16(a0, a1); w1.y = cvt_pk_bf16(a2, a3); *(u32x2*)qp = w1;
                        u32x2 w2; w2.x = cvt_pk_bf16(b0, b1); w2.y = cvt_pk_bf16(b2, b3); *(u32x2*)(qp + 32) = w2; }
            }
        }
    }
};

struct EpiConvAct {
    static constexpr bool PERM = true, AFTER_DRAIN = false, APERM = true;
    bf16_t* ACT; float* PART; float* HALO; const float* cw; const float* cb; const float* rs;
    static constexpr int DFF = 11008;
    static constexpr int ATILED = 1;
    __device__ __forceinline__ static float shr1f(float x) { return __builtin_bit_cast(float, __builtin_amdgcn_update_dpp(0, __builtin_bit_cast(int, x), 0x111, 0xF, 0xF, true)); }
    __device__ __forceinline__ static f32x4 shr1(const f32x4 v) { f32x4 r; r.x = shr1f(v.x); r.y = shr1f(v.y); r.z = shr1f(v.z); r.w = shr1f(v.w); return r; }
    __device__ __forceinline__ static float silu_mul(float g, float v) { return g * __builtin_amdgcn_rcpf(1.0f + __builtin_amdgcn_exp2f(g * -1.4426950408889634f)) * v; }
    __device__ __forceinline__ void operator()(const f32x4 (&acc)[2][2][4][2], const Unit& u, int wr, int wc, int fr, int fq) const {
        typedef unsigned u32x2 __attribute__((ext_vector_type(2)));
        const int j0 = u.pn * HALF + wc * 32 + 8 * fq;
        u32x2 keep[2][4];
#pragma unroll
        for (int n = 0; n < 2; ++n) {
            const int j = j0 + 4 * n;
            const f32x4 wg0 = *(const f32x4*)(cw + j), wg1 = *(const f32x4*)(cw + 2 * DFF + j), wg2 = *(const f32x4*)(cw + 4 * DFF + j), bg = *(const f32x4*)(cb + j);
            const f32x4 wv0 = *(const f32x4*)(cw + DFF + j), wv1 = *(const f32x4*)(cw + 3 * DFF + j), wv2 = *(const f32x4*)(cw + 5 * DFF + j), bv = *(const f32x4*)(cb + DFF + j);
#pragma unroll
            for (int ai = 0; ai < 2; ++ai) {
                const int blk = 4 * u.pm + 2 * ai + wr;
                const f32x4 rsv = *(const f32x4*)(rs + u.pm * BM + ai * HALF + wr * 64 + 4 * fr);
                f32x4 ug[4], uv[4];
#pragma unroll
                for (int m = 0; m < 4; ++m) { ug[m] = acc[ai][0][m][n] * rsv[m]; uv[m] = acc[ai][1][m][n] * rsv[m]; }
                const f32x4 g3 = shr1(ug[3]), g2 = shr1(ug[2]), v3 = shr1(uv[3]), v2 = shr1(uv[2]);
#pragma unroll
                for (int m = 0; m < 4; ++m) {
                    const f32x4 gc = ug[m], vc = uv[m];
                    const f32x4 gp1 = (m == 0) ? g3 : ug[m - 1 < 0 ? 0 : m - 1], gp2 = (m == 0) ? g2 : (m == 1) ? g3 : ug[m - 2 < 0 ? 0 : m - 2];
                    const f32x4 vp1 = (m == 0) ? v3 : uv[m - 1 < 0 ? 0 : m - 1], vp2 = (m == 0) ? v2 : (m == 1) ? v3 : uv[m - 2 < 0 ? 0 : m - 2];
                    const f32x4 G = bg + wg0 * gp2 + wg1 * gp1 + wg2 * gc, V = bv + wv0 * vp2 + wv1 * vp1 + wv2 * vc;
                    if (m < 2) { if (fr == 0) { float* pp = PART + ((size_t)(blk * 2 + m) * 2) * DFF + j; *(f32x4*)pp = G; *(f32x4*)(pp + DFF) = V; } }
                    else       { if (fr == 15) { float* hp = HALO + ((size_t)(blk * 2 + (m - 2)) * 2) * DFF + j; *(f32x4*)hp = gc; *(f32x4*)(hp + DFF) = vc; } }
                    u32x2 w; w.x = cvt_pk_bf16(silu_mul(G[0], V[0]), silu_mul(G[1], V[1])); w.y = cvt_pk_bf16(silu_mul(G[2], V[2]), silu_mul(G[3], V[3]));
                    if (n == 0) keep[ai][m] = w;
                    else if (!(m < 2 && fr == 0)) { u32x4 o; o.x = keep[ai][m].x; o.y = keep[ai][m].y; o.z = w.x; o.w = w.y;
                        const int row_ = u.pm * BM + ai * HALF + wr * 64 + 4 * fr + m;
                        *(u32x4*)(ACT + (ATILED ? tiled_off(row_, j0, DFF) : (size_t)row_ * DFF + j0)) = o; }
                }
            }
        }
    }
};

struct EpiNull {
    static constexpr bool PERM = true, AFTER_DRAIN = false;
    float* sink;
    __device__ __forceinline__ void operator()(const f32x4 (&acc)[2][2][4][2], const Unit& u, int wr, int wc, int fr, int fq) const {
        f32x4 s = {0.f, 0.f, 0.f, 0.f};
#pragma unroll
        for (int ai = 0; ai < 2; ++ai)
#pragma unroll
            for (int bj = 0; bj < 2; ++bj)
#pragma unroll
                for (int m = 0; m < 4; ++m)
#pragma unroll
                    for (int n = 0; n < 2; ++n) s += acc[ai][bj][m][n];
        if (s[0] + s[1] + s[2] + s[3] == 1.2345678e30f) sink[u.pm + u.pn + fr] = s[0];
    }
};

struct ZeroOrder : StaticOrder {
    __device__ bool next(int i, Unit& u) const { const bool ok = StaticOrder::next(i, u); u.pm = 0; u.pn = 0; return ok; }
};

struct ZeroAOrder : StaticOrder { __device__ bool next(int i, Unit& u) const { const bool ok = StaticOrder::next(i, u); u.pm = 0; return ok; } };
struct ZeroBOrder : StaticOrder { __device__ bool next(int i, Unit& u) const { const bool ok = StaticOrder::next(i, u); u.pn = 0; return ok; } };

struct HalfMOrder {
    StaticOrder so; int vcu; bool fast;
    __device__ void init(int M, int N, int G_, int c_, int vcu_) { so.init(M, N, G_, c_); vcu = vcu_; fast = (G_ == 256 && M == 8192 && N == 4096); }
    __device__ bool next(int i, Unit& u) const {
        if (!fast) return so.next(i, u);
        if (i >= 2) return false;
        const int x = vcu >> 5, j = vcu & 31; u.pm = 16 * i + 4 * (x >> 1) + (j & 3); u.pn = 8 * (x & 1) + (j >> 2); return true;
    }
    __device__ __forceinline__ void a_ready(const Unit&) const {}
    __device__ __forceinline__ void done(const Unit&) const {}
};

template <class E, class = void> struct epi_aperm { static constexpr bool value = false; };
template <class E> struct epi_aperm<E, decltype((void)E::APERM)> { static constexpr bool value = E::APERM; };
template <class Epi, class Sched, bool ALIGN_EPI = false, bool SP2 = false>
__device__ __forceinline__ void gemm_phase(PG8_LAS unsigned char* lds, const Gemm g, const Sched& S, const Epi& E) {
    const int tid = threadIdx.x, wid = __builtin_amdgcn_readfirstlane(tid >> 6), lane = tid & 63, wr = wid >> 2, wc = wid & 3, fr = lane & 15, fq = lane >> 4;
    const int K = g.K, nt = K / BK;
    unsigned voffA[2], voffB[2];
#pragma unroll
    for (int i = 0; i < 2; ++i) { int R, C; stage_rc(tid * 16 + i * 8192, R, C); const int Rb = Epi::PERM ? ((R & ~31) + perm32(R & 31)) : R;
        const int Ra = epi_aperm<Epi>::value ? ((R & ~63) | (4 * (R & 15) + ((R >> 4) & 3))) : R;
        voffA[i] = (unsigned)(Ra * (g.tA ? BK : K) + C) * 2u; voffB[i] = (unsigned)(Rb * (g.tB ? BK : K) + C) * 2u; }
    const long ksA = g.tA ? (long)(BM * BK * 2) : (long)(BK * 2), ksB = g.tB ? (long)(BM * BK * 2) : (long)(BK * 2);
#define PG8_REV(u_) (g.zig == 3 || (g.zig != 0 && ((((u_) ^ g.zig) & 1) != 0)))
    long kstepA = PG8_REV(0) ? -ksA : ksA, kstepB = PG8_REV(0) ? -ksB : ksB;
    const size_t hstepA = g.tA ? (size_t)(HALF * BK * 2) : (size_t)HALF * K * 2, hstepB = g.tB ? (size_t)(HALF * BK * 2) : (size_t)HALF * K * 2;
    const size_t tstepA = (size_t)BM * K * 2, tstepB = (size_t)BM * K * 2;
    const unsigned ldsw = (unsigned)wid * 1024u;
    const int aoff = lds_byte(wr * 64 + fr, fq * 8), boff = lds_byte(wc * 32 + fr, fq * 8);
#define PG8_NT_B 1
#define PG8_SA(b, h) (((b) * 2 + (h)) * HTB)
#define PG8_SB(b, h) ((4 + (b) * 2 + (h)) * HTB)
    const char* const bA_ = (const char*)g.A; const char* const bB_ = (const char*)g.Bt;
    const __amdgpu_buffer_rsrc_t srdA_ = __builtin_amdgcn_make_buffer_rsrc((void*)g.A, (short)0, (int)((size_t)g.M * K * 2), 0x00020000);
    const __amdgpu_buffer_rsrc_t srdB_ = __builtin_amdgcn_make_buffer_rsrc((void*)g.Bt, (short)0, (int)((size_t)g.N * K * 2), 0x00020000);
#define PG8_STAGE(bufoff, gbase, voff) do { _Pragma("unroll") for (int _i = 0; _i < 2; ++_i) \
        __builtin_amdgcn_raw_ptr_buffer_load_lds(srdA_, (PG8_LAS void*)(lds + (bufoff) + ldsw + _i * 8192), 16, (voff)[_i], (int)((const char*)(gbase) - bA_), 0, PG8_NT_B); } while (0)
#define PG8_STAGEB(bufoff, gbase, voff) do { _Pragma("unroll") for (int _i = 0; _i < 2; ++_i) \
        __builtin_amdgcn_raw_ptr_buffer_load_lds(srdB_, (PG8_LAS void*)(lds + (bufoff) + ldsw + _i * 8192), 16, (voff)[_i], (int)((const char*)(gbase) - bB_), 0, PG8_NT_B); } while (0)
#define PG8_LDA(dst, b, h) do { _Pragma("unroll") for (int m = 0; m < 4; ++m) _Pragma("unroll") for (int k = 0; k < 2; ++k) dst[m][k] = *(const PG8_LAS bf16x8*)(lds + PG8_SA(b, h) + aoff + m * 2048 + k * 1024); } while (0)
#define PG8_LDB(dst, b, h) do { _Pragma("unroll") for (int n = 0; n < 2; ++n) _Pragma("unroll") for (int k = 0; k < 2; ++k) dst[n][k] = *(const PG8_LAS bf16x8*)(lds + PG8_SB(b, h) + boff + n * 2048 + k * 1024); } while (0)
#define PG8_MMA(ai, bj, At, Bt) do { __builtin_amdgcn_s_setprio(1); _Pragma("unroll") for (int m = 0; m < 4; ++m) _Pragma("unroll") for (int n = 0; n < 2; ++n) _Pragma("unroll") for (int k = 0; k < 2; ++k) \
        acc[ai][bj][m][n] = __builtin_amdgcn_mfma_f32_16x16x32_bf16(Bt[n][k], At[m][k], acc[ai][bj][m][n], 0, 0, 0); __builtin_amdgcn_s_setprio(0); } while (0)
#define PG8_WAIT_V(n) asm volatile("s_waitcnt vmcnt(" #n ")" ::: "memory")
#define PG8_WAIT_L(n) asm volatile("s_waitcnt lgkmcnt(" #n ")" ::: "memory")
#define PG8_BAR __builtin_amdgcn_s_barrier()
#define PG8_SCHED __builtin_amdgcn_sched_barrier(0)
    Unit cur, nxt; int ui = 0;
    if (!S.next(0, cur)) return;
    f32x4 acc[2][2][4][2];
#pragma unroll
    for (int a = 0; a < 2; ++a)
#pragma unroll
        for (int b = 0; b < 2; ++b)
#pragma unroll
            for (int m = 0; m < 4; ++m)
#pragma unroll
                for (int n = 0; n < 2; ++n) acc[a][b][m][n] = (f32x4){0.f, 0.f, 0.f, 0.f};
    bf16x8 At[4][2], B0[2][2], B1[2][2];
    const char* cA = (const char*)g.A + (size_t)cur.pm * tstepA + (PG8_REV(0) ? (long)(nt - 1) * ksA : 0l); const char* cB = (const char*)g.Bt + (size_t)cur.pn * tstepB + (PG8_REV(0) ? (long)(nt - 1) * ksB : 0l);
    S.a_ready(cur);
    if constexpr (SP2) {
        PG8_STAGEB(PG8_SB(0, 0), cB, voffB); PG8_STAGEB(PG8_SB(0, 1), cB + hstepB, voffB); PG8_STAGE(PG8_SA(0, 0), cA, voffA); PG8_STAGE(PG8_SA(0, 1), cA + hstepA, voffA);
        if (wr == 1) PG8_BAR;
        PG8_WAIT_V(2); PG8_BAR;
        PG8_STAGEB(PG8_SB(1, 0), cB + kstepB, voffB); PG8_STAGE(PG8_SA(1, 0), cA + kstepA, voffA); PG8_STAGEB(PG8_SB(1, 1), cB + hstepB + kstepB, voffB);
        PG8_WAIT_V(6); PG8_BAR;
    } else {
        PG8_STAGEB(PG8_SB(0, 0), cB, voffB); PG8_STAGE(PG8_SA(0, 0), cA, voffA); PG8_STAGEB(PG8_SB(0, 1), cB + hstepB, voffB); PG8_STAGE(PG8_SA(0, 1), cA + hstepA, voffA);
        if (wr == 1) PG8_BAR;
        PG8_WAIT_V(4); PG8_BAR;
        PG8_STAGEB(PG8_SB(1, 0), cB + kstepB, voffB); PG8_STAGE(PG8_SA(1, 0), cA + kstepA, voffA); PG8_STAGEB(PG8_SB(1, 1), cB + hstepB + kstepB, voffB);
        PG8_WAIT_V(6); PG8_BAR;
    }
    for (;;) {
        const bool has_next = S.next(ui + 1, nxt);
        const bool nrev = PG8_REV(ui + 1);
        const long nkstepA = has_next ? (nrev ? -ksA : ksA) : kstepA, nkstepB = has_next ? (nrev ? -ksB : ksB) : kstepB;
        const char* nA = has_next ? (const char*)g.A + (size_t)nxt.pm * tstepA + (nrev ? (long)(nt - 1) * ksA : 0l) : cA; const char* nB = has_next ? (const char*)g.Bt + (size_t)nxt.pn * tstepB + (nrev ? (long)(nt - 1) * ksB : 0l) : cB;
        if constexpr (SP2) {
            if (wr == 0) {
                for (int t = 0; t < nt; t += 2) {
            const bool last = (t == nt - 2);
            const char* a1 = cA + (long)(t + 1) * kstepA;
            const char* a2 = last ? nA : cA + (long)(t + 2) * kstepA; const char* b2 = last ? nB : cB + (long)(t + 2) * kstepB;
            const char* a3 = a2 + (last ? nkstepA : kstepA); const char* b3 = b2 + (last ? nkstepB : kstepB);
            if (last && has_next) S.a_ready(nxt);
            PG8_LDB(B0, 0, 0); PG8_LDB(B1, 0, 1); PG8_SCHED; PG8_LDA(At, 0, 0); PG8_STAGE(PG8_SA(1, 1), a1 + hstepA, voffA);
            PG8_WAIT_L(0); PG8_BAR; PG8_MMA(0, 0, At, B0); PG8_MMA(0, 1, At, B1); PG8_WAIT_V(8); PG8_BAR; PG8_SCHED;
            PG8_LDA(At, 0, 1); PG8_STAGEB(PG8_SB(0, 0), b2, voffB); PG8_STAGEB(PG8_SB(0, 1), b2 + hstepB, voffB); PG8_STAGE(PG8_SA(0, 0), a2, voffA);
            PG8_WAIT_L(0); PG8_BAR; PG8_MMA(1, 0, At, B0); PG8_MMA(1, 1, At, B1); PG8_WAIT_V(8); PG8_BAR; PG8_SCHED;
            PG8_LDB(B0, 1, 0); PG8_LDB(B1, 1, 1); PG8_SCHED; PG8_LDA(At, 1, 0); PG8_STAGE(PG8_SA(0, 1), a2 + hstepA, voffA);
            PG8_WAIT_L(0); PG8_BAR; PG8_MMA(0, 0, At, B0); PG8_MMA(0, 1, At, B1); PG8_WAIT_V(8); PG8_BAR; PG8_SCHED;
            PG8_LDA(At, 1, 1); PG8_STAGEB(PG8_SB(1, 0), b3, voffB); PG8_STAGEB(PG8_SB(1, 1), b3 + hstepB, voffB); PG8_STAGE(PG8_SA(1, 0), a3, voffA);
            PG8_WAIT_L(0); PG8_BAR; PG8_MMA(1, 0, At, B0); PG8_MMA(1, 1, At, B1); PG8_WAIT_V(8); PG8_BAR; PG8_SCHED;
                }
            } else {
                for (int t = 0; t < nt; t += 2) {
            const bool last = (t == nt - 2);
            const char* a1 = cA + (long)(t + 1) * kstepA;
            const char* a2 = last ? nA : cA + (long)(t + 2) * kstepA; const char* b2 = last ? nB : cB + (long)(t + 2) * kstepB;
            const char* a3 = a2 + (last ? nkstepA : kstepA); const char* b3 = b2 + (last ? nkstepB : kstepB);
            if (last && has_next) S.a_ready(nxt);
            PG8_LDB(B0, 0, 0); PG8_LDB(B1, 0, 1); PG8_SCHED; PG8_LDA(At, 0, 0); PG8_STAGE(PG8_SA(1, 1), a1 + hstepA, voffA);
            PG8_WAIT_V(8); PG8_WAIT_L(0); PG8_BAR; PG8_MMA(0, 0, At, B0); PG8_MMA(0, 1, At, B1); PG8_BAR; PG8_SCHED;
            PG8_LDA(At, 0, 1); PG8_STAGEB(PG8_SB(0, 0), b2, voffB); PG8_STAGEB(PG8_SB(0, 1), b2 + hstepB, voffB); PG8_STAGE(PG8_SA(0, 0), a2, voffA);
            PG8_WAIT_V(8); PG8_WAIT_L(0); PG8_BAR; PG8_MMA(1, 0, At, B0); PG8_MMA(1, 1, At, B1); PG8_BAR; PG8_SCHED;
            PG8_LDB(B0, 1, 0); PG8_LDB(B1, 1, 1); PG8_SCHED; PG8_LDA(At, 1, 0); PG8_STAGE(PG8_SA(0, 1), a2 + hstepA, voffA);
            PG8_WAIT_V(8); PG8_WAIT_L(0); PG8_BAR; PG8_MMA(0, 0, At, B0); PG8_MMA(0, 1, At, B1); PG8_BAR; PG8_SCHED;
            PG8_LDA(At, 1, 1); PG8_STAGEB(PG8_SB(1, 0), b3, voffB); PG8_STAGEB(PG8_SB(1, 1), b3 + hstepB, voffB); PG8_STAGE(PG8_SA(1, 0), a3, voffA);
            PG8_WAIT_V(8); PG8_WAIT_L(0); PG8_BAR; PG8_MMA(1, 0, At, B0); PG8_MMA(1, 1, At, B1); PG8_BAR; PG8_SCHED;
                }
            }
        } else {
            for (int t = 0; t < nt; t += 2) {
            const bool last = (t == nt - 2);
            const char* a1 = cA + (long)(t + 1) * kstepA;
            const char* a2 = last ? nA : cA + (long)(t + 2) * kstepA; const char* b2 = last ? nB : cB + (long)(t + 2) * kstepB;
            const char* a3 = a2 + (last ? nkstepA : kstepA); const char* b3 = b2 + (last ? nkstepB : kstepB);
            if (last && has_next) S.a_ready(nxt);
            PG8_LDB(B0, 0, 0); PG8_SCHED; PG8_LDA(At, 0, 0); PG8_STAGE(PG8_SA(1, 1), a1 + hstepA, voffA);
            PG8_WAIT_L(8); PG8_BAR; PG8_WAIT_L(0); PG8_MMA(0, 0, At, B0); PG8_BAR; PG8_SCHED;
            PG8_LDB(B1, 0, 1); PG8_STAGEB(PG8_SB(0, 0), b2, voffB);
            PG8_BAR; PG8_WAIT_L(0); PG8_MMA(0, 1, At, B1); PG8_BAR;
            PG8_LDA(At, 0, 1); PG8_STAGE(PG8_SA(0, 0), a2, voffA);
            PG8_BAR; PG8_WAIT_L(0); PG8_MMA(1, 0, At, B0); PG8_BAR; PG8_SCHED;
            PG8_STAGEB(PG8_SB(0, 1), b2 + hstepB, voffB);
            PG8_WAIT_V(6); PG8_BAR; PG8_MMA(1, 1, At, B1); PG8_BAR;
            PG8_LDB(B0, 1, 0); PG8_SCHED; PG8_LDA(At, 1, 0); PG8_STAGE(PG8_SA(0, 1), a2 + hstepA, voffA);
            PG8_WAIT_L(8); PG8_BAR; PG8_WAIT_L(0); PG8_MMA(0, 0, At, B0); PG8_BAR; PG8_SCHED;
            PG8_LDB(B1, 1, 1); PG8_STAGEB(PG8_SB(1, 0), b3, voffB);
            PG8_BAR; PG8_WAIT_L(0); PG8_MMA(0, 1, At, B1); PG8_BAR;
            PG8_LDA(At, 1, 1); PG8_STAGE(PG8_SA(1, 0), a3, voffA);
            PG8_BAR; PG8_WAIT_L(0); PG8_MMA(1, 0, At, B0); PG8_BAR; PG8_SCHED;
            PG8_STAGEB(PG8_SB(1, 1), b3 + hstepB, voffB);
            PG8_WAIT_V(6); PG8_BAR; PG8_MMA(1, 1, At, B1); PG8_BAR;
            }
        }
        if constexpr (ALIGN_EPI) { if (wr == 0) PG8_BAR; }
        if constexpr (!Epi::AFTER_DRAIN) { E(acc, cur, wr, wc, fr, fq); S.done(cur); }
        if (!has_next) break;
#pragma unroll
        for (int a = 0; a < 2; ++a)
#pragma unroll
            for (int b = 0; b < 2; ++b)
#pragma unroll
                for (int m = 0; m < 4; ++m)
#pragma unroll
                    for (int n = 0; n < 2; ++n) acc[a][b][m][n] = (f32x4){0.f, 0.f, 0.f, 0.f};
        cur = nxt; cA = nA; cB = nB; kstepA = nkstepA; kstepB = nkstepB; ++ui;
        if constexpr (ALIGN_EPI) { if (wr == 1) PG8_BAR; }
    }
    PG8_WAIT_V(0);
    if constexpr (!ALIGN_EPI) { if (wr == 0) PG8_BAR; }
    PG8_BAR;
    if constexpr (Epi::AFTER_DRAIN) { E.fused(acc, cur, wr, wc, fr, fq, lds, wid, lane); S.done(cur); }
#undef PG8_REV
#undef PG8_SA
#undef PG8_SB
#undef PG8_STAGE
#undef PG8_LDA
#undef PG8_LDB
#undef PG8_MMA
#undef PG8_WAIT_V
#undef PG8_WAIT_L
#undef PG8_BAR
#undef PG8_SCHED
}
}

constexpr int BATCH = 2, SEQ = 4096, DM = 4096, M = BATCH * SEQ;
constexpr int QLORA = 1024, KVLORA = 512, NH = 32, DQK = 192, DNOPE = 128, DROPE = 64, DV = 128;
constexpr int N1 = 1792;
constexpr int QW = NH * DQK;
constexpr int DFF = 11008, DFF2 = 22016;
constexpr int SWH = 64, SWKV = 8, SWD = 64, WIN = 128, QK1W = 4096 + 512 + 512;
constexpr float EPS = 1e-6f;
constexpr float LOG2E = 1.4426950408889634f;
constexpr float QS0 = (float)(0.07216878364870322 * 1.4426950408889634);
constexpr float QS1 = (float)(0.125 * 1.4426950408889634);
constexpr int NWAVES = 8;
constexpr int FLIP_IN = 0;
constexpr int ZIG_OUT = 1, ZIG_DEF = 0;
constexpr int K0IN_ON = 0;
constexpr int XTILED = 0;
constexpr bool LEADB_IN = false;
constexpr int WTILED = 1;

constexpr size_t MiB = 1u << 20;
constexpr size_t WS_CTL = 0, CTL_ZERO_BYTES = 1 * MiB;
constexpr size_t WS_CS    = 2 * MiB;
constexpr size_t WS_RS    = 6 * MiB;
constexpr size_t WS_W1T   = 8 * MiB;
constexpr size_t WS_WUQT  = WS_W1T   + (size_t)N1 * DM * 2;
constexpr size_t WS_WKNT  = WS_WUQT  + (size_t)QW * QLORA * 2;
constexpr size_t WS_WVT   = WS_WKNT  + (size_t)4096 * KVLORA * 2;
constexpr size_t WS_WO0T  = WS_WVT   + (size_t)4096 * KVLORA * 2;
constexpr size_t WS_WIN0T = WS_WO0T  + (size_t)DM * DM * 2;
constexpr size_t WS_WOUT0T= WS_WIN0T + (size_t)DFF2 * DM * 2;
constexpr size_t WS_WQK1T = WS_WOUT0T+ (size_t)DM * DFF * 2;
constexpr size_t WS_WV1T  = WS_WQK1T + (size_t)QK1W * DM * 2;
constexpr size_t WS_WO1T  = WS_WV1T  + (size_t)512 * DM * 2;
constexpr size_t WS_WIN1T = WS_WO1T  + (size_t)DM * DM * 2;
constexpr size_t WS_WOUT1T= WS_WIN1T + (size_t)DFF2 * DM * 2;
constexpr size_t WS_XN    = WS_WOUT1T+ (size_t)DM * DFF * 2;
constexpr size_t WS_CQKV  = WS_XN    + (size_t)M * DM * 2;
constexpr size_t WS_CQN   = WS_CQKV  + (size_t)M * N1 * 4;
constexpr size_t WS_CKV   = WS_CQN   + (size_t)M * QLORA * 2;
constexpr size_t WS_QF    = WS_CKV   + (size_t)M * KVLORA * 2;
constexpr size_t WS_Q     = WS_QF    + (size_t)M * QW * 4;
constexpr size_t WS_K     = WS_Q     + (size_t)M * QW * 2;
constexpr size_t WS_VT    = WS_K     + (size_t)M * QW * 2;
constexpr size_t WS_O     = WS_VT    + (size_t)4096 * M * 2;
constexpr size_t WS_AF    = WS_O     + (size_t)M * DM * 2;
constexpr size_t WS_U     = WS_AF    + (size_t)M * DM * 4;
constexpr size_t WS_ACT   = WS_U     + (size_t)M * DFF2 * 2;
constexpr size_t WS_QK1   = WS_ACT   + (size_t)M * DFF * 2;
constexpr size_t WS_VT1   = WS_QK1   + (size_t)M * QK1W * 2;
constexpr size_t WS_END   = WS_VT1   + (size_t)512 * M * 2;
constexpr int CW_BAR = 4096;

constexpr int RING_OFF = 0, RING_BYTES = 131072;
constexpr int LDSCTL_OFF = RING_BYTES, MISC_OFF = LDSCTL_OFF + 320;
constexpr int JOBS_OFF = LDSCTL_OFF + 1024;
constexpr int LDS_BYTES = 147456;
#define GAS __attribute__((address_space(1)))
#define LAS __attribute__((address_space(3)))
typedef unsigned short bf16;
typedef unsigned v4u __attribute__((ext_vector_type(4)));
typedef float f32x4 __attribute__((ext_vector_type(4)));
typedef short bf16x8 __attribute__((ext_vector_type(8)));
typedef GAS unsigned gu32;
typedef GAS unsigned long long gu64;
#define RLX_AGENT __ATOMIC_RELAXED, __HIP_MEMORY_SCOPE_AGENT
#define LDS_WAIT() asm volatile("s_waitcnt lgkmcnt(0)" ::: "memory")
#define VM_WAIT() asm volatile("s_waitcnt vmcnt(0)" ::: "memory")
__device__ __forceinline__ unsigned long long rt() { return __builtin_amdgcn_s_memrealtime(); }
__device__ __forceinline__ unsigned f2bf(float f) { unsigned u = __builtin_bit_cast(unsigned, f); return (u + 0x7fffu + ((u >> 16) & 1u)) >> 16; }
__device__ __forceinline__ unsigned pk2(float lo, float hi) { return f2bf(lo) | (f2bf(hi) << 16); }

#define XB_TMO      128
#define XB_XCNT(j)  (256  + 64 * (j))
#define XB_XSUB(j)  (1280 + 64 * (j))
#define XB_XGEN(j)  (2304 + 64 * (j))
#define XB_TOP      3328
#define XB_TOPGEN   3392
#define XCD_BAR_WORDS 3456
#define XB_SPIN_CAP (1u << 18)

__device__ __forceinline__ unsigned xb_ld(unsigned* p)              { return __hip_atomic_load(p, __ATOMIC_RELAXED, __HIP_MEMORY_SCOPE_AGENT); }
__device__ __forceinline__ unsigned xb_add(unsigned* p, unsigned v) { return __hip_atomic_fetch_add(p, v, __ATOMIC_RELAXED, __HIP_MEMORY_SCOPE_AGENT); }
__device__ __forceinline__ unsigned xb_xcc_id() { return (unsigned)__builtin_amdgcn_s_getreg((3 << 11) | 20) & 0xFu; }
#define XB_SPIN(cond, bar) do { unsigned _sp = 0; while (cond) { __builtin_amdgcn_s_sleep(1); \
    if ((++_sp & 255u) == 0u) { if (xb_ld(&(bar)[XB_TMO])) break; if (_sp > XB_SPIN_CAP) { atomicAdd(&(bar)[XB_TMO], 1u); break; } } } } while (0)

struct XcdBarrier {
    unsigned* bar; unsigned x;
    volatile LAS unsigned* st;
};

__device__ __forceinline__ XcdBarrier xcd_barrier_post(unsigned* bar, volatile LAS unsigned* st) {
    XcdBarrier b; b.bar = bar; b.x = xb_xcc_id(); b.st = st;
    if (threadIdx.x == 0) (void)xb_add(&bar[XB_XCNT(b.x)], 1u);
    return b;
}
__device__ __forceinline__ void xcd_barrier_complete(unsigned* bar, unsigned x, unsigned& nloc, unsigned& nx) {
    const unsigned G = gridDim.x * gridDim.y * gridDim.z;
    unsigned sum, cnt, mine, sp = 0u;
    for (;;) {
        sum = 0u; cnt = 0u; mine = 0u;
#pragma unroll
        for (unsigned j = 0; j < 16; ++j) { const unsigned c = xb_ld(&bar[XB_XCNT(j)]); sum += c; cnt += (c > 0u) ? 1u : 0u; mine = (j == x) ? c : mine; }
        if (sum == G) break;
        __builtin_amdgcn_s_sleep(1);
        if ((++sp & 255u) == 0u) { if (xb_ld(&bar[XB_TMO])) break; if (sp > XB_SPIN_CAP) { atomicAdd(&bar[XB_TMO], 1u); break; } }
    }
    nloc = mine > 0u ? mine : 1u; nx = cnt > 0u ? cnt : 1u;
}

__device__ __forceinline__ void xcd_barrier(const XcdBarrier& b) {
    asm volatile("s_waitcnt vmcnt(0)" ::: "memory");
    __syncthreads();
    if (threadIdx.x == 0) {
        unsigned* bar = b.bar;
        __builtin_amdgcn_s_waitcnt(0);
        unsigned nloc = b.st[0], nx = b.st[1];
        if (nloc == 0u) { xcd_barrier_complete(bar, b.x, nloc, nx); b.st[0] = nloc; b.st[1] = nx; }
        const unsigned old = xb_add(&bar[XB_XSUB(b.x)], 1u);
        const unsigned gen = old / nloc;
        if (old + 1u == (gen + 1u) * nloc) {
            __builtin_amdgcn_fence(__ATOMIC_RELEASE, "agent");
            asm volatile("s_waitcnt vmcnt(0)" ::: "memory");
            const unsigned og = xb_add(&bar[XB_TOP], 1u);
            const unsigned tg = og / nx;
            if (og + 1u == (tg + 1u) * nx) xb_add(&bar[XB_TOPGEN], 1u);
            else XB_SPIN(xb_ld(&bar[XB_TOPGEN]) == tg, bar);
            __builtin_amdgcn_fence(__ATOMIC_ACQUIRE, "agent");
            xb_add(&bar[XB_XGEN(b.x)], 1u);
            asm volatile("s_waitcnt vmcnt(0)" ::: "memory");
        } else {
            XB_SPIN(xb_ld(&bar[XB_XGEN(b.x)]) == gen, bar);
            __builtin_amdgcn_fence(__ATOMIC_ACQUIRE, "agent");
            asm volatile("s_waitcnt vmcnt(0)" ::: "memory");
        }
    }
    __syncthreads();
}

typedef float f32x16 __attribute__((ext_vector_type(16)));
typedef float f32x2v __attribute__((ext_vector_type(2)));
typedef unsigned u32x2v __attribute__((ext_vector_type(2)));
__device__ __forceinline__ unsigned cvtpk(float lo, float hi) { unsigned r; asm volatile("v_cvt_pk_bf16_f32 %0, %1, %2" : "=v"(r) : "v"(lo), "v"(hi)); return r; }
#define PACK8(P, B) __builtin_bit_cast(bf16x8, (v4u){cvtpk(P[(B) + 0], P[(B) + 1]), cvtpk(P[(B) + 2], P[(B) + 3]), cvtpk(P[(B) + 4], P[(B) + 5]), cvtpk(P[(B) + 6], P[(B) + 7])})
__device__ __forceinline__ float wave_sum(float v) {
#pragma unroll
    for (int o = 1; o < 64; o <<= 1) v += __shfl_xor(v, o);
    return v;
}
__device__ __forceinline__ int pi32(int m) { return (m & ~0xC) | ((m & 4) << 1) | ((m & 8) >> 1); }
__constant__ float kFreq[32] = {
    1.000000000e+00f, 7.498942614e-01f, 5.623413324e-01f, 4.216965139e-01f, 3.162277639e-01f, 2.371373773e-01f, 1.778279394e-01f, 1.333521307e-01f,
    1.000000015e-01f, 7.498941571e-02f, 5.623413250e-02f, 4.216965288e-02f, 3.162277490e-02f, 2.371373773e-02f, 1.778279431e-02f, 1.333521493e-02f,
    9.999999776e-03f, 7.498941850e-03f, 5.623413250e-03f, 4.216964822e-03f, 3.162277630e-03f, 2.371373586e-03f, 1.778279431e-03f, 1.333521446e-03f,
    1.000000047e-03f, 7.498942432e-04f, 5.623413017e-04f, 4.216965172e-04f, 3.162277571e-04f, 2.371373703e-04f, 1.778279402e-04f, 1.333521504e-04f};

struct Ctx { LAS unsigned char* lds; int tid, lane, wave, vcu, G; };

struct WJob { const float* W; const float* gain; bf16* WT; int ldw, K, ncols, col0, gs, gsrc, drow0, item0, mode, pad; };
constexpr int NJOBS = 14;
__device__ __forceinline__ void wt_item(const float* W, const float* gain, bf16* WT, int ldw, int K, int ncols, int col0, int gs, int gsrc, int drow0, LAS float* scr, int item, int lane) {
    const int nblk = ncols / 32, kb = item / nblk, nb = item - kb * nblk, k0 = 64 * kb, n0 = 32 * nb;
    const int grp = n0 / gs, sc0 = col0 + grp * gsrc + (n0 - grp * gs);
    const float* src = W + (size_t)k0 * ldw + sc0 + (lane & 31);
#pragma unroll 8
    for (int i = 0; i < 32; ++i) { const int kk = 2 * i + (lane >> 5); float w = src[(size_t)kk * ldw]; if (gain) w *= gain[k0 + kk]; scr[kk * 33 + (lane & 31)] = w; }
    LDS_WAIT(); asm volatile("" ::: "memory");
    const int c = lane & 7;
#pragma unroll
    for (int j = 0; j < 4; ++j) { const int n = (lane >> 3) + 8 * j; const LAS float* s = scr + (8 * c) * 33 + n;
        v4u o; o.x = cvtpk(s[0 * 33], s[1 * 33]); o.y = cvtpk(s[2 * 33], s[3 * 33]); o.z = cvtpk(s[4 * 33], s[5 * 33]); o.w = cvtpk(s[6 * 33], s[7 * 33]);
        *(GAS v4u*)(WT + (WTILED ? pg8::tiled_off(drow0 + n0 + n, k0 + 8 * c, K) : (size_t)(drow0 + n0 + n) * K + k0 + 8 * c)) = o; }
    LDS_WAIT(); asm volatile("" ::: "memory");
}
struct WTile { const float* base; unsigned voff; const float* gain; const float* gsafe; bf16* dst; int ldw, K, n0, mode, drow0; };
__device__ __forceinline__ bool wt_decode(const LAS WJob* jobs, int nblkjobs, int ntiles, int T, int lane, int wave, WTile& t, int hole_lo = 0x7fffffff, int hole_len = 0) {
    if (T >= hole_lo) T += hole_len;
    if (T >= ntiles) return false;
    int j = 0;
    for (int q = 1; q < nblkjobs; ++q) j += (T >= jobs[q].item0) ? 1 : 0;
    const LAS WJob& J = jobs[j];
    const int lt = T - J.item0, nblk = J.ncols >> 8, kb = lt / nblk, nb = lt - kb * nblk, k0 = 64 * kb, n0 = 256 * nb;
    const int nn = n0 + 4 * (lane ^ wave), grp = nn / J.gs, sc = J.col0 + grp * J.gsrc + (nn - grp * J.gs);
    t.base = J.W; t.voff = (unsigned)(((size_t)(k0 + 8 * wave) * J.ldw + sc) * 4); t.gain = J.gain ? J.gain + k0 : nullptr; t.gsafe = J.W; t.dst = WTILED ? J.WT + (size_t)kb * 16384 : J.WT + (size_t)J.drow0 * J.K + k0; t.drow0 = J.drow0; t.ldw = J.ldw; t.K = J.K; t.n0 = n0; t.mode = J.mode;
    return true;
}
__device__ __forceinline__ void wt_block_phase(const Ctx& F, const LAS WJob* jobs, int nblkjobs, int tile_lo, int ntiles, int rank, int nranks, int hole_lo = 0x7fffffff, int hole_len = 0) {
    const int lane = F.lane, wave = F.wave, kcl = lane & 7, nl = lane >> 3;
#define WT_ISSUE(t, b, g0, g1) do { const GAS float* gp_ = (const GAS float*)((t).gain ? (t).gain : (t).gsafe) + 8 * kcl; \
        asm volatile("global_load_dwordx4 %0, %1, off" : "=v"(g0) : "v"(gp_) : "memory"); asm volatile("global_load_dwordx4 %0, %1, off offset:16" : "=v"(g1) : "v"(gp_) : "memory");     \
        asm volatile("" ::: "memory"); \
        {     \
            const unsigned long long wb_ = (unsigned long long)(t).base; \
            const unsigned long long wbs_ = ((unsigned long long)(unsigned)__builtin_amdgcn_readfirstlane((int)(wb_ >> 32)) << 32) | (unsigned)__builtin_amdgcn_readfirstlane((int)wb_); \
            const __amdgpu_buffer_rsrc_t srdw_ = __builtin_amdgcn_make_buffer_rsrc((void*)wbs_, (short)0, 0x7ffff000, 0x00020000); \
            const int rowb_ = __builtin_amdgcn_readfirstlane((t).ldw) * 4; \
            _Pragma("unroll") for (int i = 0; i < 8; ++i) __builtin_amdgcn_raw_ptr_buffer_load_lds(srdw_, (LAS void*)(F.lds + (b) * 65536 + (8 * wave + i) * 1024), 16, (t).voff, i * rowb_, 0, 2  ); } \
        asm volatile("" ::: "memory"); } while (0)
#define WT_STEP(X, bx, gx0, gx1, Y, hy, by, gy0, gy1) do { \
        asm volatile("s_waitcnt vmcnt(0) lgkmcnt(0)\n\ts_barrier" : "+v"(gx0), "+v"(gx1) :: "memory"); \
        T += nranks; hy = wt_decode(jobs, nblkjobs, ntiles, T, lane, wave, Y, hole_lo, hole_len); \
        if (hy) WT_ISSUE(Y, by, gy0, gy1); \
        {   const LAS unsigned char* buf = F.lds + (bx) * 65536; \
            const f32x4 one4 = {1.f, 1.f, 1.f, 1.f}; const f32x4 ga = (X).gain ? gx0 : one4, gb = (X).gain ? gx1 : one4; \
            _Pragma("unroll") for (int c = 0; c < 4; ++c) { const int n = 8 * (wave + 8 * c) + nl; \
                const LAS unsigned char* p = buf + (8 * kcl) * 1024 + ((((n >> 2) ^ kcl)) << 4) + ((n & 3) << 2); \
                float v[8]; \
                _Pragma("unroll") for (int e = 0; e < 8; ++e) v[e] = *(const LAS float*)(p + e * 1024); \
                v4u o; o.x = cvtpk(v[0] * ga.x, v[1] * ga.y); o.y = cvtpk(v[2] * ga.z, v[3] * ga.w); o.z = cvtpk(v[4] * gb.x, v[5] * gb.y); o.w = cvtpk(v[6] * gb.z, v[7] * gb.w); \
                int dn = (X).n0 + n; \
                if ((X).mode == 1) { const int hd = dn / DQK; int cl = dn - hd * DQK; if (cl >= DNOPE) { const int w = (cl - DNOPE) >> 5, pp = (cl - DNOPE) & 31; cl = DNOPE + 2 * pp + w; } dn = hd * DQK + cl; } \
                else if ((X).mode == 2) { dn = dn < DFF ? ((dn >> 7) * 256 + (dn & 127)) : (((dn - DFF) >> 7) * 256 + 128 + ((dn - DFF) & 127)); } \
                if (WTILED) { dn += (X).drow0; *(GAS v4u*)((X).dst + (size_t)(dn >> 8) * ((size_t)(X).K << 8) + ((dn & 255) << 6) + 8 * kcl) = o; } \
                else *(GAS v4u*)((X).dst + (size_t)dn * (X).K + 8 * kcl) = o; } } } while (0)
    WTile A, B;
    f32x4 gA0, gA1, gB0, gB1;
    gA0 = gA1 = gB0 = gB1 = (f32x4){1.f, 1.f, 1.f, 1.f};
    int T = tile_lo + rank;
    bool hA = wt_decode(jobs, nblkjobs, ntiles, T, lane, wave, A, hole_lo, hole_len), hB = false;
    if (!hA) return;
    WT_ISSUE(A, 0, gA0, gA1);
    for (;;) {
        WT_STEP(A, 0, gA0, gA1, B, hB, 1, gB0, gB1);
        if (!hB) break;
        WT_STEP(B, 1, gB0, gB1, A, hA, 0, gA0, gA1);
        if (!hA) break;
    }
    asm volatile("s_waitcnt vmcnt(0) lgkmcnt(0)\n\ts_barrier" ::: "memory");
#undef WT_STEP
#undef WT_ISSUE
}
__device__ __forceinline__ void sincos_d(float angf, float& s, float& c) {
    const double x = (double)angf;
    const double kd = __builtin_rint(x * 0.63661977236758134308);
    double r = __builtin_fma(-kd, 1.57079632679489655800e+00, x);
    r = __builtin_fma(-kd, 6.12323399573676603587e-17, r);
    const int k = (int)kd;
    const double r2 = r * r;
    double sp = 1.0 / 6227020800.0;
    sp = sp * r2 - 1.0 / 39916800.0; sp = sp * r2 + 1.0 / 362880.0; sp = sp * r2 - 1.0 / 5040.0; sp = sp * r2 + 1.0 / 120.0; sp = sp * r2 - 1.0 / 6.0; sp = sp * r2 + 1.0; sp = sp * r;
    double cp = -1.0 / 87178291200.0;
    cp = cp * r2 + 1.0 / 479001600.0; cp = cp * r2 - 1.0 / 3628800.0; cp = cp * r2 + 1.0 / 40320.0; cp = cp * r2 - 1.0 / 720.0; cp = cp * r2 + 1.0 / 24.0; cp = cp * r2 - 0.5; cp = cp * r2 + 1.0;
    const int q = k & 3;
    const double ss = (q == 0) ? sp : (q == 1) ? cp : (q == 2) ? -sp : -cp;
    const double cc = (q == 0) ? cp : (q == 1) ? -sp : (q == 2) ? -cp : sp;
    s = (float)ss; c = (float)cc;
}

template <int MODE, bool HF32>
__device__ __forceinline__ void rows_phase(const Ctx& F, const void* src, const void* Hin, const float* g, float* outf, bf16* HB, float* RS) {
    const int gw = F.vcu * NWAVES + F.wave, NGW = F.G * NWAVES;
#define UNPK8(dst, w) do { dst[0] = (f32x4){__uint_as_float((w).x << 16), __uint_as_float((w).x & 0xffff0000u), __uint_as_float((w).y << 16), __uint_as_float((w).y & 0xffff0000u)}; \
                           dst[1] = (f32x4){__uint_as_float((w).z << 16), __uint_as_float((w).z & 0xffff0000u), __uint_as_float((w).w << 16), __uint_as_float((w).w & 0xffff0000u)}; } while (0)
    for (int m = gw; m < M; m += NGW) {
        if (MODE == 0) {
            const GAS f32x4* a = (const GAS f32x4*)((const float*)src + (size_t)m * DM) + F.lane;
            f32x4 v[16]; float ss = 0.f;
#pragma unroll
            for (int j = 0; j < 16; ++j) { v[j] = a[64 * j]; ss += (v[j].x * v[j].x + v[j].y * v[j].y) + (v[j].z * v[j].z + v[j].w * v[j].w); }
            const float rstd = 1.0f / sqrtf(wave_sum(ss) * (1.0f / DM) + EPS);
            if (F.lane == 0) RS[m] = rstd;
            GAS unsigned long long* o8 = (GAS unsigned long long*)(HB + (size_t)m * DM) + F.lane;
#pragma unroll
            for (int j = 0; j < 16; ++j) o8[64 * j] = (unsigned long long)cvtpk(v[j].x, v[j].y) | ((unsigned long long)cvtpk(v[j].z, v[j].w) << 32);
        } else {
            const GAS v4u* a = (const GAS v4u*)((const bf16*)src + (size_t)m * DM) + F.lane;
            f32x4 v[8][2]; float ss = 0.f;
#pragma unroll
            for (int j = 0; j < 8; ++j) { const v4u w = a[64 * j]; UNPK8(v[j], w);
#pragma unroll
                for (int e = 0; e < 2; ++e) ss += (v[j][e].x * v[j][e].x + v[j][e].y * v[j][e].y) + (v[j][e].z * v[j][e].z + v[j][e].w * v[j][e].w); }
            const float rstd = 1.0f / sqrtf(wave_sum(ss) * (1.0f / DM) + EPS);
            const GAS f32x4* gp = (const GAS f32x4*)g + 2 * F.lane;
            float s2 = 0.f;
#pragma unroll
            for (int j = 0; j < 8; ++j) {
                f32x4 hv[2];
                if (HF32) { const GAS f32x4* hp = (const GAS f32x4*)((const float*)Hin + (size_t)m * DM) + 2 * F.lane; hv[0] = hp[128 * j]; hv[1] = hp[128 * j + 1]; }
                else      { const v4u w = ((const GAS v4u*)((const bf16*)Hin + (size_t)m * DM) + F.lane)[64 * j]; UNPK8(hv, w); }
#pragma unroll
                for (int e = 0; e < 2; ++e) { const f32x4 gv = gp[128 * j + e]; const f32x4 o = hv[e] + (v[j][e] * rstd) * gv; v[j][e] = o; s2 += (o.x * o.x + o.y * o.y) + (o.z * o.z + o.w * o.w); }
            }
            if (MODE == 1) {
                const float rstd2 = 1.0f / sqrtf(wave_sum(s2) * (1.0f / DM) + EPS);
                if (F.lane == 0) RS[m] = rstd2;
                GAS v4u* o16 = (GAS v4u*)(HB + (size_t)m * DM) + F.lane;
#pragma unroll
                for (int j = 0; j < 8; ++j) { v4u w; w.x = cvtpk(v[j][0].x, v[j][0].y); w.y = cvtpk(v[j][0].z, v[j][0].w); w.z = cvtpk(v[j][1].x, v[j][1].y); w.w = cvtpk(v[j][1].z, v[j][1].w); o16[64 * j] = w; }
            } else {
                GAS f32x4* op = (GAS f32x4*)(outf + (size_t)m * DM) + 2 * F.lane;
#pragma unroll
                for (int j = 0; j < 8; ++j) { op[128 * j] = v[j][0]; op[128 * j + 1] = v[j][1]; }
            }
        }
    }
#undef UNPK8
}
__device__ __forceinline__ void latent_rows_phase(const Ctx& F, const float* CQKV, const float* CS, bf16* CQN, bf16* CKV, bf16* K) {
    const int gw = F.vcu * NWAVES + F.wave, NGW = F.G * NWAVES, lane = F.lane, l32 = lane & 31;
    for (int m = gw; m < M; m += NGW) {
        const float* row = CQKV + (size_t)m * N1;
        { const GAS f32x4* a = (const GAS f32x4*)row + lane; f32x4 v[4]; float ss = 0.f;
#pragma unroll
          for (int j = 0; j < 4; ++j) { v[j] = a[64 * j]; ss += (v[j].x * v[j].x + v[j].y * v[j].y) + (v[j].z * v[j].z + v[j].w * v[j].w); }
          const float rstd = 1.0f / sqrtf(wave_sum(ss) * (1.0f / QLORA) + EPS);
          GAS unsigned long long* o8 = (GAS unsigned long long*)(CQN + (size_t)m * QLORA) + lane;
#pragma unroll
          for (int j = 0; j < 4; ++j) o8[64 * j] = (unsigned long long)cvtpk(v[j].x * rstd, v[j].y * rstd) | ((unsigned long long)cvtpk(v[j].z * rstd, v[j].w * rstd) << 32); }
        { const GAS f32x4* a = (const GAS f32x4*)(row + QLORA) + lane; f32x4 v[2]; float ss = 0.f;
#pragma unroll
          for (int j = 0; j < 2; ++j) { v[j] = a[64 * j]; ss += (v[j].x * v[j].x + v[j].y * v[j].y) + (v[j].z * v[j].z + v[j].w * v[j].w); }
          const float rstd = 1.0f / sqrtf(wave_sum(ss) * (1.0f / KVLORA) + EPS);
          GAS unsigned long long* o8 = (GAS unsigned long long*)(CKV + (size_t)m * KVLORA) + lane;
#pragma unroll
          for (int j = 0; j < 2; ++j) o8[64 * j] = (unsigned long long)cvtpk(v[j].x * rstd, v[j].y * rstd) | ((unsigned long long)cvtpk(v[j].z * rstd, v[j].w * rstd) << 32); }
        { const float x1 = row[QLORA + KVLORA + l32], x2 = row[QLORA + KVLORA + 32 + l32];
          const float co = CS[(size_t)m * 64 + l32], si = CS[(size_t)m * 64 + 32 + l32];
          const float o1 = x1 * co - x2 * si, o2 = x2 * co + x1 * si;
          const int a = (2 * l32) & 31, which = l32 >> 4;
          const float a0 = __shfl(o1, a), a1 = __shfl(o1, a + 1), b0 = __shfl(o2, a), b1 = __shfl(o2, a + 1);
          const unsigned w = cvtpk(which ? b0 : a0, which ? b1 : a1);
          GAS unsigned* kd = (GAS unsigned*)(K + (size_t)m * QW + DNOPE) + l32;
#pragma unroll
          for (int it = 0; it < 16; ++it) { const int head = 2 * it + (lane >> 5); kd[head * (DQK / 2)] = w; } }
    }
}
__device__ __forceinline__ void q_rope_phase(const Ctx& F, const float* QF, const float* CS, bf16* Q) {
    const int gw = F.vcu * NWAVES + F.wave, NGW = F.G * NWAVES, lane = F.lane, l32 = lane & 31;
    for (int m = gw; m < M; m += NGW) {
        const float* qrow = QF + (size_t)m * QW; bf16* qo = Q + (size_t)m * QW;
        const float co = CS[(size_t)m * 64 + l32], si = CS[(size_t)m * 64 + 32 + l32];
        const int a = (2 * l32) & 31, which = l32 >> 4;
#pragma unroll 4
        for (int h = 0; h < NH; ++h) {
            const int base = h * DQK;
            const f32x2v nv = *(const GAS f32x2v*)(qrow + base + 2 * lane);
            *(GAS unsigned*)(qo + base + 2 * lane) = cvtpk(nv.x * QS0, nv.y * QS0);
            const float x1 = qrow[base + DNOPE + l32], x2 = qrow[base + DNOPE + 32 + l32];
            const float o1 = (x1 * co - x2 * si) * QS0, o2 = (x2 * co + x1 * si) * QS0;
            const float a0 = __shfl(o1, a), a1 = __shfl(o1, a + 1), b0 = __shfl(o2, a), b1 = __shfl(o2, a + 1);
            const unsigned w = cvtpk(which ? b0 : a0, which ? b1 : a1);
            if (lane < 32) *(GAS unsigned*)(qo + base + DNOPE + 2 * lane) = w;
        }
    }
}
__device__ __forceinline__ void conv_fix_phase(const Ctx& F, const float* PART, const float* HALO, const float* cw, const float* cb, bf16* ACT) {
    constexpr int NJ = DFF / 4, NB = M / 64;
    const int gt = F.vcu * (NWAVES * 64) + F.tid, NT = F.G * NWAVES * 64;
    for (int it = gt; it < NB * 2 * NJ; it += NT) {
        const int j = 4 * (it % NJ), br = it / NJ, r = br & 1, blk = br >> 1;
        const float* pp = PART + ((size_t)(blk * 2 + r) * 2) * DFF + j;
        f32x4 G = *(const GAS f32x4*)pp, V = *(const GAS f32x4*)(pp + DFF);
        if ((blk % (SEQ / 64)) != 0) {
            const float* h0 = HALO + ((size_t)((blk - 1) * 2 + 0) * 2) * DFF + j; const float* h1 = HALO + ((size_t)((blk - 1) * 2 + 1) * 2) * DFF + j;
            const f32x4 wg0 = *(const GAS f32x4*)(cw + j), wg1 = *(const GAS f32x4*)(cw + DFF2 + j), wv0 = *(const GAS f32x4*)(cw + DFF + j), wv1 = *(const GAS f32x4*)(cw + DFF2 + DFF + j);
            const f32x4 g62 = *(const GAS f32x4*)h0, v62 = *(const GAS f32x4*)(h0 + DFF), g63 = *(const GAS f32x4*)h1, v63 = *(const GAS f32x4*)(h1 + DFF);
            if (r == 0) { G += wg0 * g62 + wg1 * g63; V += wv0 * v62 + wv1 * v63; }
            else        { G += wg0 * g63;             V += wv0 * v63; }
        }
        float o[4];
#pragma unroll
        for (int e = 0; e < 4; ++e) o[e] = G[e] * __builtin_amdgcn_rcpf(1.0f + __builtin_amdgcn_exp2f(-G[e] * LOG2E)) * V[e];
        u32x2v w; w.x = cvtpk(o[0], o[1]); w.y = cvtpk(o[2], o[3]);
        *(GAS u32x2v*)(ACT + (pg8::EpiConvAct::ATILED ? pg8::tiled_off(64 * blk + r, j, DFF) : (size_t)(64 * blk + r) * DFF + j)) = w;
    }
}

constexpr bool PIGGY = false;
constexpr int PG_LDS = 98304;
struct PgState {
    int next_T, end_T;
    int job, job_end, kb, nb, nblk;
    int cnt; bool pend0, pend1;
};
constexpr int PG_STASH = 131072 + 4096;
__device__ __forceinline__ void pg_setjob(PgState& S, const LAS WJob* jobs, int nblkjobs) {
    const int T = S.next_T;
    int j = 0;
    for (int q = 1; q < nblkjobs; ++q) j += (T >= jobs[q].item0) ? 1 : 0;
    S.job = j; S.job_end = (j + 1 < nblkjobs) ? jobs[j + 1].item0 : 0x7fffffff;
    S.nblk = jobs[j].ncols >> 8;
    const int lt = T - jobs[j].item0; S.kb = lt / S.nblk; S.nb = lt - S.kb * S.nblk;
}
__device__ __forceinline__ void pg_issue(PgState& S, int step_T, int sub, const LAS WJob* jobs, int nblkjobs, LAS unsigned char* ldsw, LAS unsigned* stash, int wid, int lane) {
    if (S.next_T >= S.job_end) pg_setjob(S, jobs, nblkjobs);
    const LAS WJob& J = jobs[S.job];
    const int ldw = J.ldw, K = J.K;
    const int k0 = 128 * S.kb + 64 * (sub >> 2) + 8 * wid, n0 = 256 * S.nb + 64 * (sub & 3);
    const float* src = J.W + ((size_t)k0 * ldw + J.col0 + n0) + ((lane >> 4) * ldw + 4 * (lane & 15));
    __builtin_amdgcn_global_load_lds((const GAS unsigned*)src, (LAS unsigned*)ldsw, 16, 0, 0);
    __builtin_amdgcn_global_load_lds((const GAS unsigned*)(src + (size_t)4 * ldw), (LAS unsigned*)(ldsw + 1024), 16, 0, 0);
    int dn0 = n0;
    if (J.mode == 2) dn0 = n0 < DFF ? ((n0 >> 7) * 256 + (n0 & 127)) : (((n0 - DFF) >> 7) * 256 + 128 + ((n0 - DFF) & 127));
    const unsigned long long dst = (unsigned long long)(J.WT + (size_t)(J.drow0 + dn0) * K + k0), gp = J.gain ? (unsigned long long)(J.gain + k0) : 0ull;
    if (lane == 0) { stash[0] = (unsigned)dst; stash[1] = (unsigned)(dst >> 32); stash[2] = (unsigned)gp; stash[3] = (unsigned)(gp >> 32); stash[4] = (unsigned)K; }
    S.next_T += step_T; S.nb += step_T;
    while (S.nb >= S.nblk) { S.nb -= S.nblk; ++S.kb; }
    ++S.cnt;
}
typedef float f32x8s __attribute__((ext_vector_type(8)));
__device__ __forceinline__ void pg_consume(const LAS unsigned char* ldsw, const LAS unsigned* stash, int lane) {
    const unsigned d0 = stash[0], d1 = stash[1], g0_ = stash[2], g1_ = stash[3], K = stash[4];
    const unsigned long long gu = ((unsigned long long)(unsigned)__builtin_amdgcn_readfirstlane((int)g1_) << 32) | (unsigned)__builtin_amdgcn_readfirstlane((int)g0_);
    f32x8s g = {1.f, 1.f, 1.f, 1.f, 1.f, 1.f, 1.f, 1.f};
    if (gu != 0ull) asm volatile("s_load_dwordx8 %0, %1, 0x0" : "=s"(g) : "s"(gu));
    float v[8];
#pragma unroll
    for (int e = 0; e < 8; ++e) v[e] = *(const LAS float*)(ldsw + e * 256 + 4 * lane);
    asm volatile("s_waitcnt lgkmcnt(0)" : "+s"(g) :: "memory");
    v4u o; o.x = cvtpk(v[0] * g[0], v[1] * g[1]); o.y = cvtpk(v[2] * g[2], v[3] * g[3]); o.z = cvtpk(v[4] * g[4], v[5] * g[5]); o.w = cvtpk(v[6] * g[6], v[7] * g[7]);
    bf16* dst = (bf16*)(((unsigned long long)d1 << 32) | d0) + (size_t)lane * K;
    *(GAS v4u*)dst = o;
}

constexpr int MLA_KB = 64 * 384, MLA_VB = 128 * 128, MLA_V0 = 2 * MLA_KB;
template <int VAR>
__device__ __forceinline__ void mla_unit(LAS unsigned char* lds, const bf16* __restrict__ Q, const bf16* __restrict__ K, const bf16* __restrict__ VT, bf16* __restrict__ O, int b, int h, int qb, PgState& PS, const LAS WJob* jobs, int pg_step, int pg_sub) {
    const int tid = threadIdx.x, lane = tid & 63, wid = __builtin_amdgcn_readfirstlane(tid >> 6), l32 = lane & 31, hi = lane >> 5;
    const int NT = 4 * (qb + 1), rowb = b * SEQ;
    unsigned kgo[3], vgo[2];
#pragma unroll
    for (int i = 0; i < 3; ++i) { const int s_ = 64 * (3 * wid + i) + lane, row = s_ / 24, pos = s_ - 24 * row, c = (pos & ~7) | ((pos & 7) ^ ((row >> 1) & 7));
        kgo[i] = (unsigned)(((rowb + row) * QW + h * DQK + 8 * c) * 2); }
#pragma unroll
    for (int i = 0; i < 2; ++i) { const int s_ = 64 * (2 * wid + i) + lane, d = s_ >> 3, pos = s_ & 7, c = pos ^ ((d >> 1) & 7);
        vgo[i] = (unsigned)(((h * DV + d) * M + rowb + 8 * c) * 2); }
    const char* Kb = (const char*)K; const char* Vb = (const char*)VT;
    const __amdgpu_buffer_rsrc_t srdK = __builtin_amdgcn_make_buffer_rsrc((void*)Kb, (short)0, (int)((size_t)M * QW * 2), 0x00020000);
    const __amdgpu_buffer_rsrc_t srdV = __builtin_amdgcn_make_buffer_rsrc((void*)Vb, (short)0, (int)((size_t)NH * DV * M * 2), 0x00020000);
#define MLA_DMA(t_, kslot, vslot) do { \
        _Pragma("unroll") for (int i = 0; i < 3; ++i) __builtin_amdgcn_raw_ptr_buffer_load_lds(srdK, (LAS void*)(lds + (kslot) * MLA_KB + (3 * wid + i) * 1024), 16, kgo[i], (int)((unsigned)(t_) * (unsigned)(64 * QW * 2)), 0, 0); \
        _Pragma("unroll") for (int i = 0; i < 2; ++i) __builtin_amdgcn_raw_ptr_buffer_load_lds(srdV, (LAS void*)(lds + MLA_V0 + (vslot) * MLA_VB + (2 * wid + i) * 1024), 16, vgo[i], (int)((unsigned)(t_) * 128u), 0, 0); } while (0)
    MLA_DMA(0, 0, 0);
    const int qrow = rowb + 256 * qb + 32 * wid + l32;
    bf16x8 qr[12];
#pragma unroll
    for (int d0 = 0; d0 < 12; ++d0) qr[d0] = *(const GAS bf16x8*)(Q + (size_t)qrow * QW + h * DQK + 16 * d0 + 8 * hi);
    float m_run = -1e30f, lsum = 0.f;
    f32x16 o[4];
#pragma unroll
    for (int d = 0; d < 4; ++d)
#pragma unroll
        for (int r = 0; r < 16; ++r) o[d][r] = 0.f;
    int kfb[4], vfb[4];
    { const int kr = pi32(l32), fk = (kr >> 1) & 7, fv = (l32 >> 1) & 7;
#pragma unroll
      for (int j = 0; j < 4; ++j) { kfb[j] = kr * 384 + 16 * ((2 * j + hi) ^ fk); vfb[j] = l32 * 128 + 16 * ((2 * j + hi) ^ fv); } }
    const int qpos = 256 * qb + 32 * wid + l32;
    const bool halfB = wid >= 4;
    bf16x8 pb0, pb1, pb2, pb3;
#pragma unroll
    for (int e = 0; e < 8; ++e) { pb0[e] = 0; pb1[e] = 0; pb2[e] = 0; pb3[e] = 0; }
#define MLA_VLD(dst, d_) do { dst[0] = *(const LAS bf16x8*)(vp_ + vfb[0] + (d_) * 4096); dst[1] = *(const LAS bf16x8*)(vp_ + vfb[1] + (d_) * 4096); \
                              dst[2] = *(const LAS bf16x8*)(vp_ + vfb[2] + (d_) * 4096); dst[3] = *(const LAS bf16x8*)(vp_ + vfb[3] + (d_) * 4096); } while (0)
#define MLA_PVD(d_, vv) do { o[d_] = __builtin_amdgcn_mfma_f32_32x32x16_bf16(vv[0], pb0, o[d_], 0, 0, 0); o[d_] = __builtin_amdgcn_mfma_f32_32x32x16_bf16(vv[1], pb1, o[d_], 0, 0, 0); \
                             o[d_] = __builtin_amdgcn_mfma_f32_32x32x16_bf16(vv[2], pb2, o[d_], 0, 0, 0); o[d_] = __builtin_amdgcn_mfma_f32_32x32x16_bf16(vv[3], pb3, o[d_], 0, 0, 0); } while (0)
#define MLA_PV(vslot) do { const LAS unsigned char* vp_ = lds + MLA_V0 + (vslot) * MLA_VB; bf16x8 va[4], vb[4], vc[4]; \
        MLA_VLD(va, 0); MLA_VLD(vb, 1); MLA_VLD(vc, 2); __builtin_amdgcn_sched_barrier(0); MLA_PVD(0, va); __builtin_amdgcn_sched_barrier(0); \
        MLA_VLD(va, 3); __builtin_amdgcn_sched_barrier(0); MLA_PVD(1, vb); __builtin_amdgcn_sched_barrier(0); \
        MLA_PVD(2, vc); __builtin_amdgcn_sched_barrier(0); MLA_PVD(3, va); __builtin_amdgcn_sched_barrier(0); } while (0)
    __syncthreads();
    int vs = 0;
    for (int t = 0; t < NT; ++t) {
        const int bs = t & 1; const bool more = (t + 1) < NT;
        const int vs_prev = (vs == 0) ? 2 : vs - 1, vs_next = (vs == 2) ? 0 : vs + 1;
        if (more && VAR != 1 && VAR != 3 && VAR != 4) MLA_DMA(t + 1, bs ^ 1, vs_next);
        bool pg_st = false, pg_is = false;
        if (VAR == 0 && PIGGY) {
            const int slot = PS.cnt & 1;
            LAS unsigned char* ldsw = lds + PG_LDS + slot * 16384 + wid * 2048;
            LAS unsigned* stash = (LAS unsigned*)(lds + PG_STASH + wid * 64 + slot * 32);
            if (slot == 0 ? PS.pend0 : PS.pend1) { pg_consume(ldsw, stash, lane); pg_st = true; if (slot == 0) PS.pend0 = false; else PS.pend1 = false; }
            if (PS.next_T < PS.end_T) { pg_issue(PS, pg_step, pg_sub, jobs, NJOBS - 1, ldsw, stash, wid, lane); pg_is = true; if (slot == 0) PS.pend0 = true; else PS.pend1 = true; }
        }
        const bool active = (VAR != 2) && (64 * t <= 256 * qb + 32 * wid + 31);
        if (VAR != 2 && halfB && t > 0 && (64 * (t - 1) <= 256 * qb + 32 * wid + 31)) MLA_PV(vs_prev);
        if (active) {
            const LAS unsigned char* kp = lds + bs * MLA_KB;
            f32x16 p0, p1;
#pragma unroll
            for (int r = 0; r < 16; ++r) { p0[r] = 0.f; p1[r] = 0.f; }
            {
                bf16x8 ka[4], kc[4];
#define MLA_KLD(d0_, slot_) do { ka[slot_] = *(const LAS bf16x8*)(kp + kfb[(d0_) & 3] + 128 * ((d0_) >> 2)); kc[slot_] = *(const LAS bf16x8*)(kp + kfb[(d0_) & 3] + 128 * ((d0_) >> 2) + 32 * 384); } while (0)
                MLA_KLD(0, 0); MLA_KLD(1, 1); MLA_KLD(2, 2);
                __builtin_amdgcn_sched_barrier(0);
#pragma unroll
                for (int d0 = 0; d0 < 12; ++d0) {
                    if (d0 + 3 < 12) MLA_KLD(d0 + 3, (d0 + 3) & 3);
                    __builtin_amdgcn_sched_barrier(0);
                    p0 = __builtin_amdgcn_mfma_f32_32x32x16_bf16(ka[d0 & 3], qr[d0], p0, 0, 0, 0);
                    p1 = __builtin_amdgcn_mfma_f32_32x32x16_bf16(kc[d0 & 3], qr[d0], p1, 0, 0, 0);
                    __builtin_amdgcn_sched_barrier(0);
                }
#undef MLA_KLD
            }
            if (VAR != 3 && VAR != 4) {
            if (64 * t + 63 > 256 * qb + 32 * wid) {
                const int kb0 = 64 * t + 8 * hi;
#pragma unroll
                for (int r = 0; r < 16; ++r) { const int key = kb0 + 16 * (r >> 3) + (r & 7);
                    if (key > qpos) p0[r] = -__builtin_inff(); if (key + 32 > qpos) p1[r] = -__builtin_inff(); }
            }
            float mx = p0[0];
#pragma unroll
            for (int r = 1; r < 16; ++r) mx = fmaxf(mx, p0[r]);
#pragma unroll
            for (int r = 0; r < 16; ++r) mx = fmaxf(mx, p1[r]);
            mx = fmaxf(mx, __shfl_xor(mx, 32));
            if (__any(mx > m_run + 8.0f)) {
                const float m_new = fmaxf(m_run, mx), alpha = __builtin_amdgcn_exp2f(m_run - m_new);
                m_run = m_new; lsum *= alpha;
#pragma unroll
                for (int d = 0; d < 4; ++d)
#pragma unroll
                    for (int r = 0; r < 16; ++r) o[d][r] *= alpha;
            }
            float ps = 0.f, ps1 = 0.f;
#pragma unroll
            for (int r = 0; r < 16; ++r) { p0[r] = __builtin_amdgcn_exp2f(p0[r] - m_run); p1[r] = __builtin_amdgcn_exp2f(p1[r] - m_run);
                asm("v_add_f32 %0, %0, %1" : "+v"(ps) : "v"(p0[r])); asm("v_add_f32 %0, %0, %1" : "+v"(ps1) : "v"(p1[r])); }
            lsum += ps + ps1;
            }
            pb0 = PACK8(p0, 0); pb1 = PACK8(p0, 8); pb2 = PACK8(p1, 0); pb3 = PACK8(p1, 8);
            if (!halfB) MLA_PV(vs);
        }
        if (VAR != 0 || !PIGGY || (!pg_st && !pg_is)) __syncthreads();
        else if (pg_st && pg_is) asm volatile("s_waitcnt vmcnt(3) lgkmcnt(0)\n\ts_barrier" ::: "memory");
        else if (pg_is)          asm volatile("s_waitcnt vmcnt(2) lgkmcnt(0)\n\ts_barrier" ::: "memory");
        else                     asm volatile("s_waitcnt vmcnt(1) lgkmcnt(0)\n\ts_barrier" ::: "memory");
        vs = vs_next;
    }
    if (VAR != 2 && halfB && (64 * (NT - 1) <= 256 * qb + 32 * wid + 31)) MLA_PV((vs == 0) ? 2 : vs - 1);
    __syncthreads();
#undef MLA_PV
#undef MLA_PVD
#undef MLA_VLD
#undef MLA_DMA
    const float ltot = lsum + __shfl_xor(lsum, 32);
    const float inv = 1.0f / ltot;
    bf16* orow = O + (size_t)qrow * DM + h * DV + 8 * hi;
#pragma unroll
    for (int d = 0; d < 4; ++d)
#pragma unroll
        for (int j = 0; j < 2; ++j) {
            const unsigned e0 = cvtpk(o[d][8 * j] * inv, o[d][8 * j + 1] * inv), e1 = cvtpk(o[d][8 * j + 2] * inv, o[d][8 * j + 3] * inv);
            const unsigned q0 = cvtpk(o[d][8 * j + 4] * inv, o[d][8 * j + 5] * inv), q1 = cvtpk(o[d][8 * j + 6] * inv, o[d][8 * j + 7] * inv);
            const auto s0 = __builtin_amdgcn_permlane32_swap(e0, q0, false, false), s1 = __builtin_amdgcn_permlane32_swap(e1, q1, false, false);
            v4u w; w.x = s0[0]; w.y = s1[0]; w.z = s0[1]; w.w = s1[1];
            *(GAS v4u*)(orow + 32 * d + 16 * j) = w; }
}
template <int VAR>
__device__ __forceinline__ void mla_attn_phase(const Ctx& F, const bf16* Q, const bf16* K, const bf16* VT, bf16* O, const LAS WJob* jobs, int pg_lo, int pg_hi) {
    PgState PS;
    const int pg_step = F.G >> 3, pg_sub = F.vcu & 7;
    PS.next_T = pg_lo + (F.vcu >> 3); PS.end_T = (VAR == 0 && PIGGY) ? pg_hi : 0; PS.job = 0; PS.job_end = 0; PS.kb = 0; PS.nb = 0; PS.nblk = 1; PS.cnt = 0; PS.pend0 = false; PS.pend1 = false;
    for (int L = F.vcu; L < BATCH * NH * 8; L += F.G) {
        const int bh = L >> 3, p = L & 7;
        mla_unit<VAR>(F.lds, Q, K, VT, O, bh / NH, bh % NH, 15 - p, PS, jobs, pg_step, pg_sub);
        mla_unit<VAR>(F.lds, Q, K, VT, O, bh / NH, bh % NH, p, PS, jobs, pg_step, pg_sub);
    }
    if (VAR == 0 && PIGGY) {
        asm volatile("s_waitcnt vmcnt(0)" ::: "memory");
        if (PS.pend0) { pg_consume(F.lds + PG_LDS + F.wave * 2048, (const LAS unsigned*)(F.lds + PG_STASH + F.wave * 64), F.lane); PS.pend0 = false; }
        if (PS.pend1) { pg_consume(F.lds + PG_LDS + 16384 + F.wave * 2048, (const LAS unsigned*)(F.lds + PG_STASH + F.wave * 64 + 32), F.lane); PS.pend1 = false; }
        while (PS.next_T < PS.end_T) { LAS unsigned char* ldsw = F.lds + PG_LDS + F.wave * 2048; LAS unsigned* stash = (LAS unsigned*)(F.lds + PG_STASH + F.wave * 64);
            pg_issue(PS, pg_step, pg_sub, jobs, NJOBS - 1, ldsw, stash, F.wave, F.lane); asm volatile("s_waitcnt vmcnt(0)" ::: "memory"); pg_consume(ldsw, stash, F.lane); }
    }
}

constexpr int SWA_KBYTES = 256 * 144, SWA_VROW = 528;
struct SwaStage { v4u k[4], v[4]; };
__device__ __forceinline__ void swa_load(SwaStage& S, const bf16* __restrict__ QK, int b, int g, int n) {
    const int tid = threadIdx.x, kv0 = b * SEQ + WIN * (n - 1);
#pragma unroll
    for (int i = 0; i < 4; ++i) { const int idx = tid + 512 * i, kk = idx >> 3, c = idx & 7; S.k[i] = (v4u){0u, 0u, 0u, 0u}; S.v[i] = (v4u){0u, 0u, 0u, 0u};
        if (n > 0 || kk >= WIN) { S.k[i] = *(const GAS v4u*)(QK + (size_t)(kv0 + kk) * QK1W + 4096 + g * SWD + 8 * c); S.v[i] = *(const GAS v4u*)(QK + (size_t)(kv0 + kk) * QK1W + 4608 + g * SWD + 8 * c); } }
}
__device__ __forceinline__ void swa_store(const SwaStage& S, LAS unsigned char* lds) {
    const int tid = threadIdx.x;
#pragma unroll
    for (int i = 0; i < 4; ++i) { const int idx = tid + 512 * i, kk = idx >> 3, c = idx & 7;
        *(LAS v4u*)(lds + kk * 144 + 16 * c) = S.k[i];
        const v4u v = S.v[i];
        LAS unsigned short* vt = (LAS unsigned short*)(lds + SWA_KBYTES + (8 * c) * SWA_VROW + 2 * kk);
        vt[0 * (SWA_VROW / 2)] = (unsigned short)(v.x & 0xffffu); vt[1 * (SWA_VROW / 2)] = (unsigned short)(v.x >> 16); vt[2 * (SWA_VROW / 2)] = (unsigned short)(v.y & 0xffffu); vt[3 * (SWA_VROW / 2)] = (unsigned short)(v.y >> 16);
        vt[4 * (SWA_VROW / 2)] = (unsigned short)(v.z & 0xffffu); vt[5 * (SWA_VROW / 2)] = (unsigned short)(v.z >> 16); vt[6 * (SWA_VROW / 2)] = (unsigned short)(v.w & 0xffffu); vt[7 * (SWA_VROW / 2)] = (unsigned short)(v.w >> 16); }
}
__device__ __forceinline__ void swa_compute(LAS unsigned char* lds, const bf16* __restrict__ QK, bf16* __restrict__ O, const float* __restrict__ sinks, int b, int g, int n) {
    const int tid = threadIdx.x, lane = tid & 63, wid = __builtin_amdgcn_readfirstlane(tid >> 6), l32 = lane & 31, hi = lane >> 5;
    const int rowb = b * SEQ;
    const int hh = SWKV * g + wid;
    const float slope2 = exp2f(-(float)(hh + 1) * 0.125f) * LOG2E, sink2 = sinks[hh] * LOG2E;
#pragma unroll 1
    for (int jj = 0; jj < 2; ++jj) {
        bf16x8 qr[2][4];
#pragma unroll
        for (int u = 0; u < 2; ++u)
#pragma unroll
            for (int d0 = 0; d0 < 4; ++d0) qr[u][d0] = *(const GAS bf16x8*)(QK + (size_t)(rowb + WIN * n + 32 * jj + 64 * u + l32) * QK1W + hh * SWD + 16 * d0 + 8 * hi);
        const int qd = WIN + l32 - 8 * hi;
        float m_run[2] = {sink2, sink2}, lsum[2] = {0.f, 0.f};
        f32x16 o[2][2];
#pragma unroll
        for (int u = 0; u < 2; ++u)
#pragma unroll
            for (int d = 0; d < 2; ++d)
#pragma unroll
                for (int r = 0; r < 16; ++r) o[u][d][r] = 0.f;
#pragma unroll 1
        for (int i = 0; i < 5; ++i) {
#pragma unroll
            for (int u = 0; u < 2; ++u) {
                const int j = jj + 2 * u;
                const LAS unsigned char* kp = lds + (32 * j + pi32(l32)) * 144 + 16 * hi;
                const LAS unsigned char* vp = lds + SWA_KBYTES + l32 * SWA_VROW + 64 * j + 16 * hi;
                f32x16 p;
#pragma unroll
                for (int r = 0; r < 16; ++r) p[r] = 0.f;
#pragma unroll
                for (int d0 = 0; d0 < 4; ++d0) p = __builtin_amdgcn_mfma_f32_32x32x16_bf16(*(const LAS bf16x8*)(kp + i * 32 * 144 + 32 * d0), qr[u][d0], p, 0, 0, 0);
                float mx = -__builtin_inff();
#pragma unroll
                for (int r = 0; r < 16; ++r) { const int dist = qd - 32 * i - 16 * (r >> 3) - (r & 7), kk = 32 * (j + i) + 16 * (r >> 3) + 8 * hi + (r & 7);
                    const bool valid = ((unsigned)dist < (unsigned)WIN) && (n > 0 || kk >= WIN);
                    const float sc = valid ? p[r] - slope2 * (float)dist : -__builtin_inff(); p[r] = sc; mx = fmaxf(mx, sc); }
                mx = fmaxf(mx, __shfl_xor(mx, 32));
                const float m_new = fmaxf(m_run[u], mx), alpha = __builtin_amdgcn_exp2f(m_run[u] - m_new);
                m_run[u] = m_new;
                float ps = 0.f;
#pragma unroll
                for (int r = 0; r < 16; ++r) { p[r] = __builtin_amdgcn_exp2f(p[r] - m_new); ps += p[r]; }
                lsum[u] = lsum[u] * alpha + ps;
#pragma unroll
                for (int d = 0; d < 2; ++d)
#pragma unroll
                    for (int r = 0; r < 16; ++r) o[u][d][r] *= alpha;
                const bf16x8 pa = PACK8(p, 0), pb = PACK8(p, 8);
#pragma unroll
                for (int d = 0; d < 2; ++d) {
                    o[u][d] = __builtin_amdgcn_mfma_f32_32x32x16_bf16(*(const LAS bf16x8*)(vp + d * 32 * SWA_VROW + 64 * i), pa, o[u][d], 0, 0, 0);
                    o[u][d] = __builtin_amdgcn_mfma_f32_32x32x16_bf16(*(const LAS bf16x8*)(vp + d * 32 * SWA_VROW + 64 * i + 32), pb, o[u][d], 0, 0, 0);
                }
            }
        }
#pragma unroll
        for (int u = 0; u < 2; ++u) {
            const int j = jj + 2 * u; const int qrow = rowb + WIN * n + 32 * j + l32;
            float ls = lsum[u] + __shfl_xor(lsum[u], 32);
            ls += __builtin_amdgcn_exp2f(sink2 - m_run[u]);
            const float inv = 1.0f / ls;
            bf16* orow = O + (size_t)qrow * DM + hh * SWD + 8 * hi;
#pragma unroll
            for (int d = 0; d < 2; ++d)
#pragma unroll
                for (int j2 = 0; j2 < 2; ++j2) {
                    const unsigned e0 = cvtpk(o[u][d][8 * j2] * inv, o[u][d][8 * j2 + 1] * inv), e1 = cvtpk(o[u][d][8 * j2 + 2] * inv, o[u][d][8 * j2 + 3] * inv);
                    const unsigned q0 = cvtpk(o[u][d][8 * j2 + 4] * inv, o[u][d][8 * j2 + 5] * inv), q1 = cvtpk(o[u][d][8 * j2 + 6] * inv, o[u][d][8 * j2 + 7] * inv);
                    const auto s0 = __builtin_amdgcn_permlane32_swap(e0, q0, false, false), s1 = __builtin_amdgcn_permlane32_swap(e1, q1, false, false);
                    v4u w; w.x = s0[0]; w.y = s1[0]; w.z = s0[1]; w.w = s1[1];
                    *(GAS v4u*)(orow + 32 * d + 16 * j2) = w; }
        }
    }
}
__device__ __forceinline__ void swa_attn_phase(const Ctx& F, const bf16* QK, bf16* O, const float* sinks) {
    constexpr int NB = SEQ / WIN, NU = BATCH * SWKV * NB;
    int L = F.vcu;
    if (L >= NU) return;
    SwaStage S;
    swa_load(S, QK, (L / NB) / SWKV, (L / NB) % SWKV, L % NB);
    swa_store(S, F.lds);
    __syncthreads();
    for (;;) {
        const int Ln = L + F.G; const bool more = Ln < NU;
        if (more) swa_load(S, QK, (Ln / NB) / SWKV, (Ln / NB) % SWKV, Ln % NB);
        swa_compute(F.lds, QK, O, sinks, (L / NB) / SWKV, (L / NB) % SWKV, L % NB);
        if (!more) break;
        __syncthreads();
        swa_store(S, F.lds);
        __syncthreads();
        L = Ln;
    }
    __syncthreads();
}

struct Args { const float* in[23]; float* out; unsigned char* ws; WJob jobs[NJOBS]; int nitems, ntiles, ph_lo, ph_hi; int qb[8]; };
constexpr int NPHASE = 20;

__global__ void __launch_bounds__(NWAVES * 64, 2) yoco_fwd(Args args) {
    extern __shared__ __attribute__((aligned(16))) unsigned char lds_raw[];
    Ctx F;
    F.lds = (LAS unsigned char*)lds_raw;
    volatile LAS unsigned* MISC = (volatile LAS unsigned*)(F.lds + MISC_OFF);
    F.tid = threadIdx.x; F.lane = F.tid & 63; F.wave = __builtin_amdgcn_readfirstlane(F.tid >> 6);
    F.G = gridDim.x; { const int bx = blockIdx.x; F.vcu = (F.G % 8 == 0) ? (bx % 8) * (F.G / 8) + bx / 8 : bx; }
    unsigned char* ws = args.ws;
    gu32* ctl = (gu32*)(ws + WS_CTL);
    for (int u = F.tid; u < (LDS_BYTES - LDSCTL_OFF) / 4; u += NWAVES * 64) ((LAS unsigned*)(F.lds + LDSCTL_OFF))[u] = 0u;
    __syncthreads();
    const LAS WJob* ljobs = (const LAS WJob*)(F.lds + JOBS_OFF);
    if (F.tid == 0) {
#pragma unroll
        for (int q = 0; q < NJOBS; ++q) { LAS WJob* d = (LAS WJob*)(F.lds + JOBS_OFF) + q; d->W = args.jobs[q].W; d->gain = args.jobs[q].gain; d->WT = args.jobs[q].WT; d->ldw = args.jobs[q].ldw; d->K = args.jobs[q].K;
            d->ncols = args.jobs[q].ncols; d->col0 = args.jobs[q].col0; d->gs = args.jobs[q].gs; d->gsrc = args.jobs[q].gsrc; d->drow0 = args.jobs[q].drow0; d->item0 = args.jobs[q].item0; d->mode = args.jobs[q].mode; d->pad = 0; }
    }
    __syncthreads();
    XcdBarrier bar = xcd_barrier_post((unsigned*)(ctl + CW_BAR), MISC + 8);
    const int lo = args.ph_lo, hi = args.ph_hi;
#ifndef PH_MASK
#define PH_MASK 0xFFFFFu
#endif
#define IN(k) ((((PH_MASK) >> (k)) & 1u) && lo <= (k) && (k) < hi)
#define SEAM(k) do { if (IN(k) && IN((k) + 1)) xcd_barrier(bar); } while (0)
#ifndef DUP_MASK
#define DUP_MASK 0u
#endif
#define REPS(k) ((((DUP_MASK) >> (k)) & 1u) ? 2 : 1)

    const float* x = args.in[0]; const int* pos = (const int*)args.in[1];
    const float* n_mix_post = args.in[3]; const float* n_ffn_post = args.in[5];
    const float* sinks = args.in[17]; const float* conv_w = args.in[20]; const float* conv_b = args.in[21];
    float* H = args.out;
    float* CS = (float*)(ws + WS_CS); float* RS = (float*)(ws + WS_RS);
    bf16* W1T = (bf16*)(ws + WS_W1T); bf16* WUQT = (bf16*)(ws + WS_WUQT); bf16* WKNT = (bf16*)(ws + WS_WKNT); bf16* WVT = (bf16*)(ws + WS_WVT);
    bf16* WO0T = (bf16*)(ws + WS_WO0T); bf16* WIN0T = (bf16*)(ws + WS_WIN0T); bf16* WOUT0T = (bf16*)(ws + WS_WOUT0T);
    bf16* WQK1T = (bf16*)(ws + WS_WQK1T); bf16* WV1T = (bf16*)(ws + WS_WV1T); bf16* WO1T = (bf16*)(ws + WS_WO1T); bf16* WIN1T = (bf16*)(ws + WS_WIN1T); bf16* WOUT1T = (bf16*)(ws + WS_WOUT1T);
    bf16* XN = (bf16*)(ws + WS_XN); float* CQKV = (float*)(ws + WS_CQKV); bf16* CQN = (bf16*)(ws + WS_CQN); bf16* CKV = (bf16*)(ws + WS_CKV);
    float* QF = (float*)(ws + WS_QF); bf16* Q = (bf16*)(ws + WS_Q); bf16* K = (bf16*)(ws + WS_K); bf16* VT = (bf16*)(ws + WS_VT); bf16* O = (bf16*)(ws + WS_O);
    bf16* AF = (bf16*)(ws + WS_AF); float* PART = (float*)(ws + WS_U); float* HALO = PART + (size_t)(M / 64) * 4 * DFF; bf16* ACT = (bf16*)(ws + WS_ACT); bf16* QK1 = (bf16*)(ws + WS_QK1); bf16* VT1 = (bf16*)(ws + WS_VT1);
    LAS unsigned char* ring = F.lds + RING_OFF;
    const int cid = (int)blockIdx.x;
    const int xcd_ = cid & 7;
    const int K0_IN = K0IN_ON ? (xcd_ >> 1) * 16 : 0;
    const int K0_OUT = 0;
#define GEMM_F32(Ap, Bp, Mv, Nv, Kv, Cp, ldcv, rsv) do { pg8::Gemm g_{(const pg8::bf16_t*)(Ap), (const pg8::bf16_t*)(Bp), (Mv), (Nv), (Kv), XTILED, WTILED, ZIG_DEF, 0}; pg8::StaticOrder S_; S_.init((Mv), (Nv), F.G, cid); \
        pg8::EpiF32 E_{(Cp), (ldcv), (rsv)}; pg8::gemm_phase<pg8::EpiF32, pg8::StaticOrder, true, true>(ring, g_, S_, E_); } while (0)
#define GEMM_BF16(Ap, Bp, Mv, Nv, Kv, Op, ldcv, gsv, gstv, scv, s0v, rsv) GEMM_BF16T(Ap, Bp, Mv, Nv, Kv, Op, ldcv, gsv, gstv, scv, s0v, rsv, 0)
#define GEMM_BF16T(Ap, Bp, Mv, Nv, Kv, Op, ldcv, gsv, gstv, scv, s0v, rsv, tAv) do { pg8::Gemm g_{(const pg8::bf16_t*)(Ap), (const pg8::bf16_t*)(Bp), (Mv), (Nv), (Kv), (tAv), WTILED, (((const void*)(Ap) == (const void*)ACT) ? ZIG_OUT : ZIG_DEF), 0}; pg8::StaticOrder S_; S_.init((Mv), (Nv), F.G, cid); \
        pg8::EpiBf16Map E_{(pg8::bf16_t*)(Op), (ldcv), (gsv), (gstv), (scv), (s0v), (rsv)}; pg8::gemm_phase<pg8::EpiBf16Map, pg8::StaticOrder, true, true>(ring, g_, S_, E_); } while (0)

#define GEMM_BF16_HM(Ap, Bp, Mv, Nv, Kv, Op, ldcv) do { pg8::Gemm g_{(const pg8::bf16_t*)(Ap), (const pg8::bf16_t*)(Bp), (Mv), (Nv), (Kv), 0, WTILED, ZIG_DEF, 0}; pg8::HalfMOrder S_; S_.init((Mv), (Nv), F.G, cid, F.vcu); \
        pg8::EpiBf16Map E_{(pg8::bf16_t*)(Op), (ldcv), 1 << 30, 0, 0, 1.f, nullptr}; pg8::gemm_phase<pg8::EpiBf16Map, pg8::HalfMOrder, true, true>(ring, g_, S_, E_); } while (0)
#define GEMM_CONV(Ap, Bp, cwp, cbp) do { pg8::Gemm g_{(const pg8::bf16_t*)(Ap), (const pg8::bf16_t*)(Bp), M, DFF2, DM, XTILED, WTILED, ZIG_DEF, K0_IN}; pg8::StaticOrder S_; S_.init(M, DFF2, F.G, cid, FLIP_IN); \
        pg8::EpiConvAct E_{(pg8::bf16_t*)ACT, PART, HALO, (cwp), (cbp), RS}; pg8::gemm_phase<pg8::EpiConvAct, pg8::StaticOrder, true, true>(ring, g_, S_, E_); } while (0)
#define TAIL_CONVERT(nwg, q) do { const int rem_ = (nwg) % F.G; if (rem_ == 0 || cid >= rem_) wt_block_phase(F, ljobs, NJOBS - 1, args.qb[q], args.qb[(q) + 1], rem_ == 0 ? cid : cid - rem_, rem_ == 0 ? F.G : F.G - rem_); } while (0)
    if (IN(0)) for (int rep_ = 0; rep_ < REPS(0); ++rep_) { if (rep_) xcd_barrier(bar);
        LAS float* scr = (LAS float*)(ring + F.wave * 16384);
        const int gw = F.vcu * NWAVES + F.wave, NGW = F.G * NWAVES;
        wt_block_phase(F, ljobs, NJOBS - 1, args.qb[0], args.qb[1], F.vcu, F.G, args.qb[6], args.qb[7] - args.qb[6]);
        { const WJob& J = args.jobs[NJOBS - 1];
          for (int it = gw; it < args.nitems; it += NGW) wt_item(J.W, J.gain, J.WT, J.ldw, J.K, J.ncols, J.col0, J.gs, J.gsrc, J.drow0, scr, it, F.lane); }
        { const int gt = F.vcu * (NWAVES * 64) + F.tid, NT = F.G * NWAVES * 64;
          for (int idx = gt; idx < M * 32; idx += NT) { const int m = idx >> 5, i = idx & 31; float s, c; sincos_d((float)pos[m] * kFreq[i], s, c); CS[(size_t)m * 64 + i] = c; CS[(size_t)m * 64 + 32 + i] = s; } }
        rows_phase<0, true>(F, x, nullptr, nullptr, nullptr, XN, RS);
    }
#if defined(DUP_P0)
    { xcd_barrier(bar);
        LAS float* scr = (LAS float*)(ring + F.wave * 16384);
        const int gw = F.vcu * NWAVES + F.wave, NGW = F.G * NWAVES;
        wt_block_phase(F, ljobs, NJOBS - 1, args.qb[0], args.qb[1], F.vcu, F.G);
        { const WJob& J = args.jobs[NJOBS - 1];
          for (int it = gw; it < args.nitems; it += NGW) wt_item(J.W, J.gain, J.WT, J.ldw, J.K, J.ncols, J.col0, J.gs, J.gsrc, J.drow0, scr, it, F.lane); }
        { const int gt = F.vcu * (NWAVES * 64) + F.tid, NT = F.G * NWAVES * 64;
          for (int idx = gt; idx < M * 32; idx += NT) { const int m = idx >> 5, i = idx & 31; float s, c; sincos_d((float)pos[m] * kFreq[i], s, c); CS[(size_t)m * 64 + i] = c; CS[(size_t)m * 64 + 32 + i] = s; } }
        rows_phase<0, true>(F, x, nullptr, nullptr, nullptr, XN, RS);
    }
#endif
#if defined(DUP_P0W)
    { xcd_barrier(bar); wt_block_phase(F, ljobs, NJOBS - 1, args.qb[0], args.qb[1], F.vcu, F.G, args.qb[6], args.qb[7] - args.qb[6]); }
#endif
    SEAM(0);
    if (IN(1)) for (int rep_ = 0; rep_ < REPS(1); ++rep_) { if (rep_) xcd_barrier(bar); GEMM_F32(XN, W1T, M, N1, DM, CQKV, N1, RS); TAIL_CONVERT((M / 256) * (N1 / 256), 1); }
    SEAM(1);
    if (IN(2)) for (int rep_ = 0; rep_ < REPS(2); ++rep_) { if (rep_) xcd_barrier(bar); latent_rows_phase(F, CQKV, CS, CQN, CKV, K); }
    SEAM(2);
    if (IN(3)) for (int rep_ = 0; rep_ < REPS(3); ++rep_) { if (rep_) xcd_barrier(bar);
        { pg8::Gemm g_{(const pg8::bf16_t*)CQN, (const pg8::bf16_t*)WUQT, M, QW, QLORA, 0, WTILED, ZIG_DEF, 0}; pg8::StaticOrder S_; S_.init(M, QW, F.G, cid);
          pg8::EpiQRope E_{(pg8::bf16_t*)Q, CS, QS0}; pg8::gemm_phase<pg8::EpiQRope, pg8::StaticOrder, true, true>(ring, g_, S_, E_); }
        GEMM_BF16(CKV, WKNT, M, 4096, KVLORA, K, QW, DNOPE, DQK, 0, 1.f, nullptr);
        { pg8::Gemm g_{(const pg8::bf16_t*)WVT, (const pg8::bf16_t*)CKV, 4096, M, KVLORA, WTILED, 0, ZIG_DEF, 0}; pg8::StaticOrder S_; S_.init(4096, M, F.G, cid);
          pg8::EpiBf16Map E_{(pg8::bf16_t*)VT, M, 1 << 30, 0, 0, 1.f, nullptr}; pg8::gemm_phase<pg8::EpiBf16Map, pg8::StaticOrder, true, true>(ring, g_, S_, E_); }
    }
#if defined(DUP_P3)
    { xcd_barrier(bar);
        { pg8::Gemm g_{(const pg8::bf16_t*)CQN, (const pg8::bf16_t*)WUQT, M, QW, QLORA, 0, WTILED, ZIG_DEF, 0}; pg8::StaticOrder S_; S_.init(M, QW, F.G, cid);
          pg8::EpiQRope E_{(pg8::bf16_t*)Q, CS, QS0}; pg8::gemm_phase<pg8::EpiQRope, pg8::StaticOrder, true, true>(ring, g_, S_, E_); }
        GEMM_BF16(CKV, WKNT, M, 4096, KVLORA, K, QW, DNOPE, DQK, 0, 1.f, nullptr);
        { pg8::Gemm g_{(const pg8::bf16_t*)WVT, (const pg8::bf16_t*)CKV, 4096, M, KVLORA, WTILED, 0, ZIG_DEF, 0}; pg8::StaticOrder S_; S_.init(4096, M, F.G, cid);
          pg8::EpiBf16Map E_{(pg8::bf16_t*)VT, M, 1 << 30, 0, 0, 1.f, nullptr}; pg8::gemm_phase<pg8::EpiBf16Map, pg8::StaticOrder, true, true>(ring, g_, S_, E_); }
    }
#endif
    SEAM(3);
    if (IN(5)) for (int rep_ = 0; rep_ < REPS(5); ++rep_) { if (rep_) xcd_barrier(bar); mla_attn_phase<0>(F, Q, K, VT, O, ljobs, args.qb[6], args.qb[7]); }
#if defined(DUP_P5V1)
    xcd_barrier(bar); mla_attn_phase<1>(F, Q, K, VT, (bf16*)(ws + WS_QF), ljobs, 0, 0);
#endif
#if defined(DUP_P5V4)
    xcd_barrier(bar); mla_attn_phase<4>(F, Q, K, VT, (bf16*)(ws + WS_QF), ljobs, 0, 0);
#endif
#if defined(DUP_P5V3)
    xcd_barrier(bar); mla_attn_phase<3>(F, Q, K, VT, (bf16*)(ws + WS_QF), ljobs, 0, 0);
#endif
#if defined(DUP_P5V2)
    xcd_barrier(bar); mla_attn_phase<2>(F, Q, K, VT, (bf16*)(ws + WS_QF), ljobs, 0, 0);
#endif
    SEAM(5);
    if (IN(6)) for (int rep_ = 0; rep_ < REPS(6); ++rep_) { if (rep_) xcd_barrier(bar); GEMM_BF16(O, WO0T, M, DM, DM, AF, DM, 1 << 30, 0, 0, 1.f, nullptr); }
    SEAM(6);
    if (IN(7)) for (int rep_ = 0; rep_ < REPS(7); ++rep_) { if (rep_) xcd_barrier(bar); rows_phase<1, false>(F, AF, XN, n_mix_post, nullptr, XN, RS);     }
    SEAM(7);
    if (IN(8)) for (int rep_ = 0; rep_ < REPS(8); ++rep_) { if (rep_) xcd_barrier(bar); GEMM_CONV(XN, WIN0T, conv_w, conv_b); TAIL_CONVERT((M / 256) * (DFF2 / 256), 2); }
#if defined(DUP_P8)
    xcd_barrier(bar); GEMM_CONV(XN, WIN0T, conv_w, conv_b);
#endif
#if defined(DUP_P8ZERO)
    xcd_barrier(bar); { pg8::Gemm g_{(const pg8::bf16_t*)XN, (const pg8::bf16_t*)WIN0T, M, DFF2, DM, 0, WTILED, ZIG_DEF, 0}; pg8::ZeroOrder S_; S_.init(M, DFF2, F.G, cid);
        pg8::EpiNull E_{(float*)(ws + WS_QF)}; pg8::gemm_phase<pg8::EpiNull, pg8::ZeroOrder, true, true>(ring, g_, S_, E_); }
#endif
#if defined(DUP_P8SHORT)
    xcd_barrier(bar); { pg8::Gemm g_{(const pg8::bf16_t*)XN, (const pg8::bf16_t*)WIN0T, M, 44032, 2048, 0, WTILED, ZIG_DEF, 0}; pg8::ZeroOrder S_; S_.init(M, 44032, F.G, cid);
        pg8::EpiNull E_{(float*)(ws + WS_QF)}; pg8::gemm_phase<pg8::EpiNull, pg8::ZeroOrder, true, true>(ring, g_, S_, E_); }
#endif
#if defined(DUP_P8NULL)
    xcd_barrier(bar); { pg8::Gemm g_{(const pg8::bf16_t*)XN, (const pg8::bf16_t*)WIN0T, M, DFF2, DM, 0, WTILED, ZIG_DEF, 0}; pg8::StaticOrder S_; S_.init(M, DFF2, F.G, cid);
        pg8::EpiNull E_{(float*)(ws + WS_QF)}; pg8::gemm_phase<pg8::EpiNull, pg8::StaticOrder, true, true>(ring, g_, S_, E_); }
#endif
#if defined(DUP_P10)
    xcd_barrier(bar); xcd_barrier(bar);
#endif
#if defined(BAR20)
    for (int q_ = 0; q_ < 20; ++q_) xcd_barrier(bar);
#endif
    SEAM(8);
    if (IN(9)) for (int rep_ = 0; rep_ < REPS(9); ++rep_) { if (rep_) xcd_barrier(bar); conv_fix_phase(F, PART, HALO, conv_w, conv_b, ACT); }
    SEAM(9);
    if (IN(10)) for (int rep_ = 0; rep_ < REPS(10); ++rep_) { if (rep_) xcd_barrier(bar); GEMM_BF16T(ACT, WOUT0T, M, DM, DFF, AF, DM, 1 << 30, 0, 0, 1.f, nullptr, pg8::EpiConvAct::ATILED); }
#if defined(DUP_P10ZERO)
    xcd_barrier(bar); { pg8::Gemm g_{(const pg8::bf16_t*)ACT, (const pg8::bf16_t*)WOUT0T, M, DM, DFF, pg8::EpiConvAct::ATILED, WTILED, ZIG_DEF, 0}; pg8::ZeroOrder S_; S_.init(M, DM, F.G, cid);
        pg8::EpiNull E_{(float*)(ws + WS_QF)}; pg8::gemm_phase<pg8::EpiNull, pg8::ZeroOrder, true, true>(ring, g_, S_, E_); }
#endif
#if defined(DUP_P10HM)
    xcd_barrier(bar); { pg8::Gemm g_{(const pg8::bf16_t*)ACT, (const pg8::bf16_t*)WOUT0T, M, DM, DFF, pg8::EpiConvAct::ATILED, WTILED, ZIG_DEF, 0}; pg8::HalfMOrder S_; S_.init(M, DM, F.G, cid, F.vcu);
        pg8::EpiNull E_{(float*)(ws + WS_QF)}; pg8::gemm_phase<pg8::EpiNull, pg8::HalfMOrder, true, true>(ring, g_, S_, E_); }
#endif
#if defined(DUP_P10ZA)
    xcd_barrier(bar); { pg8::Gemm g_{(const pg8::bf16_t*)ACT, (const pg8::bf16_t*)WOUT0T, M, DM, DFF, pg8::EpiConvAct::ATILED, WTILED, ZIG_DEF, 0}; pg8::ZeroAOrder S_; S_.init(M, DM, F.G, cid);
        pg8::EpiNull E_{(float*)(ws + WS_QF)}; pg8::gemm_phase<pg8::EpiNull, pg8::ZeroAOrder, true, true>(ring, g_, S_, E_); }
#endif
#if defined(DUP_P10ZB)
    xcd_barrier(bar); { pg8::Gemm g_{(const pg8::bf16_t*)ACT, (const pg8::bf16_t*)WOUT0T, M, DM, DFF, pg8::EpiConvAct::ATILED, WTILED, ZIG_DEF, 0}; pg8::ZeroBOrder S_; S_.init(M, DM, F.G, cid);
        pg8::EpiNull E_{(float*)(ws + WS_QF)}; pg8::gemm_phase<pg8::EpiNull, pg8::ZeroBOrder, true, true>(ring, g_, S_, E_); }
#endif
#if defined(DUP_P10NULL)
    xcd_barrier(bar); { pg8::Gemm g_{(const pg8::bf16_t*)ACT, (const pg8::bf16_t*)WOUT0T, M, DM, DFF, pg8::EpiConvAct::ATILED, WTILED, ZIG_DEF, 0}; pg8::StaticOrder S_; S_.init(M, DM, F.G, cid);
        pg8::EpiNull E_{(float*)(ws + WS_QF)}; pg8::gemm_phase<pg8::EpiNull, pg8::StaticOrder, true, true>(ring, g_, S_, E_); }
#endif
    SEAM(10);
    if (IN(11)) for (int rep_ = 0; rep_ < REPS(11); ++rep_) { if (rep_) xcd_barrier(bar); rows_phase<1, false>(F, AF, XN, n_ffn_post, nullptr, XN, RS); }
    SEAM(11);
    if (IN(12)) for (int rep_ = 0; rep_ < REPS(12); ++rep_) { if (rep_) xcd_barrier(bar);
        GEMM_BF16T(XN, WQK1T, M, QK1W, DM, QK1, QK1W, 1 << 30, 0, 4096, QS1, RS, XTILED);
        TAIL_CONVERT((M / 256) * (QK1W / 256), 3);
    }
    SEAM(12);
    if (IN(13)) for (int rep_ = 0; rep_ < REPS(13); ++rep_) { if (rep_) xcd_barrier(bar); swa_attn_phase(F, QK1, O, sinks); }
    SEAM(13);
    if (IN(14)) for (int rep_ = 0; rep_ < REPS(14); ++rep_) { if (rep_) xcd_barrier(bar); GEMM_BF16(O, WO1T, M, DM, DM, AF, DM, 1 << 30, 0, 0, 1.f, nullptr); }
    SEAM(14);
    if (IN(15)) for (int rep_ = 0; rep_ < REPS(15); ++rep_) { if (rep_) xcd_barrier(bar); rows_phase<1, false>(F, AF, XN, n_mix_post + DM, nullptr, XN, RS); }
    SEAM(15);
    if (IN(16)) for (int rep_ = 0; rep_ < REPS(16); ++rep_) { if (rep_) xcd_barrier(bar); GEMM_CONV(XN, WIN1T, conv_w + (size_t)3 * DFF2, conv_b + DFF2); TAIL_CONVERT((M / 256) * (DFF2 / 256), 4); }
    SEAM(16);
    if (IN(17)) for (int rep_ = 0; rep_ < REPS(17); ++rep_) { if (rep_) xcd_barrier(bar); conv_fix_phase(F, PART, HALO, conv_w + (size_t)3 * DFF2, conv_b + DFF2, ACT); }
    SEAM(17);
    if (IN(18)) for (int rep_ = 0; rep_ < REPS(18); ++rep_) { if (rep_) xcd_barrier(bar); GEMM_BF16T(ACT, WOUT1T, M, DM, DFF, AF, DM, 1 << 30, 0, 0, 1.f, nullptr, pg8::EpiConvAct::ATILED); }
    SEAM(18);
    if (IN(19)) for (int rep_ = 0; rep_ < REPS(19); ++rep_) { if (rep_) xcd_barrier(bar); rows_phase<2, false>(F, AF, XN, n_ffn_post + DM, H, nullptr, nullptr); }
#undef IN
#undef SEAM
}

#ifndef MK_SPLIT
#define MK_SPLIT 0
#endif
extern "C" void kernel_launch(void* const* d_in, const int* in_sizes, int n_in, void* d_out, int out_size, void* d_ws, size_t ws_size, hipStream_t stream) {
    static int grid = 0;
    if (grid == 0) {
        if (n_in != 23 || out_size != M * DM || ws_size < WS_END) { fprintf(stderr, "kernel_launch: unexpected shapes (n_in %d, out %d, ws %zu < %zu)\n", n_in, out_size, ws_size, (size_t)WS_END); grid = -1; return; }
        int dev = 0, cus = 0, per_cu = 0;
        if (hipGetDevice(&dev) != hipSuccess || hipDeviceGetAttribute(&cus, hipDeviceAttributeMultiprocessorCount, dev) != hipSuccess) { grid = -1; return; }
        if (hipFuncSetAttribute((const void*)yoco_fwd, hipFuncAttributeMaxDynamicSharedMemorySize, LDS_BYTES) != hipSuccess) { fprintf(stderr, "kernel_launch: hipFuncSetAttribute failed\n"); grid = -1; return; }
        if (hipOccupancyMaxActiveBlocksPerMultiprocessor(&per_cu, (const void*)yoco_fwd, NWAVES * 64, LDS_BYTES) != hipSuccess || per_cu < 1)
            fprintf(stderr, "kernel_launch: occupancy query reports %d workgroups per CU\n", per_cu);
        (void)hipGetLastError();
        grid = cus;
    }
    if (grid < 0) return;
    (void)hipMemsetAsync((char*)d_ws + WS_CTL, 0, 65536, stream);
    Args a; memset(&a, 0, sizeof(a));
    for (int i = 0; i < 23; ++i) a.in[i] = (const float*)d_in[i];
    a.out = (float*)d_out; a.ws = (unsigned char*)d_ws;
    unsigned char* ws = (unsigned char*)d_ws;
    const float* nmp = a.in[2]; const float* nfp = a.in[4];
    int nj = 0, tiles = 0;
    auto add = [&](const float* W, const float* gain, size_t wt_off, int ldw, int K, int ncols, int col0, int gs, int gsrc, int drow0, int mode = 0) {
        WJob& J = a.jobs[nj++]; J.W = W; J.gain = gain; J.WT = (bf16*)(ws + wt_off); J.ldw = ldw; J.K = K; J.ncols = ncols; J.col0 = col0; J.gs = gs; J.gsrc = gsrc; J.drow0 = drow0; J.item0 = tiles; J.mode = mode; J.pad = 0;
        tiles += (K / 64) * (ncols / 256); };
    const int BIG = 1 << 30;
    add(a.in[6],  nmp,        WS_W1T,   QLORA,  DM,     QLORA,  0, BIG, 0, 0);
    add(a.in[8],  a.in[7],    WS_WUQT,  QW,     QLORA,  QW,     0, BIG, 0, 0, 1);
    add(a.in[11], a.in[10],   WS_WKNT,  8192,   KVLORA, 4096,   0, 128, 256, 0);
    add(a.in[11], a.in[10],   WS_WVT,   8192,   KVLORA, 4096, 128, 128, 256, 0);
    add(a.in[12], nullptr,    WS_WO0T,  DM,     DM,     DM,     0, BIG, 0, 0);
    add(a.in[19], nfp,        WS_WIN0T, DFF2,   DM,     DFF2,   0, BIG, 0, 0, 2);
    add(a.in[22], nullptr,    WS_WOUT0T,DM,     DFF,    DM,     0, BIG, 0, 0);
    add(a.in[16], nmp + DM,   WS_WQK1T, DM,     DM,     DM,     0, BIG, 0, 0);
    add(a.in[14], a.in[13],   WS_WQK1T, 512,    DM,     512,    0, BIG, 0, 4096);
    add(a.in[15], a.in[13],   WS_WQK1T, 512,    DM,     512,    0, BIG, 0, 4608);
    add(a.in[18], nullptr,    WS_WO1T,  DM,     DM,     DM,     0, BIG, 0, 0);
    add(a.in[19] + (size_t)DM * DFF2, nfp + DM, WS_WIN1T, DFF2, DM, DFF2, 0, BIG, 0, 0, 2);
    add(a.in[22] + (size_t)DFF * DM,  nullptr,  WS_WOUT1T, DM,  DFF, DM,  0, BIG, 0, 0);
    { auto idle = [&](int nwg) { const int rem = nwg % grid; return rem ? grid - rem : 0; };
      const int c16 = 27 * idle((M / 256) * (DFF2 / 256)), c12 = 27 * idle((M / 256) * (QK1W / 256)), c8 = c16, c1 = 24 * idle((M / 256) * (N1 / 256));
      const int lim16 = a.jobs[12].item0  , lim12 = a.jobs[10].item0  , lim8 = a.jobs[6].item0  , lim1 = a.jobs[1].item0  ;
      int t4 = tiles - c16; if (t4 < lim16) t4 = lim16;
      int t3 = t4 - c12;    if (t3 < lim12) t3 = lim12;
      int t2 = t3 - c8;     if (t2 < lim8)  t2 = lim8;
      int t1 = t2 - c1;     if (t1 < lim1)  t1 = lim1;
      int att_lo = a.jobs[4].item0, att_hi = (PIGGY && grid % 8 == 0) ? att_lo + (grid * 136) / 8 : att_lo; if (att_hi > t1) att_hi = t1; if (att_hi < att_lo) att_hi = att_lo;
      a.qb[0] = 0; a.qb[1] = t1; a.qb[2] = t2; a.qb[3] = t3; a.qb[4] = t4; a.qb[5] = tiles; a.qb[6] = att_lo; a.qb[7] = att_hi; }
    a.ntiles = tiles;
    { WJob& J = a.jobs[nj++]; J.W = a.in[9]; J.gain = nmp; J.WT = (bf16*)(ws + WS_W1T); J.ldw = 576; J.K = DM; J.ncols = 576; J.col0 = 0; J.gs = BIG; J.gsrc = 0; J.drow0 = QLORA; J.item0 = 0; J.mode = 0; J.pad = 0; }
    const int items = (DM / 64) * (576 / 32);
    a.nitems = items;
#if MK_SPLIT
    for (int p = 0; p < NPHASE; ++p) { a.ph_lo = p; a.ph_hi = p + 1; hipLaunchKernelGGL(yoco_fwd, dim3(grid), dim3(NWAVES * 64), LDS_BYTES, stream, a); }
#else
    a.ph_lo = 0; a.ph_hi = NPHASE;
    hipLaunchKernelGGL(yoco_fwd, dim3(grid), dim3(NWAVES * 64), LDS_BYTES, stream, a);
#endif
    const hipError_t le = hipPeekAtLastError();
    if (le != hipSuccess) fprintf(stderr, "kernel_launch: launch failed: %s\n", hipGetErrorName(le));
}
```

```cpp
#include <hip/hip_runtime.h>
#include <cstdio>
#include <cstdint>
#include <cstring>
namespace pg8 {
#define PG8_LAS __attribute__((address_space(3)))
typedef unsigned short bf16_t;
typedef short bf16x8 __attribute__((ext_vector_type(8)));
typedef float f32x4 __attribute__((ext_vector_type(4)));
typedef unsigned u32x4 __attribute__((ext_vector_type(4)));
constexpr int BM = 256, BK = 64, HALF = 128, HTB = HALF * BK * 2  , STAGE_BYTES = 8 * HTB, NXCD = 8, WGM = 8;

__host__ __device__ __forceinline__ int lds_byte(int r, int c) { const int st = (r >> 4) * 2 + (c >> 5), rr = r & 15, cc = c & 31, ob = rr * 64 + cc * 2; return st * 1024 + (ob ^ (((ob >> 9) & 1) << 5)); }
__host__ __device__ __forceinline__ void stage_rc(int b, int& R, int& C) { const int st = b / 1024, sb = b % 1024, swz = sb ^ (((sb >> 9) & 1) << 5); R = (st >> 1) * 16 + swz / 64; C = (st & 1) * 32 + (swz % 64) / 2; }
__host__ __device__ __forceinline__ int perm32(int rho) { const int n = rho >> 4, i = rho & 15; return 8 * (i >> 2) + 4 * n + (i & 3); }

struct Unit { int pm, pn; };
struct Gemm { const bf16_t* A; const bf16_t* Bt; int M, N, K; int tA, tB, zig, k0; };
__host__ __device__ __forceinline__ size_t tiled_off(int row, int col, int K) { return ((((size_t)(row >> 8) * (size_t)(K >> 6) + (size_t)(col >> 6)) * 256 + (size_t)(row & 255)) << 6) + (size_t)(col & 63); }

struct StaticOrder {
    int nM, nN, nwg, G, c, flipn;
    __host__ __device__ void init(int M, int N, int G_, int c_, int flipn_ = 0) { nM = M / BM; nN = N / BM; nwg = nM * nN; G = G_; c = c_; flipn = flipn_; }
    __host__ __device__ bool next(int i, Unit& u) const {
        const long L = (long)i * G + c; if (L >= nwg) return false;
        int wgid = (int)L; { const int q = nwg / NXCD, r = nwg % NXCD, xcd = wgid % NXCD, off = wgid / NXCD; wgid = (xcd < r ? xcd * (q + 1) : r * (q + 1) + (xcd - r) * q) + off; }
        const int nig = WGM * nN, gid = wgid / nig, fm = gid * WGM, gsz = (nM - fm) < WGM ? (nM - fm) : WGM;
        u.pm = fm + ((wgid % nig) % gsz); u.pn = (wgid % nig) / gsz; if (flipn) u.pn = nN - 1 - u.pn; return true;
    }
    __device__ __forceinline__ void a_ready(const Unit&) const {}
    __device__ __forceinline__ void done(const Unit&) const {}
};

__device__ __forceinline__ unsigned cvt_pk_bf16(float lo, float hi) { unsigned r; asm volatile("v_cvt_pk_bf16_f32 %0, %1, %2" : "=v"(r) : "v"(lo), "v"(hi)); return r; }
typedef float f32x2 __attribute__((ext_vector_type(2)));
struct EpiF32 {
    static constexpr bool PERM = false, AFTER_DRAIN = false;
    float* C; int ldc; const float* rs;
    __device__ __forceinline__ void operator()(const f32x4 (&acc)[2][2][4][2], const Unit& u, int wr, int wc, int fr, int fq) const {
        const int row0 = u.pm * BM + wr * 64 + fr, col0 = u.pn * BM + wc * 32 + 4 * fq;
#pragma unroll
        for (int ai = 0; ai < 2; ++ai)
#pragma unroll
            for (int m = 0; m < 4; ++m) { const int row = row0 + ai * HALF + m * 16; float* rowp = C + (size_t)row * ldc + col0; const float s = rs ? rs[row] : 1.f;
#pragma unroll
                for (int bj = 0; bj < 2; ++bj)
#pragma unroll
                    for (int n = 0; n < 2; ++n) *(f32x4*)(rowp + bj * HALF + n * 16) = acc[ai][bj][m][n] * s; }
    }
};
struct EpiBf16Map {
    static constexpr bool PERM = true, AFTER_DRAIN = false;
    bf16_t* O; int ldc; int gs, gstride; int scale_cols; float scale0; const float* rs;
    __device__ __forceinline__ void operator()(const f32x4 (&acc)[2][2][4][2], const Unit& u, int wr, int wc, int fr, int fq) const {
        const int row0 = u.pm * BM + wr * 64 + fr;
        int dcol[2]; float sc[2];
#pragma unroll
        for (int bj = 0; bj < 2; ++bj) { const int ch = u.pn * BM + bj * HALF, grp = ch / gs; dcol[bj] = grp * gstride + (ch - grp * gs) + wc * 32 + 8 * fq; sc[bj] = ch < scale_cols ? scale0 : 1.f; }
#pragma unroll
        for (int ai = 0; ai < 2; ++ai)
#pragma unroll
            for (int m = 0; m < 4; ++m) { const int row = row0 + ai * HALF + m * 16; bf16_t* rowp = O + (size_t)row * ldc; const float s = rs ? rs[row] : 1.f;
#pragma unroll
                for (int bj = 0; bj < 2; ++bj) { const f32x4 v0 = acc[ai][bj][m][0] * (sc[bj] * s), v1 = acc[ai][bj][m][1] * (sc[bj] * s);
                    u32x4 w; w.x = cvt_pk_bf16(v0[0], v0[1]); w.y = cvt_pk_bf16(v0[2], v0[3]); w.z = cvt_pk_bf16(v1[0], v1[1]); w.w = cvt_pk_bf16(v1[2], v1[3]);
                    *(u32x4*)(rowp + dcol[bj]) = w; } }
    }
};

struct EpiQRope {
    static constexpr bool PERM = true, AFTER_DRAIN = false;
    bf16_t* Q; const float* CS; float qs;
    __device__ __forceinline__ void operator()(const f32x4 (&acc)[2][2][4][2], const Unit& u, int wr, int wc, int fr, int fq) const {
        typedef unsigned u32x2 __attribute__((ext_vector_type(2)));
        const int row0 = u.pm * BM + wr * 64 + fr;
#pragma unroll
        for (int bj = 0; bj < 2; ++bj) {
            const int c0 = u.pn * BM + bj * HALF + wc * 32 + 8 * fq, head = c0 / 192, cl = c0 - head * 192;
            if (cl < 128) {
#pragma unroll
                for (int ai = 0; ai < 2; ++ai)
#pragma unroll
                    for (int m = 0; m < 4; ++m) { const f32x4 v0 = acc[ai][bj][m][0] * qs, v1 = acc[ai][bj][m][1] * qs;
                        u32x4 w; w.x = cvt_pk_bf16(v0[0], v0[1]); w.y = cvt_pk_bf16(v0[2], v0[3]); w.z = cvt_pk_bf16(v1[0], v1[1]); w.w = cvt_pk_bf16(v1[2], v1[3]);
                        *(u32x4*)(Q + (size_t)(row0 + ai * HALF + m * 16) * 6144 + c0) = w; }
            } else {
                const int p0 = (cl - 128) >> 1;
#pragma unroll
                for (int ai = 0; ai < 2; ++ai)
#pragma unroll
                    for (int m = 0; m < 4; ++m) { const int row = row0 + ai * HALF + m * 16;
                        const f32x4 c4 = *(const f32x4*)(CS + (size_t)row * 64 + p0), s4 = *(const f32x4*)(CS + (size_t)row * 64 + 32 + p0);
                        const f32x4 x = acc[ai][bj][m][0], y = acc[ai][bj][m][1];
                        const float a0 = (x[0] * c4[0] - x[1] * s4[0]) * qs, b0 = (x[1] * c4[0] + x[0] * s4[0]) * qs, a1 = (x[2] * c4[1] - x[3] * s4[1]) * qs, b1 = (x[3] * c4[1] + x[2] * s4[1]) * qs;
                        const float a2 = (y[0] * c4[2] - y[1] * s4[2]) * qs, b2 = (y[1] * c4[2] + y[0] * s4[2]) * qs, a3 = (y[2] * c4[3] - y[3] * s4[3]) * qs, b3 = (y[3] * c4[3] + y[2] * s4[3]) * qs;
                        bf16_t* qp = Q + (size_t)row * 6144 + head * 192 + 128 + p0;
                        u32x2 w1; w1.x = cvt_pk_bf16(a0, a1); w1.y = cvt_pk_bf16(a2, a3); *(u32x2*)qp = w1;
                        u32x2 w2; w2.x = cvt_pk_bf16(b0, b1); w2.y = cvt_pk_bf16(b2, b3); *(u32x2*)(qp + 32) = w2; }
            }
        }
    }
};

struct EpiConvAct {
    static constexpr bool PERM = true, AFTER_DRAIN = false, APERM = true;
    bf16_t* ACT; float* PART; float* HALO; const float* cw; const float* cb; const float* rs;
    static constexpr int DFF = 11008;
    static constexpr int ATILED = 1;
    __device__ __forceinline__ static float shr1f(float x) { return __builtin_bit_cast(float, __builtin_amdgcn_update_dpp(0, __builtin_bit_cast(int, x), 0x111, 0xF, 0xF, true)); }
    __device__ __forceinline__ static f32x4 shr1(const f32x4 v) { f32x4 r; r.x = shr1f(v.x); r.y = shr1f(v.y); r.z = shr1f(v.z); r.w = shr1f(v.w); return r; }
    __device__ __forceinline__ static float silu_mul(float g, float v) { return g * __builtin_amdgcn_rcpf(1.0f + __builtin_amdgcn_exp2f(g * -1.4426950408889634f)) * v; }
    __device__ __forceinline__ void operator()(const f32x4 (&acc)[2][2][4][2], const Unit& u, int wr, int wc, int fr, int fq) const {
        typedef unsigned u32x2 __attribute__((ext_vector_type(2)));
        const int j0 = u.pn * HALF + wc * 32 + 8 * fq;
        u32x2 keep[2][4];
#pragma unroll
        for (int n = 0; n < 2; ++n) {
            const int j = j0 + 4 * n;
            const f32x4 wg0 = *(const f32x4*)(cw + j), wg1 = *(const f32x4*)(cw + 2 * DFF + j), wg2 = *(const f32x4*)(cw + 4 * DFF + j), bg = *(const f32x4*)(cb + j);
            const f32x4 wv0 = *(const f32x4*)(cw + DFF + j), wv1 = *(const f32x4*)(cw + 3 * DFF + j), wv2 = *(const f32x4*)(cw + 5 * DFF + j), bv = *(const f32x4*)(cb + DFF + j);
#pragma unroll
            for (int ai = 0; ai < 2; ++ai) {
                const int blk = 4 * u.pm + 2 * ai + wr;
                const f32x4 rsv = *(const f32x4*)(rs + u.pm * BM + ai * HALF + wr * 64 + 4 * fr);
                f32x4 ug[4], uv[4];
#pragma unroll
                for (int m = 0; m < 4; ++m) { ug[m] = acc[ai][0][m][n] * rsv[m]; uv[m] = acc[ai][1][m][n] * rsv[m]; }
                const f32x4 g3 = shr1(ug[3]), g2 = shr1(ug[2]), v3 = shr1(uv[3]), v2 = shr1(uv[2]);
#pragma unroll
                for (int m = 0; m < 4; ++m) {
                    const f32x4 gc = ug[m], vc = uv[m];
                    const f32x4 gp1 = (m == 0) ? g3 : ug[m - 1 < 0 ? 0 : m - 1], gp2 = (m == 0) ? g2 : (m == 1) ? g3 : ug[m - 2 < 0 ? 0 : m - 2];
                    const f32x4 vp1 = (m == 0) ? v3 : uv[m - 1 < 0 ? 0 : m - 1], vp2 = (m == 0) ? v2 : (m == 1) ? v3 : uv[m - 2 < 0 ? 0 : m - 2];
                    const f32x4 G = bg + wg0 * gp2 + wg1 * gp1 + wg2 * gc, V = bv + wv0 * vp2 + wv1 * vp1 + wv2 * vc;
                    if (m < 2) { if (fr == 0) { float* pp = PART + ((size_t)(blk * 2 + m) * 2) * DFF + j; *(f32x4*)pp = G; *(f32x4*)(pp + DFF) = V; } }
                    else       { if (fr == 15) { float* hp = HALO + ((size_t)(blk * 2 + (m - 2)) * 2) * DFF + j; *(f32x4*)hp = gc; *(f32x4*)(hp + DFF) = vc; } }
                    u32x2 w; w.x = cvt_pk_bf16(silu_mul(G[0], V[0]), silu_mul(G[1], V[1])); w.y = cvt_pk_bf16(silu_mul(G[2], V[2]), silu_mul(G[3], V[3]));
                    if (n == 0) keep[ai][m] = w;
                    else if (!(m < 2 && fr == 0)) { u32x4 o; o.x = keep[ai][m].x; o.y = keep[ai][m].y; o.z = w.x; o.w = w.y;
                        const int row_ = u.pm * BM + ai * HALF + wr * 64 + 4 * fr + m;
                        *(u32x4*)(ACT + (ATILED ? tiled_off(row_, j0, DFF) : (size_t)row_ * DFF + j0)) = o; }
                }
            }
        }
    }
};

struct EpiNull {
    static constexpr bool PERM = true, AFTER_DRAIN = false;
    float* sink;
    __device__ __forceinline__ void operator()(const f32x4 (&acc)[2][2][4][2], const Unit& u, int wr, int wc, int fr, int fq) const {
        f32x4 s = {0.f, 0.f, 0.f, 0.f};
#pragma unroll
        for (int ai = 0; ai < 2; ++ai)
#pragma unroll
            for (int bj = 0; bj < 2; ++bj)
#pragma unroll
                for (int m = 0; m < 4; ++m)
#pragma unroll
                    for (int n = 0; n < 2; ++n) s += acc[ai][bj][m][n];
        if (s[0] + s[1] + s[2] + s[3] == 1.2345678e30f) sink[u.pm + u.pn + fr] = s[0];
    }
};

struct ZeroOrder : StaticOrder {
    __device__ bool next(int i, Unit& u) const { const bool ok = StaticOrder::next(i, u); u.pm = 0; u.pn = 0; return ok; }
};

struct ZeroAOrder : StaticOrder { __device__ bool next(int i, Unit& u) const { const bool ok = StaticOrder::next(i, u); u.pm = 0; return ok; } };
struct ZeroBOrder : StaticOrder { __device__ bool next(int i, Unit& u) const { const bool ok = StaticOrder::next(i, u); u.pn = 0; return ok; } };

struct HalfMOrder {
    StaticOrder so; int vcu; bool fast;
    __device__ void init(int M, int N, int G_, int c_, int vcu_) { so.init(M, N, G_, c_); vcu = vcu_; fast = (G_ == 256 && M == 8192 && N == 4096); }
    __device__ bool next(int i, Unit& u) const {
        if (!fast) return so.next(i, u);
        if (i >= 2) return false;
        const int x = vcu >> 5, j = vcu & 31; u.pm = 16 * i + 4 * (x >> 1) + (j & 3); u.pn = 8 * (x & 1) + (j >> 2); return true;
    }
    __device__ __forceinline__ void a_ready(const Unit&) const {}
    __device__ __forceinline__ void done(const Unit&) const {}
};

template <class E, class = void> struct epi_aperm { static constexpr bool value = false; };
template <class E> struct epi_aperm<E, decltype((void)E::APERM)> { static constexpr bool value = E::APERM; };
template <class Epi, class Sched, bool ALIGN_EPI = false, bool SP2 = false>
__device__ __forceinline__ void gemm_phase(PG8_LAS unsigned char* lds, const Gemm g, const Sched& S, const Epi& E) {
    const int tid = threadIdx.x, wid = __builtin_amdgcn_readfirstlane(tid >> 6), lane = tid & 63, wr = wid >> 2, wc = wid & 3, fr = lane & 15, fq = lane >> 4;
    const int K = g.K, nt = K / BK;
    unsigned voffA[2], voffB[2];
#pragma unroll
    for (int i = 0; i < 2; ++i) { int R, C; stage_rc(tid * 16 + i * 8192, R, C); const int Rb = Epi::PERM ? ((R & ~31) + perm32(R & 31)) : R;
        const int Ra = epi_aperm<Epi>::value ? ((R & ~63) | (4 * (R & 15) + ((R >> 4) & 3))) : R;
        voffA[i] = (unsigned)(Ra * (g.tA ? BK : K) + C) * 2u; voffB[i] = (unsigned)(Rb * (g.tB ? BK : K) + C) * 2u; }
    const long ksA = g.tA ? (long)(BM * BK * 2) : (long)(BK * 2), ksB = g.tB ? (long)(BM * BK * 2) : (long)(BK * 2);
#define PG8_REV(u_) (g.zig == 3 || (g.zig != 0 && ((((u_) ^ g.zig) & 1) != 0)))
    long kstepA = PG8_REV(0) ? -ksA : ksA, kstepB = PG8_REV(0) ? -ksB : ksB;
    const size_t hstepA = g.tA ? (size_t)(HALF * BK * 2) : (size_t)HALF * K * 2, hstepB = g.tB ? (size_t)(HALF * BK * 2) : (size_t)HALF * K * 2;
    const size_t tstepA = (size_t)BM * K * 2, tstepB = (size_t)BM * K * 2;
    const unsigned ldsw = (unsigned)wid * 1024u;
    const int aoff = lds_byte(wr * 64 + fr, fq * 8), boff = lds_byte(wc * 32 + fr, fq * 8);
#define PG8_NT_B 1
#define PG8_SA(b, h) (((b) * 2 + (h)) * HTB)
#define PG8_SB(b, h) ((4 + (b) * 2 + (h)) * HTB)
    const char* const bA_ = (const char*)g.A; const char* const bB_ = (const char*)g.Bt;
    const __amdgpu_buffer_rsrc_t srdA_ = __builtin_amdgcn_make_buffer_rsrc((void*)g.A, (short)0, (int)((size_t)g.M * K * 2), 0x00020000);
    const __amdgpu_buffer_rsrc_t srdB_ = __builtin_amdgcn_make_buffer_rsrc((void*)g.Bt, (short)0, (int)((size_t)g.N * K * 2), 0x00020000);
#define PG8_STAGE(bufoff, gbase, voff) do { _Pragma("unroll") for (int _i = 0; _i < 2; ++_i) \
        __builtin_amdgcn_raw_ptr_buffer_load_lds(srdA_, (PG8_LAS void*)(lds + (bufoff) + ldsw + _i * 8192), 16, (voff)[_i], (int)((const char*)(gbase) - bA_), 0, PG8_NT_B); } while (0)
#define PG8_STAGEB(bufoff, gbase, voff) do { _Pragma("unroll") for (int _i = 0; _i < 2; ++_i) \
        __builtin_amdgcn_raw_ptr_buffer_load_lds(srdB_, (PG8_LAS void*)(lds + (bufoff) + ldsw + _i * 8192), 16, (voff)[_i], (int)((const char*)(gbase) - bB_), 0, PG8_NT_B); } while (0)
#define PG8_LDA(dst, b, h) do { _Pragma("unroll") for (int m = 0; m < 4; ++m) _Pragma("unroll") for (int k = 0; k < 2; ++k) dst[m][k] = *(const PG8_LAS bf16x8*)(lds + PG8_SA(b, h) + aoff + m * 2048 + k * 1024); } while (0)
#define PG8_LDB(dst, b, h) do { _Pragma("unroll") for (int n = 0; n < 2; ++n) _Pragma("unroll") for (int k = 0; k < 2; ++k) dst[n][k] = *(const PG8_LAS bf16x8*)(lds + PG8_SB(b, h) + boff + n * 2048 + k * 1024); } while (0)
#define PG8_MMA(ai, bj, At, Bt) do { __builtin_amdgcn_s_setprio(1); _Pragma("unroll") for (int m = 0; m < 4; ++m) _Pragma("unroll") for (int n = 0; n < 2; ++n) _Pragma("unroll") for (int k = 0; k < 2; ++k) \
        acc[ai][bj][m][n] = __builtin_amdgcn_mfma_f32_16x16x32_bf16(Bt[n][k], At[m][k], acc[ai][bj][m][n], 0, 0, 0); __builtin_amdgcn_s_setprio(0); } while (0)
#define PG8_WAIT_V(n) asm volatile("s_waitcnt vmcnt(" #n ")" ::: "memory")
#define PG8_WAIT_L(n) asm volatile("s_waitcnt lgkmcnt(" #n ")" ::: "memory")
#define PG8_BAR __builtin_amdgcn_s_barrier()
#define PG8_SCHED __builtin_amdgcn_sched_barrier(0)
    Unit cur, nxt; int ui = 0;
    if (!S.next(0, cur)) return;
    f32x4 acc[2][2][4][2];
#pragma unroll
    for (int a = 0; a < 2; ++a)
#pragma unroll
        for (int b = 0; b < 2; ++b)
#pragma unroll
            for (int m = 0; m < 4; ++m)
#pragma unroll
                for (int n = 0; n < 2; ++n) acc[a][b][m][n] = (f32x4){0.f, 0.f, 0.f, 0.f};
    bf16x8 At[4][2], B0[2][2], B1[2][2];
    const char* cA = (const char*)g.A + (size_t)cur.pm * tstepA + (PG8_REV(0) ? (long)(nt - 1) * ksA : 0l); const char* cB = (const char*)g.Bt + (size_t)cur.pn * tstepB + (PG8_REV(0) ? (long)(nt - 1) * ksB : 0l);
    S.a_ready(cur);
    if constexpr (SP2) {
        PG8_STAGEB(PG8_SB(0, 0), cB, voffB); PG8_STAGEB(PG8_SB(0, 1), cB + hstepB, voffB); PG8_STAGE(PG8_SA(0, 0), cA, voffA); PG8_STAGE(PG8_SA(0, 1), cA + hstepA, voffA);
        if (wr == 1) PG8_BAR;
        PG8_WAIT_V(2); PG8_BAR;
        PG8_STAGEB(PG8_SB(1, 0), cB + kstepB, voffB); PG8_STAGE(PG8_SA(1, 0), cA + kstepA, voffA); PG8_STAGEB(PG8_SB(1, 1), cB + hstepB + kstepB, voffB);
        PG8_WAIT_V(6); PG8_BAR;
    } else {
        PG8_STAGEB(PG8_SB(0, 0), cB, voffB); PG8_STAGE(PG8_SA(0, 0), cA, voffA); PG8_STAGEB(PG8_SB(0, 1), cB + hstepB, voffB); PG8_STAGE(PG8_SA(0, 1), cA + hstepA, voffA);
        if (wr == 1) PG8_BAR;
        PG8_WAIT_V(4); PG8_BAR;
        PG8_STAGEB(PG8_SB(1, 0), cB + kstepB, voffB); PG8_STAGE(PG8_SA(1, 0), cA + kstepA, voffA); PG8_STAGEB(PG8_SB(1, 1), cB + hstepB + kstepB, voffB);
        PG8_WAIT_V(6); PG8_BAR;
    }
    for (;;) {
        const bool has_next = S.next(ui + 1, nxt);
        const bool nrev = PG8_REV(ui + 1);
        const long nkstepA = has_next ? (nrev ? -ksA : ksA) : kstepA, nkstepB = has_next ? (nrev ? -ksB : ksB) : kstepB;
        const char* nA = has_next ? (const char*)g.A + (size_t)nxt.pm * tstepA + (nrev ? (long)(nt - 1) * ksA : 0l) : cA; const char* nB = has_next ? (const char*)g.Bt + (size_t)nxt.pn * tstepB + (nrev ? (long)(nt - 1) * ksB : 0l) : cB;
        if constexpr (SP2) {
            if (wr == 0) {
                for (int t = 0; t < nt; t += 2) {
            const bool last = (t == nt - 2);
            const char* a1 = cA + (long)(t + 1) * kstepA;
            const char* a2 = last ? nA : cA + (long)(t + 2) * kstepA; const char* b2 = last ? nB : cB + (long)(t + 2) * kstepB;
            const char* a3 = a2 + (last ? nkstepA : kstepA); const char* b3 = b2 + (last ? nkstepB : kstepB);
            if (last && has_next) S.a_ready(nxt);
            PG8_LDB(B0, 0, 0); PG8_LDB(B1, 0, 1); PG8_SCHED; PG8_LDA(At, 0, 0); PG8_STAGE(PG8_SA(1, 1), a1 + hstepA, voffA);
            PG8_WAIT_L(0); PG8_BAR; PG8_MMA(0, 0, At, B0); PG8_MMA(0, 1, At, B1); PG8_WAIT_V(8); PG8_BAR; PG8_SCHED;
            PG8_LDA(At, 0, 1); PG8_STAGEB(PG8_SB(0, 0), b2, voffB); PG8_STAGEB(PG8_SB(0, 1), b2 + hstepB, voffB); PG8_STAGE(PG8_SA(0, 0), a2, voffA);
            PG8_WAIT_L(0); PG8_BAR; PG8_MMA(1, 0, At, B0); PG8_MMA(1, 1, At, B1); PG8_WAIT_V(8); PG8_BAR; PG8_SCHED;
            PG8_LDB(B0, 1, 0); PG8_LDB(B1, 1, 1); PG8_SCHED; PG8_LDA(At, 1, 0); PG8_STAGE(PG8_SA(0, 1), a2 + hstepA, voffA);
            PG8_WAIT_L(0); PG8_BAR; PG8_MMA(0, 0, At, B0); PG8_MMA(0, 1, At, B1); PG8_WAIT_V(8); PG8_BAR; PG8_SCHED;
            PG8_LDA(At, 1, 1); PG8_STAGEB(PG8_SB(1, 0), b3, voffB); PG8_STAGEB(PG8_SB(1, 1), b3 + hstepB, voffB); PG8_STAGE(PG8_SA(1, 0), a3, voffA);
            PG8_WAIT_L(0); PG8_BAR; PG8_MMA(1, 0, At, B0); PG8_MMA(1, 1, At, B1); PG8_WAIT_V(8); PG8_BAR; PG8_SCHED;
                }
            } else {
                for (int t = 0; t < nt; t += 2) {
            const bool last = (t == nt - 2);
            const char* a1 = cA + (long)(t + 1) * kstepA;
            const char* a2 = last ? nA : cA + (long)(t + 2) * kstepA; const char* b2 = last ? nB : cB + (long)(t + 2) * kstepB;
            const char* a3 = a2 + (last ? nkstepA : kstepA); const char* b3 = b2 + (last ? nkstepB : kstepB);
            if (last && has_next) S.a_ready(nxt);
            PG8_LDB(B0, 0, 0); PG8_LDB(B1, 0, 1); PG8_SCHED; PG8_LDA(At, 0, 0); PG8_STAGE(PG8_SA(1, 1), a1 + hstepA, voffA);
            PG8_WAIT_V(8); PG8_WAIT_L(0); PG8_BAR; PG8_MMA(0, 0, At, B0); PG8_MMA(0, 1, At, B1); PG8_BAR; PG8_SCHED;
            PG8_LDA(At, 0, 1); PG8_STAGEB(PG8_SB(0, 0), b2, voffB); PG8_STAGEB(PG8_SB(0, 1), b2 + hstepB, voffB); PG8_STAGE(PG8_SA(0, 0), a2, voffA);
            PG8_WAIT_V(8); PG8_WAIT_L(0); PG8_BAR; PG8_MMA(1, 0, At, B0); PG8_MMA(1, 1, At, B1); PG8_BAR; PG8_SCHED;
            PG8_LDB(B0, 1, 0); PG8_LDB(B1, 1, 1); PG8_SCHED; PG8_LDA(At, 1, 0); PG8_STAGE(PG8_SA(0, 1), a2 + hstepA, voffA);
            PG8_WAIT_V(8); PG8_WAIT_L(0); PG8_BAR; PG8_MMA(0, 0, At, B0); PG8_MMA(0, 1, At, B1); PG8_BAR; PG8_SCHED;
            PG8_LDA(At, 1, 1); PG8_STAGEB(PG8_SB(1, 0), b3, voffB); PG8_STAGEB(PG8_SB(1, 1), b3 + hstepB, voffB); PG8_STAGE(PG8_SA(1, 0), a3, voffA);
            PG8_WAIT_V(8); PG8_WAIT_L(0); PG8_BAR; PG8_MMA(1, 0, At, B0); PG8_MMA(1, 1, At, B1); PG8_BAR; PG8_SCHED;
                }
            }
        } else {
            for (int t = 0; t < nt; t += 2) {
            const bool last = (t == nt - 2);
            const char* a1 = cA + (long)(t + 1) * kstepA;
            const char* a2 = last ? nA : cA + (long)(t + 2) * kstepA; const char* b2 = last ? nB : cB + (long)(t + 2) * kstepB;
            const char* a3 = a2 + (last ? nkstepA : kstepA); const char* b3 = b2 + (last ? nkstepB : kstepB);
            if (last && has_next) S.a_ready(nxt);
            PG8_LDB(B0, 0, 0); PG8_SCHED; PG8_LDA(At, 0, 0); PG8_STAGE(PG8_SA(1, 1), a1 + hstepA, voffA);
            PG8_WAIT_L(8); PG8_BAR; PG8_WAIT_L(0); PG8_MMA(0, 0, At, B0); PG8_BAR; PG8_SCHED;
            PG8_LDB(B1, 0, 1); PG8_STAGEB(PG8_SB(0, 0), b2, voffB);
            PG8_BAR; PG8_WAIT_L(0); PG8_MMA(0, 1, At, B1); PG8_BAR;
            PG8_LDA(At, 0, 1); PG8_STAGE(PG8_SA(0, 0), a2, voffA);
            PG8_BAR; PG8_WAIT_L(0); PG8_MMA(1, 0, At, B0); PG8_BAR; PG8_SCHED;
            PG8_STAGEB(PG8_SB(0, 1), b2 + hstepB, voffB);
            PG8_WAIT_V(6); PG8_BAR; PG8_MMA(1, 1, At, B1); PG8_BAR;
            PG8_LDB(B0, 1, 0); PG8_SCHED; PG8_LDA(At, 1, 0); PG8_STAGE(PG8_SA(0, 1), a2 + hstepA, voffA);
            PG8_WAIT_L(8); PG8_BAR; PG8_WAIT_L(0); PG8_MMA(0, 0, At, B0); PG8_BAR; PG8_SCHED;
            PG8_LDB(B1, 1, 1); PG8_STAGEB(PG8_SB(1, 0), b3, voffB);
            PG8_BAR; PG8_WAIT_L(0); PG8_MMA(0, 1, At, B1); PG8_BAR;
            PG8_LDA(At, 1, 1); PG8_STAGE(PG8_SA(1, 0), a3, voffA);
            PG8_BAR; PG8_WAIT_L(0); PG8_MMA(1, 0, At, B0); PG8_BAR; PG8_SCHED;
            PG8_STAGEB(PG8_SB(1, 1), b3 + hstepB, voffB);
            PG8_WAIT_V(6); PG8_BAR; PG8_MMA(1, 1, At, B1); PG8_BAR;
            }
        }
        if constexpr (ALIGN_EPI) { if (wr == 0) PG8_BAR; }
        if constexpr (!Epi::AFTER_DRAIN) { E(acc, cur, wr, wc, fr, fq); S.done(cur); }
        if (!has_next) break;
#pragma unroll
        for (int a = 0; a < 2; ++a)
#pragma unroll
            for (int b = 0; b < 2; ++b)
#pragma unroll
                for (int m = 0; m < 4; ++m)
#pragma unroll
                    for (int n = 0; n < 2; ++n) acc[a][b][m][n] = (f32x4){0.f, 0.f, 0.f, 0.f};
        cur = nxt; cA = nA; cB = nB; kstepA = nkstepA; kstepB = nkstepB; ++ui;
        if constexpr (ALIGN_EPI) { if (wr == 1) PG8_BAR; }
    }
    PG8_WAIT_V(0);
    if constexpr (!ALIGN_EPI) { if (wr == 0) PG8_BAR; }
    PG8_BAR;
    if constexpr (Epi::AFTER_DRAIN) { E.fused(acc, cur, wr, wc, fr, fq, lds, wid, lane); S.done(cur); }
#undef PG8_REV
#undef PG8_SA
#undef PG8_SB
#undef PG8_STAGE
#undef PG8_LDA
#undef PG8_LDB
#undef PG8_MMA
#undef PG8_WAIT_V
#undef PG8_WAIT_L
#undef PG8_BAR
#undef PG8_SCHED
}
}

constexpr int BATCH = 2, SEQ = 4096, DM = 4096, M = BATCH * SEQ;
constexpr int QLORA = 1024, KVLORA = 512, NH = 32, DQK = 192, DNOPE = 128, DROPE = 64, DV = 128;
constexpr int N1 = 1792;
constexpr int QW = NH * DQK;
constexpr int DFF = 11008, DFF2 = 22016;
constexpr int SWH = 64, SWKV = 8, SWD = 64, WIN = 128, QK1W = 4096 + 512 + 512;
constexpr float EPS = 1e-6f;
constexpr float LOG2E = 1.4426950408889634f;
constexpr float QS0 = (float)(0.07216878364870322 * 1.4426950408889634);
constexpr float QS1 = (float)(0.125 * 1.4426950408889634);
constexpr int NWAVES = 8;
constexpr int FLIP_IN = 0;
constexpr int ZIG_OUT = 1, ZIG_DEF = 0;
constexpr int K0IN_ON = 0;
constexpr int XTILED = 0;
constexpr bool LEADB_IN = false;
constexpr int WTILED = 1;

constexpr size_t MiB = 1u << 20;
constexpr size_t WS_CTL = 0, CTL_ZERO_BYTES = 1 * MiB;
constexpr size_t WS_CS    = 2 * MiB;
constexpr size_t WS_RS    = 6 * MiB;
constexpr size_t WS_W1T   = 8 * MiB;
constexpr size_t WS_WUQT  = WS_W1T   + (size_t)N1 * DM * 2;
constexpr size_t WS_WKNT  = WS_WUQT  + (size_t)QW * QLORA * 2;
constexpr size_t WS_WVT   = WS_WKNT  + (size_t)4096 * KVLORA * 2;
constexpr size_t WS_WO0T  = WS_WVT   + (size_t)4096 * KVLORA * 2;
constexpr size_t WS_WIN0T = WS_WO0T  + (size_t)DM * DM * 2;
constexpr size_t WS_WOUT0T= WS_WIN0T + (size_t)DFF2 * DM * 2;
constexpr size_t WS_WQK1T = WS_WOUT0T+ (size_t)DM * DFF * 2;
constexpr size_t WS_WV1T  = WS_WQK1T + (size_t)QK1W * DM * 2;
constexpr size_t WS_WO1T  = WS_WV1T  + (size_t)512 * DM * 2;
constexpr size_t WS_WIN1T = WS_WO1T  + (size_t)DM * DM * 2;
constexpr size_t WS_WOUT1T= WS_WIN1T + (size_t)DFF2 * DM * 2;
constexpr size_t WS_XN    = WS_WOUT1T+ (size_t)DM * DFF * 2;
constexpr size_t WS_CQKV  = WS_XN    + (size_t)M * DM * 2;
constexpr size_t WS_CQN   = WS_CQKV  + (size_t)M * N1 * 4;
constexpr size_t WS_CKV   = WS_CQN   + (size_t)M * QLORA * 2;
constexpr size_t WS_QF    = WS_CKV   + (size_t)M * KVLORA * 2;
constexpr size_t WS_Q     = WS_QF    + (size_t)M * QW * 4;
constexpr size_t WS_K     = WS_Q     + (size_t)M * QW * 2;
constexpr size_t WS_VT    = WS_K     + (size_t)M * QW * 2;
constexpr size_t WS_O     = WS_VT    + (size_t)4096 * M * 2;
constexpr size_t WS_AF    = WS_O     + (size_t)M * DM * 2;
constexpr size_t WS_U     = WS_AF    + (size_t)M * DM * 4;
constexpr size_t WS_ACT   = WS_U     + (size_t)M * DFF2 * 2;
constexpr size_t WS_QK1   = WS_ACT   + (size_t)M * DFF * 2;
constexpr size_t WS_VT1   = WS_QK1   + (size_t)M * QK1W * 2;
constexpr size_t WS_END   = WS_VT1   + (size_t)512 * M * 2;
constexpr int CW_BAR = 4096;

constexpr int RING_OFF = 0, RING_BYTES = 131072;
constexpr int LDSCTL_OFF = RING_BYTES, MISC_OFF = LDSCTL_OFF + 320;
constexpr int JOBS_OFF = LDSCTL_OFF + 1024;
constexpr int LDS_BYTES = 147456;
#define GAS __attribute__((address_space(1)))
#define LAS __attribute__((address_space(3)))
typedef unsigned short bf16;
typedef unsigned v4u __attribute__((ext_vector_type(4)));
typedef float f32x4 __attribute__((ext_vector_type(4)));
typedef short bf16x8 __attribute__((ext_vector_type(8)));
typedef GAS unsigned gu32;
typedef GAS unsigned long long gu64;
#define RLX_AGENT __ATOMIC_RELAXED, __HIP_MEMORY_SCOPE_AGENT
#define LDS_WAIT() asm volatile("s_waitcnt lgkmcnt(0)" ::: "memory")
#define VM_WAIT() asm volatile("s_waitcnt vmcnt(0)" ::: "memory")
__device__ __forceinline__ unsigned long long rt() { return __builtin_amdgcn_s_memrealtime(); }
__device__ __forceinline__ unsigned f2bf(float f) { unsigned u = __builtin_bit_cast(unsigned, f); return (u + 0x7fffu + ((u >> 16) & 1u)) >> 16; }
__device__ __forceinline__ unsigned pk2(float lo, float hi) { return f2bf(lo) | (f2bf(hi) << 16); }

#define XB_TMO      128
#define XB_XCNT(j)  (256  + 64 * (j))
#define XB_XSUB(j)  (1280 + 64 * (j))
#define XB_XGEN(j)  (2304 + 64 * (j))
#define XB_TOP      3328
#define XB_TOPGEN   3392
#define XCD_BAR_WORDS 3456
#define XB_SPIN_CAP (1u << 18)

__device__ __forceinline__ unsigned xb_ld(unsigned* p)              { return __hip_atomic_load(p, __ATOMIC_RELAXED, __HIP_MEMORY_SCOPE_AGENT); }
__device__ __forceinline__ unsigned xb_add(unsigned* p, unsigned v) { return __hip_atomic_fetch_add(p, v, __ATOMIC_RELAXED, __HIP_MEMORY_SCOPE_AGENT); }
__device__ __forceinline__ unsigned xb_xcc_id() { return (unsigned)__builtin_amdgcn_s_getreg((3 << 11) | 20) & 0xFu; }
#define XB_SPIN(cond, bar) do { unsigned _sp = 0; while (cond) { __builtin_amdgcn_s_sleep(1); \
    if ((++_sp & 255u) == 0u) { if (xb_ld(&(bar)[XB_TMO])) break; if (_sp > XB_SPIN_CAP) { atomicAdd(&(bar)[XB_TMO], 1u); break; } } } } while (0)

struct XcdBarrier {
    unsigned* bar; unsigned x;
    volatile LAS unsigned* st;
};

__device__ __forceinline__ XcdBarrier xcd_barrier_post(unsigned* bar, volatile LAS unsigned* st) {
    XcdBarrier b; b.bar = bar; b.x = xb_xcc_id(); b.st = st;
    if (threadIdx.x == 0) (void)xb_add(&bar[XB_XCNT(b.x)], 1u);
    return b;
}
__device__ __forceinline__ void xcd_barrier_complete(unsigned* bar, unsigned x, unsigned& nloc, unsigned& nx) {
    const unsigned G = gridDim.x * gridDim.y * gridDim.z;
    unsigned sum, cnt, mine, sp = 0u;
    for (;;) {
        sum = 0u; cnt = 0u; mine = 0u;
#pragma unroll
        for (unsigned j = 0; j < 16; ++j) { const unsigned c = xb_ld(&bar[XB_XCNT(j)]); sum += c; cnt += (c > 0u) ? 1u : 0u; mine = (j == x) ? c : mine; }
        if (sum == G) break;
        __builtin_amdgcn_s_sleep(1);
        if ((++sp & 255u) == 0u) { if (xb_ld(&bar[XB_TMO])) break; if (sp > XB_SPIN_CAP) { atomicAdd(&bar[XB_TMO], 1u); break; } }
    }
    nloc = mine > 0u ? mine : 1u; nx = cnt > 0u ? cnt : 1u;
}

__device__ __forceinline__ void xcd_barrier(const XcdBarrier& b) {
    asm volatile("s_waitcnt vmcnt(0)" ::: "memory");
    __syncthreads();
    if (threadIdx.x == 0) {
        unsigned* bar = b.bar;
        __builtin_amdgcn_s_waitcnt(0);
        unsigned nloc = b.st[0], nx = b.st[1];
        if (nloc == 0u) { xcd_barrier_complete(bar, b.x, nloc, nx); b.st[0] = nloc; b.st[1] = nx; }
        const unsigned old = xb_add(&bar[XB_XSUB(b.x)], 1u);
        const unsigned gen = old / nloc;
        if (old + 1u == (gen + 1u) * nloc) {
            __builtin_amdgcn_fence(__ATOMIC_RELEASE, "agent");
            asm volatile("s_waitcnt vmcnt(0)" ::: "memory");
            const unsigned og = xb_add(&bar[XB_TOP], 1u);
            const unsigned tg = og / nx;
            if (og + 1u == (tg + 1u) * nx) xb_add(&bar[XB_TOPGEN], 1u);
            else XB_SPIN(xb_ld(&bar[XB_TOPGEN]) == tg, bar);
            __builtin_amdgcn_fence(__ATOMIC_ACQUIRE, "agent");
            xb_add(&bar[XB_XGEN(b.x)], 1u);
            asm volatile("s_waitcnt vmcnt(0)" ::: "memory");
        } else {
            XB_SPIN(xb_ld(&bar[XB_XGEN(b.x)]) == gen, bar);
            __builtin_amdgcn_fence(__ATOMIC_ACQUIRE, "agent");
            asm volatile("s_waitcnt vmcnt(0)" ::: "memory");
        }
    }
    __syncthreads();
}

typedef float f32x16 __attribute__((ext_vector_type(16)));
typedef float f32x2v __attribute__((ext_vector_type(2)));
typedef unsigned u32x2v __attribute__((ext_vector_type(2)));
__device__ __forceinline__ unsigned cvtpk(float lo, float hi) { unsigned r; asm volatile("v_cvt_pk_bf16_f32 %0, %1, %2" : "=v"(r) : "v"(lo), "v"(hi)); return r; }
#define PACK8(P, B) __builtin_bit_cast(bf16x8, (v4u){cvtpk(P[(B) + 0], P[(B) + 1]), cvtpk(P[(B) + 2], P[(B) + 3]), cvtpk(P[(B) + 4], P[(B) + 5]), cvtpk(P[(B) + 6], P[(B) + 7])})
__device__ __forceinline__ float wave_sum(float v) {
#pragma unroll
    for (int o = 1; o < 64; o <<= 1) v += __shfl_xor(v, o);
    return v;
}
__device__ __forceinline__ int pi32(int m) { return (m & ~0xC) | ((m & 4) << 1) | ((m & 8) >> 1); }
__constant__ float kFreq[32] = {
    1.000000000e+00f, 7.498942614e-01f, 5.623413324e-01f, 4.216965139e-01f, 3.162277639e-01f, 2.371373773e-01f, 1.778279394e-01f, 1.333521307e-01f,
    1.000000015e-01f, 7.498941571e-02f, 5.623413250e-02f, 4.216965288e-02f, 3.162277490e-02f, 2.371373773e-02f, 1.778279431e-02f, 1.333521493e-02f,
    9.999999776e-03f, 7.498941850e-03f, 5.623413250e-03f, 4.216964822e-03f, 3.162277630e-03f, 2.371373586e-03f, 1.778279431e-03f, 1.333521446e-03f,
    1.000000047e-03f, 7.498942432e-04f, 5.623413017e-04f, 4.216965172e-04f, 3.162277571e-04f, 2.371373703e-04f, 1.778279402e-04f, 1.333521504e-04f};

struct Ctx { LAS unsigned char* lds; int tid, lane, wave, vcu, G; };

struct WJob { const float* W; const float* gain; bf16* WT; int ldw, K, ncols, col0, gs, gsrc, drow0, item0, mode, pad; };
constexpr int NJOBS = 14;
__device__ __forceinline__ void wt_item(const float* W, const float* gain, bf16* WT, int ldw, int K, int ncols, int col0, int gs, int gsrc, int drow0, LAS float* scr, int item, int lane) {
    const int nblk = ncols / 32, kb = item / nblk, nb = item - kb * nblk, k0 = 64 * kb, n0 = 32 * nb;
    const int grp = n0 / gs, sc0 = col0 + grp * gsrc + (n0 - grp * gs);
    const float* src = W + (size_t)k0 * ldw + sc0 + (lane & 31);
#pragma unroll 8
    for (int i = 0; i < 32; ++i) { const int kk = 2 * i + (lane >> 5); float w = src[(size_t)kk * ldw]; if (gain) w *= gain[k0 + kk]; scr[kk * 33 + (lane & 31)] = w; }
    LDS_WAIT(); asm volatile("" ::: "memory");
    const int c = lane & 7;
#pragma unroll
    for (int j = 0; j < 4; ++j) { const int n = (lane >> 3) + 8 * j; const LAS float* s = scr + (8 * c) * 33 + n;
        v4u o; o.x = cvtpk(s[0 * 33], s[1 * 33]); o.y = cvtpk(s[2 * 33], s[3 * 33]); o.z = cvtpk(s[4 * 33], s[5 * 33]); o.w = cvtpk(s[6 * 33], s[7 * 33]);
        *(GAS v4u*)(WT + (WTILED ? pg8::tiled_off(drow0 + n0 + n, k0 + 8 * c, K) : (size_t)(drow0 + n0 + n) * K + k0 + 8 * c)) = o; }
    LDS_WAIT(); asm volatile("" ::: "memory");
}
struct WTile { const float* base; unsigned voff; const float* gain; const float* gsafe; bf16* dst; int ldw, K, n0, mode, drow0; };
__device__ __forceinline__ bool wt_decode(const LAS WJob* jobs, int nblkjobs, int ntiles, int T, int lane, int wave, WTile& t, int hole_lo = 0x7fffffff, int hole_len = 0) {
    if (T >= hole_lo) T += hole_len;
    if (T >= ntiles) return false;
    int j = 0;
    for (int q = 1; q < nblkjobs; ++q) j += (T >= jobs[q].item0) ? 1 : 0;
    const LAS WJob& J = jobs[j];
    const int lt = T - J.item0, nblk = J.ncols >> 8, kb = lt / nblk, nb = lt - kb * nblk, k0 = 64 * kb, n0 = 256 * nb;
    const int nn = n0 + 4 * (lane ^ wave), grp = nn / J.gs, sc = J.col0 + grp * J.gsrc + (nn - grp * J.gs);
    t.base = J.W; t.voff = (unsigned)(((size_t)(k0 + 8 * wave) * J.ldw + sc) * 4); t.gain = J.gain ? J.gain + k0 : nullptr; t.gsafe = J.W; t.dst = WTILED ? J.WT + (size_t)kb * 16384 : J.WT + (size_t)J.drow0 * J.K + k0; t.drow0 = J.drow0; t.ldw = J.ldw; t.K = J.K; t.n0 = n0; t.mode = J.mode;
    return true;
}
__device__ __forceinline__ void wt_block_phase(const Ctx& F, const LAS WJob* jobs, int nblkjobs, int tile_lo, int ntiles, int rank, int nranks, int hole_lo = 0x7fffffff, int hole_len = 0) {
    const int lane = F.lane, wave = F.wave, kcl = lane & 7, nl = lane >> 3;
#define WT_ISSUE(t, b, g0, g1) do { const GAS float* gp_ = (const GAS float*)((t).gain ? (t).gain : (t).gsafe) + 8 * kcl; \
        asm volatile("global_load_dwordx4 %0, %1, off" : "=v"(g0) : "v"(gp_) : "memory"); asm volatile("global_load_dwordx4 %0, %1, off offset:16" : "=v"(g1) : "v"(gp_) : "memory");     \
        asm volatile("" ::: "memory"); \
        {     \
            const unsigned long long wb_ = (unsigned long long)(t).base; \
            const unsigned long long wbs_ = ((unsigned long long)(unsigned)__builtin_amdgcn_readfirstlane((int)(wb_ >> 32)) << 32) | (unsigned)__builtin_amdgcn_readfirstlane((int)wb_); \
            const __amdgpu_buffer_rsrc_t srdw_ = __builtin_amdgcn_make_buffer_rsrc((void*)wbs_, (short)0, 0x7ffff000, 0x00020000); \
            const int rowb_ = __builtin_amdgcn_readfirstlane((t).ldw) * 4; \
            _Pragma("unroll") for (int i = 0; i < 8; ++i) __builtin_amdgcn_raw_ptr_buffer_load_lds(srdw_, (LAS void*)(F.lds + (b) * 65536 + (8 * wave + i) * 1024), 16, (t).voff, i * rowb_, 0, 2  ); } \
        asm volatile("" ::: "memory"); } while (0)
#define WT_STEP(X, bx, gx0, gx1, Y, hy, by, gy0, gy1) do { \
        asm volatile("s_waitcnt vmcnt(0) lgkmcnt(0)\n\ts_barrier" : "+v"(gx0), "+v"(gx1) :: "memory"); \
        T += nranks; hy = wt_decode(jobs, nblkjobs, ntiles, T, lane, wave, Y, hole_lo, hole_len); \
        if (hy) WT_ISSUE(Y, by, gy0, gy1); \
        {   const LAS unsigned char* buf = F.lds + (bx) * 65536; \
            const f32x4 one4 = {1.f, 1.f, 1.f, 1.f}; const f32x4 ga = (X).gain ? gx0 : one4, gb = (X).gain ? gx1 : one4; \
            _Pragma("unroll") for (int c = 0; c < 4; ++c) { const int n = 8 * (wave + 8 * c) + nl; \
                const LAS unsigned char* p = buf + (8 * kcl) * 1024 + ((((n >> 2) ^ kcl)) << 4) + ((n & 3) << 2); \
                float v[8]; \
                _Pragma("unroll") for (int e = 0; e < 8; ++e) v[e] = *(const LAS float*)(p + e * 1024); \
                v4u o; o.x = cvtpk(v[0] * ga.x, v[1] * ga.y); o.y = cvtpk(v[2] * ga.z, v[3] * ga.w); o.z = cvtpk(v[4] * gb.x, v[5] * gb.y); o.w = cvtpk(v[6] * gb.z, v[7] * gb.w); \
                int dn = (X).n0 + n; \
                if ((X).mode == 1) { const int hd = dn / DQK; int cl = dn - hd * DQK; if (cl >= DNOPE) { const int w = (cl - DNOPE) >> 5, pp = (cl - DNOPE) & 31; cl = DNOPE + 2 * pp + w; } dn = hd * DQK + cl; } \
                else if ((X).mode == 2) { dn = dn < DFF ? ((dn >> 7) * 256 + (dn & 127)) : (((dn - DFF) >> 7) * 256 + 128 + ((dn - DFF) & 127)); } \
                if (WTILED) { dn += (X).drow0; *(GAS v4u*)((X).dst + (size_t)(dn >> 8) * ((size_t)(X).K << 8) + ((dn & 255) << 6) + 8 * kcl) = o; } \
                else *(GAS v4u*)((X).dst + (size_t)dn * (X).K + 8 * kcl) = o; } } } while (0)
    WTile A, B;
    f32x4 gA0, gA1, gB0, gB1;
    gA0 = gA1 = gB0 = gB1 = (f32x4){1.f, 1.f, 1.f, 1.f};
    int T = tile_lo + rank;
    bool hA = wt_decode(jobs, nblkjobs, ntiles, T, lane, wave, A, hole_lo, hole_len), hB = false;
    if (!hA) return;
    WT_ISSUE(A, 0, gA0, gA1);
    for (;;) {
        WT_STEP(A, 0, gA0, gA1, B, hB, 1, gB0, gB1);
        if (!hB) break;
        WT_STEP(B, 1, gB0, gB1, A, hA, 0, gA0, gA1);
        if (!hA) break;
    }
    asm volatile("s_waitcnt vmcnt(0) lgkmcnt(0)\n\ts_barrier" ::: "memory");
#undef WT_STEP
#undef WT_ISSUE
}
__device__ __forceinline__ void sincos_d(float angf, float& s, float& c) {
    const double x = (double)angf;
    const double kd = __builtin_rint(x * 0.63661977236758134308);
    double r = __builtin_fma(-kd, 1.57079632679489655800e+00, x);
    r = __builtin_fma(-kd, 6.12323399573676603587e-17, r);
    const int k = (int)kd;
    const double r2 = r * r;
    double sp = 1.0 / 6227020800.0;
    sp = sp * r2 - 1.0 / 39916800.0; sp = sp * r2 + 1.0 / 362880.0; sp = sp * r2 - 1.0 / 5040.0; sp = sp * r2 + 1.0 / 120.0; sp = sp * r2 - 1.0 / 6.0; sp = sp * r2 + 1.0; sp = sp * r;
    double cp = -1.0 / 87178291200.0;
    cp = cp * r2 + 1.0 / 479001600.0; cp = cp * r2 - 1.0 / 3628800.0; cp = cp * r2 + 1.0 / 40320.0; cp = cp * r2 - 1.0 / 720.0; cp = cp * r2 + 1.0 / 24.0; cp = cp * r2 - 0.5; cp = cp * r2 + 1.0;
    const int q = k & 3;
    const double ss = (q == 0) ? sp : (q == 1) ? cp : (q == 2) ? -sp : -cp;
    const double cc = (q == 0) ? cp : (q == 1) ? -sp : (q == 2) ? -cp : sp;
    s = (float)ss; c = (float)cc;
}

template <int MODE, bool HF32>
__device__ __forceinline__ void rows_phase(const Ctx& F, const void* src, const void* Hin, const float* g, float* outf, bf16* HB, float* RS) {
    const int gw = F.vcu * NWAVES + F.wave, NGW = F.G * NWAVES;
#define UNPK8(dst, w) do { dst[0] = (f32x4){__uint_as_float((w).x << 16), __uint_as_float((w).x & 0xffff0000u), __uint_as_float((w).y << 16), __uint_as_float((w).y & 0xffff0000u)}; \
                           dst[1] = (f32x4){__uint_as_float((w).z << 16), __uint_as_float((w).z & 0xffff0000u), __uint_as_float((w).w << 16), __uint_as_float((w).w & 0xffff0000u)}; } while (0)
    for (int m = gw; m < M; m += NGW) {
        if (MODE == 0) {
            const GAS f32x4* a = (const GAS f32x4*)((const float*)src + (size_t)m * DM) + F.lane;
            f32x4 v[16]; float ss = 0.f;
#pragma unroll
            for (int j = 0; j < 16; ++j) { v[j] = a[64 * j]; ss += (v[j].x * v[j].x + v[j].y * v[j].y) + (v[j].z * v[j].z + v[j].w * v[j].w); }
            const float rstd = 1.0f / sqrtf(wave_sum(ss) * (1.0f / DM) + EPS);
            if (F.lane == 0) RS[m] = rstd;
            GAS unsigned long long* o8 = (GAS unsigned long long*)(HB + (size_t)m * DM) + F.lane;
#pragma unroll
            for (int j = 0; j < 16; ++j) o8[64 * j] = (unsigned long long)cvtpk(v[j].x, v[j].y) | ((unsigned long long)cvtpk(v[j].z, v[j].w) << 32);
        } else {
            const GAS v4u* a = (const GAS v4u*)((const bf16*)src + (size_t)m * DM) + F.lane;
            f32x4 v[8][2]; float ss = 0.f;
#pragma unroll
            for (int j = 0; j < 8; ++j) { const v4u w = a[64 * j]; UNPK8(v[j], w);
#pragma unroll
                for (int e = 0; e < 2; ++e) ss += (v[j][e].x * v[j][e].x + v[j][e].y * v[j][e].y) + (v[j][e].z * v[j][e].z + v[j][e].w * v[j][e].w); }
            const float rstd = 1.0f / sqrtf(wave_sum(ss) * (1.0f / DM) + EPS);
            const GAS f32x4* gp = (const GAS f32x4*)g + 2 * F.lane;
            float s2 = 0.f;
#pragma unroll
            for (int j = 0; j < 8; ++j) {
                f32x4 hv[2];
                if (HF32) { const GAS f32x4* hp = (const GAS f32x4*)((const float*)Hin + (size_t)m * DM) + 2 * F.lane; hv[0] = hp[128 * j]; hv[1] = hp[128 * j + 1]; }
                else      { const v4u w = ((const GAS v4u*)((const bf16*)Hin + (size_t)m * DM) + F.lane)[64 * j]; UNPK8(hv, w); }
#pragma unroll
                for (int e = 0; e < 2; ++e) { const f32x4 gv = gp[128 * j + e]; const f32x4 o = hv[e] + (v[j][e] * rstd) * gv; v[j][e] = o; s2 += (o.x * o.x + o.y * o.y) + (o.z * o.z + o.w * o.w); }
            }
            if (MODE == 1) {
                const float rstd2 = 1.0f / sqrtf(wave_sum(s2) * (1.0f / DM) + EPS);
                if (F.lane == 0) RS[m] = rstd2;
                GAS v4u* o16 = (GAS v4u*)(HB + (size_t)m * DM) + F.lane;
#pragma unroll
                for (int j = 0; j < 8; ++j) { v4u w; w.x = cvtpk(v[j][0].x, v[j][0].y); w.y = cvtpk(v[j][0].z, v[j][0].w); w.z = cvtpk(v[j][1].x, v[j][1].y); w.w = cvtpk(v[j][1].z, v[j][1].w); o16[64 * j] = w; }
            } else {
                GAS f32x4* op = (GAS f32x4*)(outf + (size_t)m * DM) + 2 * F.lane;
#pragma unroll
                for (int j = 0; j < 8; ++j) { op[128 * j] = v[j][0]; op[128 * j + 1] = v[j][1]; }
            }
        }
    }
#undef UNPK8
}
__device__ __forceinline__ void latent_rows_phase(const Ctx& F, const float* CQKV, const float* CS, bf16* CQN, bf16* CKV, bf16* K) {
    const int gw = F.vcu * NWAVES + F.wave, NGW = F.G * NWAVES, lane = F.lane, l32 = lane & 31;
    for (int m = gw; m < M; m += NGW) {
        const float* row = CQKV + (size_t)m * N1;
        { const GAS f32x4* a = (const GAS f32x4*)row + lane; f32x4 v[4]; float ss = 0.f;
#pragma unroll
          for (int j = 0; j < 4; ++j) { v[j] = a[64 * j]; ss += (v[j].x * v[j].x + v[j].y * v[j].y) + (v[j].z * v[j].z + v[j].w * v[j].w); }
          const float rstd = 1.0f / sqrtf(wave_sum(ss) * (1.0f / QLORA) + EPS);
          GAS unsigned long long* o8 = (GAS unsigned long long*)(CQN + (size_t)m * QLORA) + lane;
#pragma unroll
          for (int j = 0; j < 4; ++j) o8[64 * j] = (unsigned long long)cvtpk(v[j].x * rstd, v[j].y * rstd) | ((unsigned long long)cvtpk(v[j].z * rstd, v[j].w * rstd) << 32); }
        { const GAS f32x4* a = (const GAS f32x4*)(row + QLORA) + lane; f32x4 v[2]; float ss = 0.f;
#pragma unroll
          for (int j = 0; j < 2; ++j) { v[j] = a[64 * j]; ss += (v[j].x * v[j].x + v[j].y * v[j].y) + (v[j].z * v[j].z + v[j].w * v[j].w); }
          const float rstd = 1.0f / sqrtf(wave_sum(ss) * (1.0f / KVLORA) + EPS);
          GAS unsigned long long* o8 = (GAS unsigned long long*)(CKV + (size_t)m * KVLORA) + lane;
#pragma unroll
          for (int j = 0; j < 2; ++j) o8[64 * j] = (unsigned long long)cvtpk(v[j].x * rstd, v[j].y * rstd) | ((unsigned long long)cvtpk(v[j].z * rstd, v[j].w * rstd) << 32); }
        { const float x1 = row[QLORA + KVLORA + l32], x2 = row[QLORA + KVLORA + 32 + l32];
          const float co = CS[(size_t)m * 64 + l32], si = CS[(size_t)m * 64 + 32 + l32];
          const float o1 = x1 * co - x2 * si, o2 = x2 * co + x1 * si;
          const int a = (2 * l32) & 31, which = l32 >> 4;
          const float a0 = __shfl(o1, a), a1 = __shfl(o1, a + 1), b0 = __shfl(o2, a), b1 = __shfl(o2, a + 1);
          const unsigned w = cvtpk(which ? b0 : a0, which ? b1 : a1);
          GAS unsigned* kd = (GAS unsigned*)(K + (size_t)m * QW + DNOPE) + l32;
#pragma unroll
          for (int it = 0; it < 16; ++it) { const int head = 2 * it + (lane >> 5); kd[head * (DQK / 2)] = w; } }
    }
}
__device__ __forceinline__ void q_rope_phase(const Ctx& F, const float* QF, const float* CS, bf16* Q) {
    const int gw = F.vcu * NWAVES + F.wave, NGW = F.G * NWAVES, lane = F.lane, l32 = lane & 31;
    for (int m = gw; m < M; m += NGW) {
        const float* qrow = QF + (size_t)m * QW; bf16* qo = Q + (size_t)m * QW;
        const float co = CS[(size_t)m * 64 + l32], si = CS[(size_t)m * 64 + 32 + l32];
        const int a = (2 * l32) & 31, which = l32 >> 4;
#pragma unroll 4
        for (int h = 0; h < NH; ++h) {
            const int base = h * DQK;
            const f32x2v nv = *(const GAS f32x2v*)(qrow + base + 2 * lane);
            *(GAS unsigned*)(qo + base + 2 * lane) = cvtpk(nv.x * QS0, nv.y * QS0);
            const float x1 = qrow[base + DNOPE + l32], x2 = qrow[base + DNOPE + 32 + l32];
            const float o1 = (x1 * co - x2 * si) * QS0, o2 = (x2 * co + x1 * si) * QS0;
            const float a0 = __shfl(o1, a), a1 = __shfl(o1, a + 1), b0 = __shfl(o2, a), b1 = __shfl(o2, a + 1);
            const unsigned w = cvtpk(which ? b0 : a0, which ? b1 : a1);
            if (lane < 32) *(GAS unsigned*)(qo + base + DNOPE + 2 * lane) = w;
        }
    }
}
__device__ __forceinline__ void conv_fix_phase(const Ctx& F, const float* PART, const float* HALO, const float* cw, const float* cb, bf16* ACT) {
    constexpr int NJ = DFF / 4, NB = M / 64;
    const int gt = F.vcu * (NWAVES * 64) + F.tid, NT = F.G * NWAVES * 64;
    for (int it = gt; it < NB * 2 * NJ; it += NT) {
        const int j = 4 * (it % NJ), br = it / NJ, r = br & 1, blk = br >> 1;
        const float* pp = PART + ((size_t)(blk * 2 + r) * 2) * DFF + j;
        f32x4 G = *(const GAS f32x4*)pp, V = *(const GAS f32x4*)(pp + DFF);
        if ((blk % (SEQ / 64)) != 0) {
            const float* h0 = HALO + ((size_t)((blk - 1) * 2 + 0) * 2) * DFF + j; const float* h1 = HALO + ((size_t)((blk - 1) * 2 + 1) * 2) * DFF + j;
            const f32x4 wg0 = *(const GAS f32x4*)(cw + j), wg1 = *(const GAS f32x4*)(cw + DFF2 + j), wv0 = *(const GAS f32x4*)(cw + DFF + j), wv1 = *(const GAS f32x4*)(cw + DFF2 + DFF + j);
            const f32x4 g62 = *(const GAS f32x4*)h0, v62 = *(const GAS f32x4*)(h0 + DFF), g63 = *(const GAS f32x4*)h1, v63 = *(const GAS f32x4*)(h1 + DFF);
            if (r == 0) { G += wg0 * g62 + wg1 * g63; V += wv0 * v62 + wv1 * v63; }
            else        { G += wg0 * g63;             V += wv0 * v63; }
        }
        float o[4];
#pragma unroll
        for (int e = 0; e < 4; ++e) o[e] = G[e] * __builtin_amdgcn_rcpf(1.0f + __builtin_amdgcn_exp2f(-G[e] * LOG2E)) * V[e];
        u32x2v w; w.x = cvtpk(o[0], o[1]); w.y = cvtpk(o[2], o[3]);
        *(GAS u32x2v*)(ACT + (pg8::EpiConvAct::ATILED ? pg8::tiled_off(64 * blk + r, j, DFF) : (size_t)(64 * blk + r) * DFF + j)) = w;
    }
}

constexpr bool PIGGY = false;
constexpr int PG_LDS = 98304;
struct PgState {
    int next_T, end_T;
    int job, job_end, kb, nb, nblk;
    int cnt; bool pend0, pend1;
};
constexpr int PG_STASH = 131072 + 4096;
__device__ __forceinline__ void pg_setjob(PgState& S, const LAS WJob* jobs, int nblkjobs) {
    const int T = S.next_T;
    int j = 0;
    for (int q = 1; q < nblkjobs; ++q) j += (T >= jobs[q].item0) ? 1 : 0;
    S.job = j; S.job_end = (j + 1 < nblkjobs) ? jobs[j + 1].item0 : 0x7fffffff;
    S.nblk = jobs[j].ncols >> 8;
    const int lt = T - jobs[j].item0; S.kb = lt / S.nblk; S.nb = lt - S.kb * S.nblk;
}
__device__ __forceinline__ void pg_issue(PgState& S, int step_T, int sub, const LAS WJob* jobs, int nblkjobs, LAS unsigned char* ldsw, LAS unsigned* stash, int wid, int lane) {
    if (S.next_T >= S.job_end) pg_setjob(S, jobs, nblkjobs);
    const LAS WJob& J = jobs[S.job];
    const int ldw = J.ldw, K = J.K;
    const int k0 = 128 * S.kb + 64 * (sub >> 2) + 8 * wid, n0 = 256 * S.nb + 64 * (sub & 3);
    const float* src = J.W + ((size_t)k0 * ldw + J.col0 + n0) + ((lane >> 4) * ldw + 4 * (lane & 15));
    __builtin_amdgcn_global_load_lds((const GAS unsigned*)src, (LAS unsigned*)ldsw, 16, 0, 0);
    __builtin_amdgcn_global_load_lds((const GAS unsigned*)(src + (size_t)4 * ldw), (LAS unsigned*)(ldsw + 1024), 16, 0, 0);
    int dn0 = n0;
    if (J.mode == 2) dn0 = n0 < DFF ? ((n0 >> 7) * 256 + (n0 & 127)) : (((n0 - DFF) >> 7) * 256 + 128 + ((n0 - DFF) & 127));
    const unsigned long long dst = (unsigned long long)(J.WT + (size_t)(J.drow0 + dn0) * K + k0), gp = J.gain ? (unsigned long long)(J.gain + k0) : 0ull;
    if (lane == 0) { stash[0] = (unsigned)dst; stash[1] = (unsigned)(dst >> 32); stash[2] = (unsigned)gp; stash[3] = (unsigned)(gp >> 32); stash[4] = (unsigned)K; }
    S.next_T += step_T; S.nb += step_T;
    while (S.nb >= S.nblk) { S.nb -= S.nblk; ++S.kb; }
    ++S.cnt;
}
typedef float f32x8s __attribute__((ext_vector_type(8)));
__device__ __forceinline__ void pg_consume(const LAS unsigned char* ldsw, const LAS unsigned* stash, int lane) {
    const unsigned d0 = stash[0], d1 = stash[1], g0_ = stash[2], g1_ = stash[3], K = stash[4];
    const unsigned long long gu = ((unsigned long long)(unsigned)__builtin_amdgcn_readfirstlane((int)g1_) << 32) | (unsigned)__builtin_amdgcn_readfirstlane((int)g0_);
    f32x8s g = {1.f, 1.f, 1.f, 1.f, 1.f, 1.f, 1.f, 1.f};
    if (gu != 0ull) asm volatile("s_load_dwordx8 %0, %1, 0x0" : "=s"(g) : "s"(gu));
    float v[8];
#pragma unroll
    for (int e = 0; e < 8; ++e) v[e] = *(const LAS float*)(ldsw + e * 256 + 4 * lane);
    asm volatile("s_waitcnt lgkmcnt(0)" : "+s"(g) :: "memory");
    v4u o; o.x = cvtpk(v[0] * g[0], v[1] * g[1]); o.y = cvtpk(v[2] * g[2], v[3] * g[3]); o.z = cvtpk(v[4] * g[4], v[5] * g[5]); o.w = cvtpk(v[6] * g[6], v[7] * g[7]);
    bf16* dst = (bf16*)(((unsigned long long)d1 << 32) | d0) + (size_t)lane * K;
    *(GAS v4u*)dst = o;
}

constexpr int MLA_KB = 64 * 384, MLA_VB = 128 * 128, MLA_V0 = 2 * MLA_KB;
template <int VAR>
__device__ __forceinline__ void mla_unit(LAS unsigned char* lds, const bf16* __restrict__ Q, const bf16* __restrict__ K, const bf16* __restrict__ VT, bf16* __restrict__ O, int b, int h, int qb, PgState& PS, const LAS WJob* jobs, int pg_step, int pg_sub) {
    const int tid = threadIdx.x, lane = tid & 63, wid = __builtin_amdgcn_readfirstlane(tid >> 6), l32 = lane & 31, hi = lane >> 5;
    const int NT = 4 * (qb + 1), rowb = b * SEQ;
    unsigned kgo[3], vgo[2];
#pragma unroll
    for (int i = 0; i < 3; ++i) { const int s_ = 64 * (3 * wid + i) + lane, row = s_ / 24, pos = s_ - 24 * row, c = (pos & ~7) | ((pos & 7) ^ ((row >> 1) & 7));
        kgo[i] = (unsigned)(((rowb + row) * QW + h * DQK + 8 * c) * 2); }
#pragma unroll
    for (int i = 0; i < 2; ++i) { const int s_ = 64 * (2 * wid + i) + lane, d = s_ >> 3, pos = s_ & 7, c = pos ^ ((d >> 1) & 7);
        vgo[i] = (unsigned)(((h * DV + d) * M + rowb + 8 * c) * 2); }
    const char* Kb = (const char*)K; const char* Vb = (const char*)VT;
    const __amdgpu_buffer_rsrc_t srdK = __builtin_amdgcn_make_buffer_rsrc((void*)Kb, (short)0, (int)((size_t)M * QW * 2), 0x00020000);
    const __amdgpu_buffer_rsrc_t srdV = __builtin_amdgcn_make_buffer_rsrc((void*)Vb, (short)0, (int)((size_t)NH * DV * M * 2), 0x00020000);
#define MLA_DMA(t_, kslot, vslot) do { \
        _Pragma("unroll") for (int i = 0; i < 3; ++i) __builtin_amdgcn_raw_ptr_buffer_load_lds(srdK, (LAS void*)(lds + (kslot) * MLA_KB + (3 * wid + i) * 1024), 16, kgo[i], (int)((unsigned)(t_) * (unsigned)(64 * QW * 2)), 0, 0); \
        _Pragma("unroll") for (int i = 0; i < 2; ++i) __builtin_amdgcn_raw_ptr_buffer_load_lds(srdV, (LAS void*)(lds + MLA_V0 + (vslot) * MLA_VB + (2 * wid + i) * 1024), 16, vgo[i], (int)((unsigned)(t_) * 128u), 0, 0); } while (0)
    MLA_DMA(0, 0, 0);
    const int qrow = rowb + 256 * qb + 32 * wid + l32;
    bf16x8 qr[12];
#pragma unroll
    for (int d0 = 0; d0 < 12; ++d0) qr[d0] = *(const GAS bf16x8*)(Q + (size_t)qrow * QW + h * DQK + 16 * d0 + 8 * hi);
    float m_run = -1e30f, lsum = 0.f;
    f32x16 o[4];
#pragma unroll
    for (int d = 0; d < 4; ++d)
#pragma unroll
        for (int r = 0; r < 16; ++r) o[d][r] = 0.f;
    int kfb[4], vfb[4];
    { const int kr = pi32(l32), fk = (kr >> 1) & 7, fv = (l32 >> 1) & 7;
#pragma unroll
      for (int j = 0; j < 4; ++j) { kfb[j] = kr * 384 + 16 * ((2 * j + hi) ^ fk); vfb[j] = l32 * 128 + 16 * ((2 * j + hi) ^ fv); } }
    const int qpos = 256 * qb + 32 * wid + l32;
    const bool halfB = wid >= 4;
    bf16x8 pb0, pb1, pb2, pb3;
#pragma unroll
    for (int e = 0; e < 8; ++e) { pb0[e] = 0; pb1[e] = 0; pb2[e] = 0; pb3[e] = 0; }
#define MLA_VLD(dst, d_) do { dst[0] = *(const LAS bf16x8*)(vp_ + vfb[0] + (d_) * 4096); dst[1] = *(const LAS bf16x8*)(vp_ + vfb[1] + (d_) * 4096); \
                              dst[2] = *(const LAS bf16x8*)(vp_ + vfb[2] + (d_) * 4096); dst[3] = *(const LAS bf16x8*)(vp_ + vfb[3] + (d_) * 4096); } while (0)
#define MLA_PVD(d_, vv) do { o[d_] = __builtin_amdgcn_mfma_f32_32x32x16_bf16(vv[0], pb0, o[d_], 0, 0, 0); o[d_] = __builtin_amdgcn_mfma_f32_32x32x16_bf16(vv[1], pb1, o[d_], 0, 0, 0); \
                             o[d_] = __builtin_amdgcn_mfma_f32_32x32x16_bf16(vv[2], pb2, o[d_], 0, 0, 0); o[d_] = __builtin_amdgcn_mfma_f32_32x32x16_bf16(vv[3], pb3, o[d_], 0, 0, 0); } while (0)
#define MLA_PV(vslot) do { const LAS unsigned char* vp_ = lds + MLA_V0 + (vslot) * MLA_VB; bf16x8 va[4], vb[4], vc[4]; \
        MLA_VLD(va, 0); MLA_VLD(vb, 1); MLA_VLD(vc, 2); __builtin_amdgcn_sched_barrier(0); MLA_PVD(0, va); __builtin_amdgcn_sched_barrier(0); \
        MLA_VLD(va, 3); __builtin_amdgcn_sched_barrier(0); MLA_PVD(1, vb); __builtin_amdgcn_sched_barrier(0); \
        MLA_PVD(2, vc); __builtin_amdgcn_sched_barrier(0); MLA_PVD(3, va); __builtin_amdgcn_sched_barrier(0); } while (0)
    __syncthreads();
    int vs = 0;
#pragma unroll 2
    for (int t = 0; t < NT; ++t) {
        const int bs = t & 1; const bool more = (t + 1) < NT;
        const int vs_prev = (vs == 0) ? 2 : vs - 1, vs_next = (vs == 2) ? 0 : vs + 1;
        if (more && (halfB || !((VAR != 2) && (64 * t <= 256 * qb + 32 * wid + 31))) && VAR != 1 && VAR != 3 && VAR != 4) MLA_DMA(t + 1, bs ^ 1, vs_next);
        bool pg_st = false, pg_is = false;
        if (VAR == 0 && PIGGY) {
            const int slot = PS.cnt & 1;
            LAS unsigned char* ldsw = lds + PG_LDS + slot * 16384 + wid * 2048;
            LAS unsigned* stash = (LAS unsigned*)(lds + PG_STASH + wid * 64 + slot * 32);
            if (slot == 0 ? PS.pend0 : PS.pend1) { pg_consume(ldsw, stash, lane); pg_st = true; if (slot == 0) PS.pend0 = false; else PS.pend1 = false; }
            if (PS.next_T < PS.end_T) { pg_issue(PS, pg_step, pg_sub, jobs, NJOBS - 1, ldsw, stash, wid, lane); pg_is = true; if (slot == 0) PS.pend0 = true; else PS.pend1 = true; }
        }
        const bool active = (VAR != 2) && (64 * t <= 256 * qb + 32 * wid + 31);
        if (VAR != 2 && halfB && t > 0 && (64 * (t - 1) <= 256 * qb + 32 * wid + 31)) MLA_PV(vs_prev);
        if (active) {
            const LAS unsigned char* kp = lds + bs * MLA_KB;
            f32x16 p0, p1;
#pragma unroll
            for (int r = 0; r < 16; ++r) { p0[r] = 0.f; p1[r] = 0.f; }
            {
                bf16x8 ka[4], kc[4];
#define MLA_KLD(d0_, slot_) do { ka[slot_] = *(const LAS bf16x8*)(kp + kfb[(d0_) & 3] + 128 * ((d0_) >> 2)); kc[slot_] = *(const LAS bf16x8*)(kp + kfb[(d0_) & 3] + 128 * ((d0_) >> 2) + 32 * 384); } while (0)
                MLA_KLD(0, 0); MLA_KLD(1, 1); MLA_KLD(2, 2);
                __builtin_amdgcn_sched_barrier(0);
#pragma unroll
                for (int d0 = 0; d0 < 12; ++d0) {
                    if (d0 + 3 < 12) MLA_KLD(d0 + 3, (d0 + 3) & 3);
                    __builtin_amdgcn_sched_barrier(0);
                    p0 = __builtin_amdgcn_mfma_f32_32x32x16_bf16(ka[d0 & 3], qr[d0], p0, 0, 0, 0);
                    p1 = __builtin_amdgcn_mfma_f32_32x32x16_bf16(kc[d0 & 3], qr[d0], p1, 0, 0, 0);
                    __builtin_amdgcn_sched_barrier(0);
                }
#undef MLA_KLD
            }
            if (more && !halfB && VAR != 1 && VAR != 3 && VAR != 4) MLA_DMA(t + 1, bs ^ 1, vs_next);
            if (VAR != 3 && VAR != 4) {
            if (64 * t + 63 > 256 * qb + 32 * wid) {
                const int kb0 = 64 * t + 8 * hi;
#pragma unroll
                for (int r = 0; r < 16; ++r) { const int key = kb0 + 16 * (r >> 3) + (r & 7);
                    if (key > qpos) p0[r] = -__builtin_inff(); if (key + 32 > qpos) p1[r] = -__builtin_inff(); }
            }
            float mx = p0[0];
#pragma unroll
            for (int r = 1; r < 16; ++r) mx = fmaxf(mx, p0[r]);
#pragma unroll
            for (int r = 0; r < 16; ++r) mx = fmaxf(mx, p1[r]);
            mx = fmaxf(mx, __shfl_xor(mx, 32));
            if (__any(mx > m_run + 8.0f)) {
                const float m_new = fmaxf(m_run, mx), alpha = __builtin_amdgcn_exp2f(m_run - m_new);
                m_run = m_new; lsum *= alpha;
#pragma unroll
                for (int d = 0; d < 4; ++d)
#pragma unroll
                    for (int r = 0; r < 16; ++r) o[d][r] *= alpha;
            }
            float ps = 0.f, ps1 = 0.f;
#pragma unroll
            for (int r = 0; r < 16; ++r) { p0[r] = __builtin_amdgcn_exp2f(p0[r] - m_run); p1[r] = __builtin_amdgcn_exp2f(p1[r] - m_run);
                asm("v_add_f32 %0, %0, %1" : "+v"(ps) : "v"(p0[r])); asm("v_add_f32 %0, %0, %1" : "+v"(ps1) : "v"(p1[r])); }
            lsum += ps + ps1;
            }
            pb0 = PACK8(p0, 0); pb1 = PACK8(p0, 8); pb2 = PACK8(p1, 0); pb3 = PACK8(p1, 8);
            if (!halfB) MLA_PV(vs);
        }
        if (VAR != 0 || !PIGGY || (!pg_st && !pg_is)) __syncthreads();
        else if (pg_st && pg_is) asm volatile("s_waitcnt vmcnt(3) lgkmcnt(0)\n\ts_barrier" ::: "memory");
        else if (pg_is)          asm volatile("s_waitcnt vmcnt(2) lgkmcnt(0)\n\ts_barrier" ::: "memory");
        else                     asm volatile("s_waitcnt vmcnt(1) lgkmcnt(0)\n\ts_barrier" ::: "memory");
        vs = vs_next;
    }
    if (VAR != 2 && halfB && (64 * (NT - 1) <= 256 * qb + 32 * wid + 31)) MLA_PV((vs == 0) ? 2 : vs - 1);
    __syncthreads();
#undef MLA_PV
#undef MLA_PVD
#undef MLA_VLD
#undef MLA_DMA
    const float ltot = lsum + __shfl_xor(lsum, 32);
    const float inv = 1.0f / ltot;
    bf16* orow = O + (size_t)qrow * DM + h * DV + 8 * hi;
#pragma unroll
    for (int d = 0; d < 4; ++d)
#pragma unroll
        for (int j = 0; j < 2; ++j) {
            const unsigned e0 = cvtpk(o[d][8 * j] * inv, o[d][8 * j + 1] * inv), e1 = cvtpk(o[d][8 * j + 2] * inv, o[d][8 * j + 3] * inv);
            const unsigned q0 = cvtpk(o[d][8 * j + 4] * inv, o[d][8 * j + 5] * inv), q1 = cvtpk(o[d][8 * j + 6] * inv, o[d][8 * j + 7] * inv);
            const auto s0 = __builtin_amdgcn_permlane32_swap(e0, q0, false, false), s1 = __builtin_amdgcn_permlane32_swap(e1, q1, false, false);
            v4u w; w.x = s0[0]; w.y = s1[0]; w.z = s0[1]; w.w = s1[1];
            *(GAS v4u*)(orow + 32 * d + 16 * j) = w; }
}
template <int VAR>
__device__ __forceinline__ void mla_attn_phase(const Ctx& F, const bf16* Q, const bf16* K, const bf16* VT, bf16* O, const LAS WJob* jobs, int pg_lo, int pg_hi) {
    PgState PS;
    const int pg_step = F.G >> 3, pg_sub = F.vcu & 7;
    PS.next_T = pg_lo + (F.vcu >> 3); PS.end_T = (VAR == 0 && PIGGY) ? pg_hi : 0; PS.job = 0; PS.job_end = 0; PS.kb = 0; PS.nb = 0; PS.nblk = 1; PS.cnt = 0; PS.pend0 = false; PS.pend1 = false;
    for (int L = F.vcu; L < BATCH * NH * 8; L += F.G) {
        const int bh = L >> 3, p = L & 7;
        mla_unit<VAR>(F.lds, Q, K, VT, O, bh / NH, bh % NH, 15 - p, PS, jobs, pg_step, pg_sub);
        mla_unit<VAR>(F.lds, Q, K, VT, O, bh / NH, bh % NH, p, PS, jobs, pg_step, pg_sub);
    }
    if (VAR == 0 && PIGGY) {
        asm volatile("s_waitcnt vmcnt(0)" ::: "memory");
        if (PS.pend0) { pg_consume(F.lds + PG_LDS + F.wave * 2048, (const LAS unsigned*)(F.lds + PG_STASH + F.wave * 64), F.lane); PS.pend0 = false; }
        if (PS.pend1) { pg_consume(F.lds + PG_LDS + 16384 + F.wave * 2048, (const LAS unsigned*)(F.lds + PG_STASH + F.wave * 64 + 32), F.lane); PS.pend1 = false; }
        while (PS.next_T < PS.end_T) { LAS unsigned char* ldsw = F.lds + PG_LDS + F.wave * 2048; LAS unsigned* stash = (LAS unsigned*)(F.lds + PG_STASH + F.wave * 64);
            pg_issue(PS, pg_step, pg_sub, jobs, NJOBS - 1, ldsw, stash, F.wave, F.lane); asm volatile("s_waitcnt vmcnt(0)" ::: "memory"); pg_consume(ldsw, stash, F.lane); }
    }
}

constexpr int SWA_KBYTES = 256 * 144, SWA_VROW = 528;
struct SwaStage { v4u k[4], v[4]; };
__device__ __forceinline__ void swa_load(SwaStage& S, const bf16* __restrict__ QK, int b, int g, int n) {
    const int tid = threadIdx.x, kv0 = b * SEQ + WIN * (n - 1);
#pragma unroll
    for (int i = 0; i < 4; ++i) { const int idx = tid + 512 * i, kk = idx >> 3, c = idx & 7; S.k[i] = (v4u){0u, 0u, 0u, 0u}; S.v[i] = (v4u){0u, 0u, 0u, 0u};
        if (n > 0 || kk >= WIN) { S.k[i] = *(const GAS v4u*)(QK + (size_t)(kv0 + kk) * QK1W + 4096 + g * SWD + 8 * c); S.v[i] = *(const GAS v4u*)(QK + (size_t)(kv0 + kk) * QK1W + 4608 + g * SWD + 8 * c); } }
}
__device__ __forceinline__ void swa_store(const SwaStage& S, LAS unsigned char* lds) {
    const int tid = threadIdx.x;
#pragma unroll
    for (int i = 0; i < 4; ++i) { const int idx = tid + 512 * i, kk = idx >> 3, c = idx & 7;
        *(LAS v4u*)(lds + kk * 144 + 16 * c) = S.k[i];
        const v4u v = S.v[i];
        LAS unsigned short* vt = (LAS unsigned short*)(lds + SWA_KBYTES + (8 * c) * SWA_VROW + 2 * kk);
        vt[0 * (SWA_VROW / 2)] = (unsigned short)(v.x & 0xffffu); vt[1 * (SWA_VROW / 2)] = (unsigned short)(v.x >> 16); vt[2 * (SWA_VROW / 2)] = (unsigned short)(v.y & 0xffffu); vt[3 * (SWA_VROW / 2)] = (unsigned short)(v.y >> 16);
        vt[4 * (SWA_VROW / 2)] = (unsigned short)(v.z & 0xffffu); vt[5 * (SWA_VROW / 2)] = (unsigned short)(v.z >> 16); vt[6 * (SWA_VROW / 2)] = (unsigned short)(v.w & 0xffffu); vt[7 * (SWA_VROW / 2)] = (unsigned short)(v.w >> 16); }
}
__device__ __forceinline__ void swa_compute(LAS unsigned char* lds, const bf16* __restrict__ QK, bf16* __restrict__ O, const float* __restrict__ sinks, int b, int g, int n) {
    const int tid = threadIdx.x, lane = tid & 63, wid = __builtin_amdgcn_readfirstlane(tid >> 6), l32 = lane & 31, hi = lane >> 5;
    const int rowb = b * SEQ;
    const int hh = SWKV * g + wid;
    const float slope2 = exp2f(-(float)(hh + 1) * 0.125f) * LOG2E, sink2 = sinks[hh] * LOG2E;
#pragma unroll 1
    for (int jj = 0; jj < 2; ++jj) {
        bf16x8 qr[2][4];
#pragma unroll
        for (int u = 0; u < 2; ++u)
#pragma unroll
            for (int d0 = 0; d0 < 4; ++d0) qr[u][d0] = *(const GAS bf16x8*)(QK + (size_t)(rowb + WIN * n + 32 * jj + 64 * u + l32) * QK1W + hh * SWD + 16 * d0 + 8 * hi);
        const int qd = WIN + l32 - 8 * hi;
        float m_run[2] = {sink2, sink2}, lsum[2] = {0.f, 0.f};
        f32x16 o[2][2];
#pragma unroll
        for (int u = 0; u < 2; ++u)
#pragma unroll
            for (int d = 0; d < 2; ++d)
#pragma unroll
                for (int r = 0; r < 16; ++r) o[u][d][r] = 0.f;
#pragma unroll 1
        for (int i = 0; i < 5; ++i) {
#pragma unroll
            for (int u = 0; u < 2; ++u) {
                const int j = jj + 2 * u;
                const LAS unsigned char* kp = lds + (32 * j + pi32(l32)) * 144 + 16 * hi;
                const LAS unsigned char* vp = lds + SWA_KBYTES + l32 * SWA_VROW + 64 * j + 16 * hi;
                f32x16 p;
#pragma unroll
                for (int r = 0; r < 16; ++r) p[r] = 0.f;
#pragma unroll
                for (int d0 = 0; d0 < 4; ++d0) p = __builtin_amdgcn_mfma_f32_32x32x16_bf16(*(const LAS bf16x8*)(kp + i * 32 * 144 + 32 * d0), qr[u][d0], p, 0, 0, 0);
                float mx = -__builtin_inff();
#pragma unroll
                for (int r = 0; r < 16; ++r) { const int dist = qd - 32 * i - 16 * (r >> 3) - (r & 7), kk = 32 * (j + i) + 16 * (r >> 3) + 8 * hi + (r & 7);
                    const bool valid = ((unsigned)dist < (unsigned)WIN) && (n > 0 || kk >= WIN);
                    const float sc = valid ? p[r] - slope2 * (float)dist : -__builtin_inff(); p[r] = sc; mx = fmaxf(mx, sc); }
                mx = fmaxf(mx, __shfl_xor(mx, 32));
                const float m_new = fmaxf(m_run[u], mx), alpha = __builtin_amdgcn_exp2f(m_run[u] - m_new);
                m_run[u] = m_new;
                float ps = 0.f;
#pragma unroll
                for (int r = 0; r < 16; ++r) { p[r] = __builtin_amdgcn_exp2f(p[r] - m_new); ps += p[r]; }
                lsum[u] = lsum[u] * alpha + ps;
#pragma unroll
                for (int d = 0; d < 2; ++d)
#pragma unroll
                    for (int r = 0; r < 16; ++r) o[u][d][r] *= alpha;
                const bf16x8 pa = PACK8(p, 0), pb = PACK8(p, 8);
#pragma unroll
                for (int d = 0; d < 2; ++d) {
                    o[u][d] = __builtin_amdgcn_mfma_f32_32x32x16_bf16(*(const LAS bf16x8*)(vp + d * 32 * SWA_VROW + 64 * i), pa, o[u][d], 0, 0, 0);
                    o[u][d] = __builtin_amdgcn_mfma_f32_32x32x16_bf16(*(const LAS bf16x8*)(vp + d * 32 * SWA_VROW + 64 * i + 32), pb, o[u][d], 0, 0, 0);
                }
            }
        }
#pragma unroll
        for (int u = 0; u < 2; ++u) {
            const int j = jj + 2 * u; const int qrow = rowb + WIN * n + 32 * j + l32;
            float ls = lsum[u] + __shfl_xor(lsum[u], 32);
            ls += __builtin_amdgcn_exp2f(sink2 - m_run[u]);
            const float inv = 1.0f / ls;
            bf16* orow = O + (size_t)qrow * DM + hh * SWD + 8 * hi;
#pragma unroll
            for (int d = 0; d < 2; ++d)
#pragma unroll
                for (int j2 = 0; j2 < 2; ++j2) {
                    const unsigned e0 = cvtpk(o[u][d][8 * j2] * inv, o[u][d][8 * j2 + 1] * inv), e1 = cvtpk(o[u][d][8 * j2 + 2] * inv, o[u][d][8 * j2 + 3] * inv);
                    const unsigned q0 = cvtpk(o[u][d][8 * j2 + 4] * inv, o[u][d][8 * j2 + 5] * inv), q1 = cvtpk(o[u][d][8 * j2 + 6] * inv, o[u][d][8 * j2 + 7] * inv);
                    const auto s0 = __builtin_amdgcn_permlane32_swap(e0, q0, false, false), s1 = __builtin_amdgcn_permlane32_swap(e1, q1, false, false);
                    v4u w; w.x = s0[0]; w.y = s1[0]; w.z = s0[1]; w.w = s1[1];
                    *(GAS v4u*)(orow + 32 * d + 16 * j2) = w; }
        }
    }
}
__device__ __forceinline__ void swa_attn_phase(const Ctx& F, const bf16* QK, bf16* O, const float* sinks) {
    constexpr int NB = SEQ / WIN, NU = BATCH * SWKV * NB;
    int L = F.vcu;
    if (L >= NU) return;
    SwaStage S;
    swa_load(S, QK, (L / NB) / SWKV, (L / NB) % SWKV, L % NB);
    swa_store(S, F.lds);
    __syncthreads();
    for (;;) {
        const int Ln = L + F.G; const bool more = Ln < NU;
        if (more) swa_load(S, QK, (Ln / NB) / SWKV, (Ln / NB) % SWKV, Ln % NB);
        swa_compute(F.lds, QK, O, sinks, (L / NB) / SWKV, (L / NB) % SWKV, L % NB);
        if (!more) break;
        __syncthreads();
        swa_store(S, F.lds);
        __syncthreads();
        L = Ln;
    }
    __syncthreads();
}

struct Args { const float* in[23]; float* out; unsigned char* ws; WJob jobs[NJOBS]; int nitems, ntiles, ph_lo, ph_hi; int qb[8]; };
constexpr int NPHASE = 20;

__global__ void __launch_bounds__(NWAVES * 64, 2) yoco_fwd(Args args) {
    extern __shared__ __attribute__((aligned(16))) unsigned char lds_raw[];
    Ctx F;
    F.lds = (LAS unsigned char*)lds_raw;
    volatile LAS unsigned* MISC = (volatile LAS unsigned*)(F.lds + MISC_OFF);
    F.tid = threadIdx.x; F.lane = F.tid & 63; F.wave = __builtin_amdgcn_readfirstlane(F.tid >> 6);
    F.G = gridDim.x; { const int bx = blockIdx.x; F.vcu = (F.G % 8 == 0) ? (bx % 8) * (F.G / 8) + bx / 8 : bx; }
    unsigned char* ws = args.ws;
    gu32* ctl = (gu32*)(ws + WS_CTL);
    for (int u = F.tid; u < (LDS_BYTES - LDSCTL_OFF) / 4; u += NWAVES * 64) ((LAS unsigned*)(F.lds + LDSCTL_OFF))[u] = 0u;
    __syncthreads();
    const LAS WJob* ljobs = (const LAS WJob*)(F.lds + JOBS_OFF);
    if (F.tid == 0) {
#pragma unroll
        for (int q = 0; q < NJOBS; ++q) { LAS WJob* d = (LAS WJob*)(F.lds + JOBS_OFF) + q; d->W = args.jobs[q].W; d->gain = args.jobs[q].gain; d->WT = args.jobs[q].WT; d->ldw = args.jobs[q].ldw; d->K = args.jobs[q].K;
            d->ncols = args.jobs[q].ncols; d->col0 = args.jobs[q].col0; d->gs = args.jobs[q].gs; d->gsrc = args.jobs[q].gsrc; d->drow0 = args.jobs[q].drow0; d->item0 = args.jobs[q].item0; d->mode = args.jobs[q].mode; d->pad = 0; }
    }
    __syncthreads();
    XcdBarrier bar = xcd_barrier_post((unsigned*)(ctl + CW_BAR), MISC + 8);
    const int lo = args.ph_lo, hi = args.ph_hi;
#ifndef PH_MASK
#define PH_MASK 0xFFFFFu
#endif
#define IN(k) ((((PH_MASK) >> (k)) & 1u) && lo <= (k) && (k) < hi)
#define SEAM(k) do { if (IN(k) && IN((k) + 1)) xcd_barrier(bar); } while (0)
#ifndef DUP_MASK
#define DUP_MASK 0u
#endif
#define REPS(k) ((((DUP_MASK) >> (k)) & 1u) ? 2 : 1)

    const float* x = args.in[0]; const int* pos = (const int*)args.in[1];
    const float* n_mix_post = args.in[3]; const float* n_ffn_post = args.in[5];
    const float* sinks = args.in[17]; const float* conv_w = args.in[20]; const float* conv_b = args.in[21];
    float* H = args.out;
    float* CS = (float*)(ws + WS_CS); float* RS = (float*)(ws + WS_RS);
    bf16* W1T = (bf16*)(ws + WS_W1T); bf16* WUQT = (bf16*)(ws + WS_WUQT); bf16* WKNT = (bf16*)(ws + WS_WKNT); bf16* WVT = (bf16*)(ws + WS_WVT);
    bf16* WO0T = (bf16*)(ws + WS_WO0T); bf16* WIN0T = (bf16*)(ws + WS_WIN0T); bf16* WOUT0T = (bf16*)(ws + WS_WOUT0T);
    bf16* WQK1T = (bf16*)(ws + WS_WQK1T); bf16* WV1T = (bf16*)(ws + WS_WV1T); bf16* WO1T = (bf16*)(ws + WS_WO1T); bf16* WIN1T = (bf16*)(ws + WS_WIN1T); bf16* WOUT1T = (bf16*)(ws + WS_WOUT1T);
    bf16* XN = (bf16*)(ws + WS_XN); float* CQKV = (float*)(ws + WS_CQKV); bf16* CQN = (bf16*)(ws + WS_CQN); bf16* CKV = (bf16*)(ws + WS_CKV);
    float* QF = (float*)(ws + WS_QF); bf16* Q = (bf16*)(ws + WS_Q); bf16* K = (bf16*)(ws + WS_K); bf16* VT = (bf16*)(ws + WS_VT); bf16* O = (bf16*)(ws + WS_O);
    bf16* AF = (bf16*)(ws + WS_AF); float* PART = (float*)(ws + WS_U); float* HALO = PART + (size_t)(M / 64) * 4 * DFF; bf16* ACT = (bf16*)(ws + WS_ACT); bf16* QK1 = (bf16*)(ws + WS_QK1); bf16* VT1 = (bf16*)(ws + WS_VT1);
    LAS unsigned char* ring = F.lds + RING_OFF;
    const int cid = (int)blockIdx.x;
    const int xcd_ = cid & 7;
    const int K0_IN = K0IN_ON ? (xcd_ >> 1) * 16 : 0;
    const int K0_OUT = 0;
#define GEMM_F32(Ap, Bp, Mv, Nv, Kv, Cp, ldcv, rsv) do { pg8::Gemm g_{(const pg8::bf16_t*)(Ap), (const pg8::bf16_t*)(Bp), (Mv), (Nv), (Kv), XTILED, WTILED, ZIG_DEF, 0}; pg8::StaticOrder S_; S_.init((Mv), (Nv), F.G, cid); \
        pg8::EpiF32 E_{(Cp), (ldcv), (rsv)}; pg8::gemm_phase<pg8::EpiF32, pg8::StaticOrder, true, true>(ring, g_, S_, E_); } while (0)
#define GEMM_BF16(Ap, Bp, Mv, Nv, Kv, Op, ldcv, gsv, gstv, scv, s0v, rsv) GEMM_BF16T(Ap, Bp, Mv, Nv, Kv, Op, ldcv, gsv, gstv, scv, s0v, rsv, 0)
#define GEMM_BF16T(Ap, Bp, Mv, Nv, Kv, Op, ldcv, gsv, gstv, scv, s0v, rsv, tAv) do { pg8::Gemm g_{(const pg8::bf16_t*)(Ap), (const pg8::bf16_t*)(Bp), (Mv), (Nv), (Kv), (tAv), WTILED, (((const void*)(Ap) == (const void*)ACT) ? ZIG_OUT : ZIG_DEF), 0}; pg8::StaticOrder S_; S_.init((Mv), (Nv), F.G, cid); \
        pg8::EpiBf16Map E_{(pg8::bf16_t*)(Op), (ldcv), (gsv), (gstv), (scv), (s0v), (rsv)}; pg8::gemm_phase<pg8::EpiBf16Map, pg8::StaticOrder, true, true>(ring, g_, S_, E_); } while (0)

#define GEMM_BF16_HM(Ap, Bp, Mv, Nv, Kv, Op, ldcv) do { pg8::Gemm g_{(const pg8::bf16_t*)(Ap), (const pg8::bf16_t*)(Bp), (Mv), (Nv), (Kv), 0, WTILED, ZIG_DEF, 0}; pg8::HalfMOrder S_; S_.init((Mv), (Nv), F.G, cid, F.vcu); \
        pg8::EpiBf16Map E_{(pg8::bf16_t*)(Op), (ldcv), 1 << 30, 0, 0, 1.f, nullptr}; pg8::gemm_phase<pg8::EpiBf16Map, pg8::HalfMOrder, true, true>(ring, g_, S_, E_); } while (0)
#define GEMM_CONV(Ap, Bp, cwp, cbp) do { pg8::Gemm g_{(const pg8::bf16_t*)(Ap), (const pg8::bf16_t*)(Bp), M, DFF2, DM, XTILED, WTILED, ZIG_DEF, K0_IN}; pg8::StaticOrder S_; S_.init(M, DFF2, F.G, cid, FLIP_IN); \
        pg8::EpiConvAct E_{(pg8::bf16_t*)ACT, PART, HALO, (cwp), (cbp), RS}; pg8::gemm_phase<pg8::EpiConvAct, pg8::StaticOrder, true, true>(ring, g_, S_, E_); } while (0)
#define TAIL_CONVERT(nwg, q) do { const int rem_ = (nwg) % F.G; if (rem_ == 0 || cid >= rem_) wt_block_phase(F, ljobs, NJOBS - 1, args.qb[q], args.qb[(q) + 1], rem_ == 0 ? cid : cid - rem_, rem_ == 0 ? F.G : F.G - rem_); } while (0)
    if (IN(0)) for (int rep_ = 0; rep_ < REPS(0); ++rep_) { if (rep_) xcd_barrier(bar);
        LAS float* scr = (LAS float*)(ring + F.wave * 16384);
        const int gw = F.vcu * NWAVES + F.wave, NGW = F.G * NWAVES;
        wt_block_phase(F, ljobs, NJOBS - 1, args.qb[0], args.qb[1], F.vcu, F.G, args.qb[6], args.qb[7] - args.qb[6]);
        { const WJob& J = args.jobs[NJOBS - 1];
          for (int it = gw; it < args.nitems; it += NGW) wt_item(J.W, J.gain, J.WT, J.ldw, J.K, J.ncols, J.col0, J.gs, J.gsrc, J.drow0, scr, it, F.lane); }
        { const int gt = F.vcu * (NWAVES * 64) + F.tid, NT = F.G * NWAVES * 64;
          for (int idx = gt; idx < M * 32; idx += NT) { const int m = idx >> 5, i = idx & 31; float s, c; sincos_d((float)pos[m] * kFreq[i], s, c); CS[(size_t)m * 64 + i] = c; CS[(size_t)m * 64 + 32 + i] = s; } }
        rows_phase<0, true>(F, x, nullptr, nullptr, nullptr, XN, RS);
    }
#if defined(DUP_P0)
    { xcd_barrier(bar);
        LAS float* scr = (LAS float*)(ring + F.wave * 16384);
        const int gw = F.vcu * NWAVES + F.wave, NGW = F.G * NWAVES;
        wt_block_phase(F, ljobs, NJOBS - 1, args.qb[0], args.qb[1], F.vcu, F.G);
        { const WJob& J = args.jobs[NJOBS - 1];
          for (int it = gw; it < args.nitems; it += NGW) wt_item(J.W, J.gain, J.WT, J.ldw, J.K, J.ncols, J.col0, J.gs, J.gsrc, J.drow0, scr, it, F.lane); }
        { const int gt = F.vcu * (NWAVES * 64) + F.tid, NT = F.G * NWAVES * 64;
          for (int idx = gt; idx < M * 32; idx += NT) { const int m = idx >> 5, i = idx & 31; float s, c; sincos_d((float)pos[m] * kFreq[i], s, c); CS[(size_t)m * 64 + i] = c; CS[(size_t)m * 64 + 32 + i] = s; } }
        rows_phase<0, true>(F, x, nullptr, nullptr, nullptr, XN, RS);
    }
#endif
#if defined(DUP_P0W)
    { xcd_barrier(bar); wt_block_phase(F, ljobs, NJOBS - 1, args.qb[0], args.qb[1], F.vcu, F.G, args.qb[6], args.qb[7] - args.qb[6]); }
#endif
    SEAM(0);
    if (IN(1)) for (int rep_ = 0; rep_ < REPS(1); ++rep_) { if (rep_) xcd_barrier(bar); GEMM_F32(XN, W1T, M, N1, DM, CQKV, N1, RS); TAIL_CONVERT((M / 256) * (N1 / 256), 1); }
    SEAM(1);
    if (IN(2)) for (int rep_ = 0; rep_ < REPS(2); ++rep_) { if (rep_) xcd_barrier(bar); latent_rows_phase(F, CQKV, CS, CQN, CKV, K); }
    SEAM(2);
    if (IN(3)) for (int rep_ = 0; rep_ < REPS(3); ++rep_) { if (rep_) xcd_barrier(bar);
        { pg8::Gemm g_{(const pg8::bf16_t*)CQN, (const pg8::bf16_t*)WUQT, M, QW, QLORA, 0, WTILED, ZIG_DEF, 0}; pg8::StaticOrder S_; S_.init(M, QW, F.G, cid);
          pg8::EpiQRope E_{(pg8::bf16_t*)Q, CS, QS0}; pg8::gemm_phase<pg8::EpiQRope, pg8::StaticOrder, true, true>(ring, g_, S_, E_); }
        GEMM_BF16(CKV, WKNT, M, 4096, KVLORA, K, QW, DNOPE, DQK, 0, 1.f, nullptr);
        { pg8::Gemm g_{(const pg8::bf16_t*)WVT, (const pg8::bf16_t*)CKV, 4096, M, KVLORA, WTILED, 0, ZIG_DEF, 0}; pg8::StaticOrder S_; S_.init(4096, M, F.G, cid);
          pg8::EpiBf16Map E_{(pg8::bf16_t*)VT, M, 1 << 30, 0, 0, 1.f, nullptr}; pg8::gemm_phase<pg8::EpiBf16Map, pg8::StaticOrder, true, true>(ring, g_, S_, E_); }
    }
#if defined(DUP_P3)
    { xcd_barrier(bar);
        { pg8::Gemm g_{(const pg8::bf16_t*)CQN, (const pg8::bf16_t*)WUQT, M, QW, QLORA, 0, WTILED, ZIG_DEF, 0}; pg8::StaticOrder S_; S_.init(M, QW, F.G, cid);
          pg8::EpiQRope E_{(pg8::bf16_t*)Q, CS, QS0}; pg8::gemm_phase<pg8::EpiQRope, pg8::StaticOrder, true, true>(ring, g_, S_, E_); }
        GEMM_BF16(CKV, WKNT, M, 4096, KVLORA, K, QW, DNOPE, DQK, 0, 1.f, nullptr);
        { pg8::Gemm g_{(const pg8::bf16_t*)WVT, (const pg8::bf16_t*)CKV, 4096, M, KVLORA, WTILED, 0, ZIG_DEF, 0}; pg8::StaticOrder S_; S_.init(4096, M, F.G, cid);
          pg8::EpiBf16Map E_{(pg8::bf16_t*)VT, M, 1 << 30, 0, 0, 1.f, nullptr}; pg8::gemm_phase<pg8::EpiBf16Map, pg8::StaticOrder, true, true>(ring, g_, S_, E_); }
    }
#endif
    SEAM(3);
    if (IN(5)) for (int rep_ = 0; rep_ < REPS(5); ++rep_) { if (rep_) xcd_barrier(bar); mla_attn_phase<0>(F, Q, K, VT, O, ljobs, args.qb[6], args.qb[7]); }
#if defined(DUP_P5V1)
    xcd_barrier(bar); mla_attn_phase<1>(F, Q, K, VT, (bf16*)(ws + WS_QF), ljobs, 0, 0);
#endif
#if defined(DUP_P5V4)
    xcd_barrier(bar); mla_attn_phase<4>(F, Q, K, VT, (bf16*)(ws + WS_QF), ljobs, 0, 0);
#endif
#if defined(DUP_P5V3)
    xcd_barrier(bar); mla_attn_phase<3>(F, Q, K, VT, (bf16*)(ws + WS_QF), ljobs, 0, 0);
#endif
#if defined(DUP_P5V2)
    xcd_barrier(bar); mla_attn_phase<2>(F, Q, K, VT, (bf16*)(ws + WS_QF), ljobs, 0, 0);
#endif
    SEAM(5);
    if (IN(6)) for (int rep_ = 0; rep_ < REPS(6); ++rep_) { if (rep_) xcd_barrier(bar); GEMM_BF16(O, WO0T, M, DM, DM, AF, DM, 1 << 30, 0, 0, 1.f, nullptr); }
    SEAM(6);
    if (IN(7)) for (int rep_ = 0; rep_ < REPS(7); ++rep_) { if (rep_) xcd_barrier(bar); rows_phase<1, false>(F, AF, XN, n_mix_post, nullptr, XN, RS);     }
    SEAM(7);
    if (IN(8)) for (int rep_ = 0; rep_ < REPS(8); ++rep_) { if (rep_) xcd_barrier(bar); GEMM_CONV(XN, WIN0T, conv_w, conv_b); TAIL_CONVERT((M / 256) * (DFF2 / 256), 2); }
#if defined(DUP_P8)
    xcd_barrier(bar); GEMM_CONV(XN, WIN0T, conv_w, conv_b);
#endif
#if defined(DUP_P8ZERO)
    xcd_barrier(bar); { pg8::Gemm g_{(const pg8::bf16_t*)XN, (const pg8::bf16_t*)WIN0T, M, DFF2, DM, 0, WTILED, ZIG_DEF, 0}; pg8::ZeroOrder S_; S_.init(M, DFF2, F.G, cid);
        pg8::EpiNull E_{(float*)(ws + WS_QF)}; pg8::gemm_phase<pg8::EpiNull, pg8::ZeroOrder, true, true>(ring, g_, S_, E_); }
#endif
#if defined(DUP_P8SHORT)
    xcd_barrier(bar); { pg8::Gemm g_{(const pg8::bf16_t*)XN, (const pg8::bf16_t*)WIN0T, M, 44032, 2048, 0, WTILED, ZIG_DEF, 0}; pg8::ZeroOrder S_; S_.init(M, 44032, F.G, cid);
        pg8::EpiNull E_{(float*)(ws + WS_QF)}; pg8::gemm_phase<pg8::EpiNull, pg8::ZeroOrder, true, true>(ring, g_, S_, E_); }
#endif
#if defined(DUP_P8NULL)
    xcd_barrier(bar); { pg8::Gemm g_{(const pg8::bf16_t*)XN, (const pg8::bf16_t*)WIN0T, M, DFF2, DM, 0, WTILED, ZIG_DEF, 0}; pg8::StaticOrder S_; S_.init(M, DFF2, F.G, cid);
        pg8::EpiNull E_{(float*)(ws + WS_QF)}; pg8::gemm_phase<pg8::EpiNull, pg8::StaticOrder, true, true>(ring, g_, S_, E_); }
#endif
#if defined(DUP_P10)
    xcd_barrier(bar); xcd_barrier(bar);
#endif
#if defined(BAR20)
    for (int q_ = 0; q_ < 20; ++q_) xcd_barrier(bar);
#endif
    SEAM(8);
    if (IN(9)) for (int rep_ = 0; rep_ < REPS(9); ++rep_) { if (rep_) xcd_barrier(bar); conv_fix_phase(F, PART, HALO, conv_w, conv_b, ACT); }
    SEAM(9);
    if (IN(10)) for (int rep_ = 0; rep_ < REPS(10); ++rep_) { if (rep_) xcd_barrier(bar); GEMM_BF16T(ACT, WOUT0T, M, DM, DFF, AF, DM, 1 << 30, 0, 0, 1.f, nullptr, pg8::EpiConvAct::ATILED); }
#if defined(DUP_P10ZERO)
    xcd_barrier(bar); { pg8::Gemm g_{(const pg8::bf16_t*)ACT, (const pg8::bf16_t*)WOUT0T, M, DM, DFF, pg8::EpiConvAct::ATILED, WTILED, ZIG_DEF, 0}; pg8::ZeroOrder S_; S_.init(M, DM, F.G, cid);
        pg8::EpiNull E_{(float*)(ws + WS_QF)}; pg8::gemm_phase<pg8::EpiNull, pg8::ZeroOrder, true, true>(ring, g_, S_, E_); }
#endif
#if defined(DUP_P10HM)
    xcd_barrier(bar); { pg8::Gemm g_{(const pg8::bf16_t*)ACT, (const pg8::bf16_t*)WOUT0T, M, DM, DFF, pg8::EpiConvAct::ATILED, WTILED, ZIG_DEF, 0}; pg8::HalfMOrder S_; S_.init(M, DM, F.G, cid, F.vcu);
        pg8::EpiNull E_{(float*)(ws + WS_QF)}; pg8::gemm_phase<pg8::EpiNull, pg8::HalfMOrder, true, true>(ring, g_, S_, E_); }
#endif
#if defined(DUP_P10ZA)
    xcd_barrier(bar); { pg8::Gemm g_{(const pg8::bf16_t*)ACT, (const pg8::bf16_t*)WOUT0T, M, DM, DFF, pg8::EpiConvAct::ATILED, WTILED, ZIG_DEF, 0}; pg8::ZeroAOrder S_; S_.init(M, DM, F.G, cid);
        pg8::EpiNull E_{(float*)(ws + WS_QF)}; pg8::gemm_phase<pg8::EpiNull, pg8::ZeroAOrder, true, true>(ring, g_, S_, E_); }
#endif
#if defined(DUP_P10ZB)
    xcd_barrier(bar); { pg8::Gemm g_{(const pg8::bf16_t*)ACT, (const pg8::bf16_t*)WOUT0T, M, DM, DFF, pg8::EpiConvAct::ATILED, WTILED, ZIG_DEF, 0}; pg8::ZeroBOrder S_; S_.init(M, DM, F.G, cid);
        pg8::EpiNull E_{(float*)(ws + WS_QF)}; pg8::gemm_phase<pg8::EpiNull, pg8::ZeroBOrder, true, true>(ring, g_, S_, E_); }
#endif
#if defined(DUP_P10NULL)
    xcd_barrier(bar); { pg8::Gemm g_{(const pg8::bf16_t*)ACT, (const pg8::bf16_t*)WOUT0T, M, DM, DFF, pg8::EpiConvAct::ATILED, WTILED, ZIG_DEF, 0}; pg8::StaticOrder S_; S_.init(M, DM, F.G, cid);
        pg8::EpiNull E_{(float*)(ws + WS_QF)}; pg8::gemm_phase<pg8::EpiNull, pg8::StaticOrder, true, true>(ring, g_, S_, E_); }
#endif
    SEAM(10);
    if (IN(11)) for (int rep_ = 0; rep_ < REPS(11); ++rep_) { if (rep_) xcd_barrier(bar); rows_phase<1, false>(F, AF, XN, n_ffn_post, nullptr, XN, RS); }
    SEAM(11);
    if (IN(12)) for (int rep_ = 0; rep_ < REPS(12); ++rep_) { if (rep_) xcd_barrier(bar);
        GEMM_BF16T(XN, WQK1T, M, QK1W, DM, QK1, QK1W, 1 << 30, 0, 4096, QS1, RS, XTILED);
        TAIL_CONVERT((M / 256) * (QK1W / 256), 3);
    }
    SEAM(12);
    if (IN(13)) for (int rep_ = 0; rep_ < REPS(13); ++rep_) { if (rep_) xcd_barrier(bar); swa_attn_phase(F, QK1, O, sinks); }
    SEAM(13);
    if (IN(14)) for (int rep_ = 0; rep_ < REPS(14); ++rep_) { if (rep_) xcd_barrier(bar); GEMM_BF16(O, WO1T, M, DM, DM, AF, DM, 1 << 30, 0, 0, 1.f, nullptr); }
    SEAM(14);
    if (IN(15)) for (int rep_ = 0; rep_ < REPS(15); ++rep_) { if (rep_) xcd_barrier(bar); rows_phase<1, false>(F, AF, XN, n_mix_post + DM, nullptr, XN, RS); }
    SEAM(15);
    if (IN(16)) for (int rep_ = 0; rep_ < REPS(16); ++rep_) { if (rep_) xcd_barrier(bar); GEMM_CONV(XN, WIN1T, conv_w + (size_t)3 * DFF2, conv_b + DFF2); TAIL_CONVERT((M / 256) * (DFF2 / 256), 4); }
    SEAM(16);
    if (IN(17)) for (int rep_ = 0; rep_ < REPS(17); ++rep_) { if (rep_) xcd_barrier(bar); conv_fix_phase(F, PART, HALO, conv_w + (size_t)3 * DFF2, conv_b + DFF2, ACT); }
    SEAM(17);
    if (IN(18)) for (int rep_ = 0; rep_ < REPS(18); ++rep_) { if (rep_) xcd_barrier(bar); GEMM_BF16T(ACT, WOUT1T, M, DM, DFF, AF, DM, 1 << 30, 0, 0, 1.f, nullptr, pg8::EpiConvAct::ATILED); }
    SEAM(18);
    if (IN(19)) for (int rep_ = 0; rep_ < REPS(19); ++rep_) { if (rep_) xcd_barrier(bar); rows_phase<2, false>(F, AF, XN, n_ffn_post + DM, H, nullptr, nullptr); }
#undef IN
#undef SEAM
}

#ifndef MK_SPLIT
#define MK_SPLIT 0
#endif
extern "C" void kernel_launch(void* const* d_in, const int* in_sizes, int n_in, void* d_out, int out_size, void* d_ws, size_t ws_size, hipStream_t stream) {
    static int grid = 0;
    if (grid == 0) {
        if (n_in != 23 || out_size != M * DM || ws_size < WS_END) { fprintf(stderr, "kernel_launch: unexpected shapes (n_in %d, out %d, ws %zu < %zu)\n", n_in, out_size, ws_size, (size_t)WS_END); grid = -1; return; }
        int dev = 0, cus = 0, per_cu = 0;
        if (hipGetDevice(&dev) != hipSuccess || hipDeviceGetAttribute(&cus, hipDeviceAttributeMultiprocessorCount, dev) != hipSuccess) { grid = -1; return; }
        if (hipFuncSetAttribute((const void*)yoco_fwd, hipFuncAttributeMaxDynamicSharedMemorySize, LDS_BYTES) != hipSuccess) { fprintf(stderr, "kernel_launch: hipFuncSetAttribute failed\n"); grid = -1; return; }
        if (hipOccupancyMaxActiveBlocksPerMultiprocessor(&per_cu, (const void*)yoco_fwd, NWAVES * 64, LDS_BYTES) != hipSuccess || per_cu < 1)
            fprintf(stderr, "kernel_launch: occupancy query reports %d workgroups per CU\n", per_cu);
        (void)hipGetLastError();
        grid = cus;
    }
    if (grid < 0) return;
    (void)hipMemsetAsync((char*)d_ws + WS_CTL, 0, 65536, stream);
    Args a; memset(&a, 0, sizeof(a));
    for (int i = 0; i < 23; ++i) a.in[i] = (const float*)d_in[i];
    a.out = (float*)d_out; a.ws = (unsigned char*)d_ws;
    unsigned char* ws = (unsigned char*)d_ws;
    const float* nmp = a.in[2]; const float* nfp = a.in[4];
    int nj = 0, tiles = 0;
    auto add = [&](const float* W, const float* gain, size_t wt_off, int ldw, int K, int ncols, int col0, int gs, int gsrc, int drow0, int mode = 0) {
        WJob& J = a.jobs[nj++]; J.W = W; J.gain = gain; J.WT = (bf16*)(ws + wt_off); J.ldw = ldw; J.K = K; J.ncols = ncols; J.col0 = col0; J.gs = gs; J.gsrc = gsrc; J.drow0 = drow0; J.item0 = tiles; J.mode = mode; J.pad = 0;
        tiles += (K / 64) * (ncols / 256); };
    const int BIG = 1 << 30;
    add(a.in[6],  nmp,        WS_W1T,   QLORA,  DM,     QLORA,  0, BIG, 0, 0);
    add(a.in[8],  a.in[7],    WS_WUQT,  QW,     QLORA,  QW,     0, BIG, 0, 0, 1);
    add(a.in[11], a.in[10],   WS_WKNT,  8192,   KVLORA, 4096,   0, 128, 256, 0);
    add(a.in[11], a.in[10],   WS_WVT,   8192,   KVLORA, 4096, 128, 128, 256, 0);
    add(a.in[12], nullptr,    WS_WO0T,  DM,     DM,     DM,     0, BIG, 0, 0);
    add(a.in[19], nfp,        WS_WIN0T, DFF2,   DM,     DFF2,   0, BIG, 0, 0, 2);
    add(a.in[22], nullptr,    WS_WOUT0T,DM,     DFF,    DM,     0, BIG, 0, 0);
    add(a.in[16], nmp + DM,   WS_WQK1T, DM,     DM,     DM,     0, BIG, 0, 0);
    add(a.in[14], a.in[13],   WS_WQK1T, 512,    DM,     512,    0, BIG, 0, 4096);
    add(a.in[15], a.in[13],   WS_WQK1T, 512,    DM,     512,    0, BIG, 0, 4608);
    add(a.in[18], nullptr,    WS_WO1T,  DM,     DM,     DM,     0, BIG, 0, 0);
    add(a.in[19] + (size_t)DM * DFF2, nfp + DM, WS_WIN1T, DFF2, DM, DFF2, 0, BIG, 0, 0, 2);
    add(a.in[22] + (size_t)DFF * DM,  nullptr,  WS_WOUT1T, DM,  DFF, DM,  0, BIG, 0, 0);
    { auto idle = [&](int nwg) { const int rem = nwg % grid; return rem ? grid - rem : 0; };
      const int c16 = 27 * idle((M / 256) * (DFF2 / 256)), c12 = 27 * idle((M / 256) * (QK1W / 256)), c8 = c16, c1 = 24 * idle((M / 256) * (N1 / 256));
      const int lim16 = a.jobs[12].item0  , lim12 = a.jobs[10].item0  , lim8 = a.jobs[6].item0  , lim1 = a.jobs[1].item0  ;
      int t4 = tiles - c16; if (t4 < lim16) t4 = lim16;
      int t3 = t4 - c12;    if (t3 < lim12) t3 = lim12;
      int t2 = t3 - c8;     if (t2 < lim8)  t2 = lim8;
      int t1 = t2 - c1;     if (t1 < lim1)  t1 = lim1;
      int att_lo = a.jobs[4].item0, att_hi = (PIGGY && grid % 8 == 0) ? att_lo + (grid * 136) / 8 : att_lo; if (att_hi > t1) att_hi = t1; if (att_hi < att_lo) att_hi = att_lo;
      a.qb[0] = 0; a.qb[1] = t1; a.qb[2] = t2; a.qb[3] = t3; a.qb[4] = t4; a.qb[5] = tiles; a.qb[6] = att_lo; a.qb[7] = att_hi; }
    a.ntiles = tiles;
    { WJob& J = a.jobs[nj++]; J.W = a.in[9]; J.gain = nmp; J.WT = (bf16*)(ws + WS_W1T); J.ldw = 576; J.K = DM; J.ncols = 576; J.col0 = 0; J.gs = BIG; J.gsrc = 0; J.drow0 = QLORA; J.item0 = 0; J.mode = 0; J.pad = 0; }
    const int items = (DM / 64) * (576 / 32);
    a.nitems = items;
#if MK_SPLIT
    for (int p = 0; p < NPHASE; ++p) { a.ph_lo = p; a.ph_hi = p + 1; hipLaunchKernelGGL(yoco_fwd, dim3(grid), dim3(NWAVES * 64), LDS_BYTES, stream, a); }
#else
    a.ph_lo = 0; a.ph_hi = NPHASE;
    hipLaunchKernelGGL(yoco_fwd, dim3(grid), dim3(NWAVES * 64), LDS_BYTES, stream, a);
#endif
    const hipError_t le = hipPeekAtLastError();
    if (le != hipSuccess) fprintf(stderr, "kernel_launch: launch failed: %s\n", hipGetErrorName(le));
}
```
